# Optimizing an MI355X kernel written in HIP

```python
import math
import jax
import jax.numpy as jnp
from jax import lax
import numpy as np

D_MODEL = 1024
BATCH = 4
SEQ = 8192
DEPTH = 2

GRID_W = 64
CTX_LEN = 256
EPS = 1e-6
HEAD_DIM = 64
D_MIX = D_MODEL
W_GROUP = D_MIX // 4
SSD_HEADS = W_GROUP // HEAD_DIM
SSD_GROUPS = 2
SSD_STATE = 64
SSD_CONV = 5
SSD_CHUNK = 128
SSD_XBC = W_GROUP + 2 * SSD_GROUPS * SSD_STATE
COLS_A = W_GROUP + SSD_XBC + 2 * SSD_HEADS
HY_CH = W_GROUP
HY_ORDER = 2
HY_SHORT = 3
HY_EMB = 33
HY_BANDS = (HY_EMB - 1) // 2
HY_FILT = 64
HY_TARGET = 1e-2
HY_FAST_PCT = 0.3
HY_SLOW_PCT = 1.5
HY_MAX_DECAY = math.log(HY_TARGET) / HY_FAST_PCT
HY_MIN_DECAY = math.log(HY_TARGET) / HY_SLOW_PCT
COLS_B = (HY_ORDER + 1) * HY_CH
ATT_HEADS = W_GROUP // HEAD_DIM
ATT_KV = 2
COLS_ATT = ATT_HEADS * HEAD_DIM + 2 * ATT_KV * HEAD_DIM
WINDOW = 128
BLOCK = 128
ROPE_THETA = 10000.0
OFF_B = COLS_A
OFF_C = OFF_B + COLS_B
OFF_D = OFF_C + COLS_ATT
D_IN = OFF_D + COLS_ATT
D_FF = 4 * D_MODEL

kernel_name = 'hybrid_parallel_groups_flow_block'


def rms_norm(x, g):
    xf = x.astype(jnp.float32)
    y = xf * lax.rsqrt(jnp.mean(xf * xf, axis=-1, keepdims=True) + EPS)
    return (y * g.astype(jnp.float32)).astype(x.dtype)


def dw_conv_centred(u, w, b):
    k = w.shape[0]
    out = lax.conv_general_dilated(
        u, w[:, None, :].astype(u.dtype), window_strides=(1,), padding=[(k // 2, k // 2)],
        dimension_numbers=('NWC', 'WIO', 'NWC'), feature_group_count=u.shape[-1])
    return out + b.astype(u.dtype)


def rope_tables(rows):
    row = jnp.repeat(jnp.arange(rows, dtype=jnp.float32), GRID_W)
    col = jnp.tile(jnp.arange(GRID_W, dtype=jnp.float32), rows)
    n_freq = HEAD_DIM // 4
    inv = ROPE_THETA ** (-jnp.arange(n_freq, dtype=jnp.float32) / n_freq)
    ang = jnp.concatenate([row[:, None] * inv, col[:, None] * inv], axis=-1)
    return jnp.cos(ang), jnp.sin(ang)


def apply_rope(t, cos, sin):
    tf = t.astype(jnp.float32)
    t1, t2 = jnp.split(tf, 2, axis=-1)
    c = cos[None, :, None, :]
    s = sin[None, :, None, :]
    return jnp.concatenate([t1 * c - t2 * s, t1 * s + t2 * c], axis=-1).astype(t.dtype)


def ssd_scan(xs, dt, a_h, bm, cm, h0):
    b, n, nh, hp = xs.shape
    nchunk = n // SSD_CHUNK
    rep = nh // SSD_GROUPS
    bh = jnp.repeat(bm, rep, axis=2).reshape(b, nchunk, SSD_CHUNK, nh, SSD_STATE)
    ch = jnp.repeat(cm, rep, axis=2).reshape(b, nchunk, SSD_CHUNK, nh, SSD_STATE)
    xc = xs.reshape(b, nchunk, SSD_CHUNK, nh, hp)
    dtc = dt.reshape(b, nchunk, SSD_CHUNK, nh)
    a_cum = jnp.cumsum(dtc * a_h, axis=2)
    seg = a_cum[:, :, :, None, :] - a_cum[:, :, None, :, :]
    lower = jnp.tril(jnp.ones((SSD_CHUNK, SSD_CHUNK), dtype=bool))[None, None, :, :, None]
    decay_in = jnp.exp(jnp.where(lower, seg, -jnp.inf))
    scores = jnp.einsum('bcihn,bcjhn->bcijh', ch, bh) * decay_in
    y_diag = jnp.einsum('bcijh,bcjh,bcjhp->bcihp', scores, dtc, xc)
    decay_to_end = jnp.exp(a_cum[:, :, -1:, :] - a_cum)
    chunk_states = jnp.einsum('bcjhn,bcjh,bcjhp->bchpn', bh, decay_to_end * dtc, xc)
    chunk_decay = jnp.exp(a_cum[:, :, -1, :])

    def step(h, inp):
        st, dec = inp
        return dec[:, :, None, None] * h + st, h

    h_final, h_prev = lax.scan(step, h0, (jnp.moveaxis(chunk_states, 1, 0), jnp.moveaxis(chunk_decay, 1, 0)))
    h_prev = jnp.moveaxis(h_prev, 0, 1)
    y_off = jnp.einsum('bcihn,bchpn,bcih->bcihp', ch, h_prev, jnp.exp(a_cum))
    return (y_diag + y_off).reshape(b, n, nh, hp), h_final


def _maybe_flip(t, rev):
    return jnp.flip(t, axis=1) if rev else t


def _ssd_prep(a, conv_w, conv_b):
    b, n, _ = a.shape
    gn = SSD_GROUPS * SSD_STATE
    z = a[..., :W_GROUP].astype(jnp.float32)
    xbc = jax.nn.silu(dw_conv_centred(a[..., W_GROUP:W_GROUP + SSD_XBC], conv_w, conv_b)).astype(jnp.float32)
    xs = xbc[..., :W_GROUP].reshape(b, n, SSD_HEADS, HEAD_DIM)
    bm = xbc[..., W_GROUP:W_GROUP + gn].reshape(b, n, SSD_GROUPS, SSD_STATE)
    cm = xbc[..., W_GROUP + gn:].reshape(b, n, SSD_GROUPS, SSD_STATE)
    dt_raw = a[..., W_GROUP + SSD_XBC:].astype(jnp.float32).reshape(b, n, 2, SSD_HEADS)
    return z, xs, bm, cm, dt_raw


def ssd_branch(a_lat, a_ctx, conv_w, conv_b, a_log, dt_bias, d_skip, norm_g, need_ctx):
    zl, xl, bl, cl, dtl = _ssd_prep(a_lat, conv_w, conv_b)
    zc, xc, bc, cc, dtc = _ssd_prep(a_ctx, conv_w, conv_b)
    b, n = a_lat.shape[:2]
    n_ctx = a_ctx.shape[1]
    skip = d_skip.astype(jnp.float32)[:, None]
    yl = skip * xl
    yc = skip * xc
    for d in range(2):
        rev = d == 1
        a_h = -jnp.exp(a_log[d].astype(jnp.float32))
        bias = dt_bias[d].astype(jnp.float32)
        dt_c = jax.nn.softplus(dtc[:, :, d] + bias)
        dt_l = jax.nn.softplus(dtl[:, :, d] + bias)
        h0 = jnp.zeros((b, SSD_HEADS, HEAD_DIM, SSD_STATE), jnp.float32)
        yc_d, h_ctx = ssd_scan(_maybe_flip(xc, rev), _maybe_flip(dt_c, rev), a_h,
                               _maybe_flip(bc, rev), _maybe_flip(cc, rev), h0)
        yl_d, _ = ssd_scan(_maybe_flip(xl, rev), _maybe_flip(dt_l, rev), a_h,
                           _maybe_flip(bl, rev), _maybe_flip(cl, rev), h_ctx)
        yl = yl + _maybe_flip(yl_d, rev)
        if need_ctx:
            yc = yc + _maybe_flip(yc_d, rev)
    out_l = rms_norm(yl.reshape(b, n, W_GROUP) * jax.nn.silu(zl), norm_g).astype(a_lat.dtype)
    if not need_ctx:
        return out_l, None
    out_c = rms_norm(yc.reshape(b, n_ctx, W_GROUP) * jax.nn.silu(zc), norm_g).astype(a_ctx.dtype)
    return out_l, out_c


def hyena_spectra(n, w1, b1, freq1, w2, b2, freq2, w3, b3):
    f32 = jnp.float32
    pos = jnp.arange(n, dtype=f32)
    t = jnp.linspace(0.0, 1.0, n, dtype=f32)
    f = jnp.linspace(1e-4, HY_BANDS - 1, HY_BANDS, dtype=f32)
    ang = 2.0 * math.pi * pos[:, None] * f[None, :] / n
    z = jnp.concatenate([t[:, None], jnp.cos(ang), -jnp.sin(ang)], axis=-1)
    h = jnp.sin(freq1.astype(f32) * (z @ w1.astype(f32) + b1.astype(f32)))
    h = jnp.sin(freq2.astype(f32) * (h @ w2.astype(f32) + b2.astype(f32)))
    k = (h @ w3.astype(f32) + b3.astype(f32)).reshape(n, HY_ORDER, 2, HY_CH)
    deltas = jnp.abs(jnp.linspace(HY_MIN_DECAY, HY_MAX_DECAY, HY_CH, dtype=f32))
    k = k * jnp.exp(-t[:, None] * deltas[None, :])[:, None, None, :]
    k = k * lax.rsqrt(jnp.sum(k * k, axis=(0, 2), keepdims=True) + EPS)
    k_fwd, k_bwd = k[:, :, 0], k[:, :, 1]
    full = jnp.concatenate([k_fwd, jnp.zeros((1, HY_ORDER, HY_CH), f32), jnp.flip(k_bwd[1:], axis=0)], axis=0)
    return jnp.fft.rfft(full, axis=0)


def hyena_seq(u, conv_w, conv_b, spec, bias):
    n = u.shape[1]
    u = dw_conv_centred(u, conv_w, conv_b).astype(jnp.float32)
    v, x1, x2 = jnp.split(u, 3, axis=-1)
    gates = (x1, x2)
    bias = bias.astype(jnp.float32)
    z = v
    for o in range(HY_ORDER):
        zf = jnp.fft.irfft(jnp.fft.rfft(z, n=2 * n, axis=1) * spec[:, o], n=2 * n, axis=1)[:, :n]
        z = gates[o] * (zf + z * bias[o])
    return z


def split_qkv(p):
    b, n, _ = p.shape
    nq = ATT_HEADS * HEAD_DIM
    nk = ATT_KV * HEAD_DIM
    q = p[..., :nq].reshape(b, n, ATT_HEADS, HEAD_DIM)
    k = p[..., nq:nq + nk].reshape(b, n, ATT_KV, HEAD_DIM)
    v = p[..., nq + nk:].reshape(b, n, ATT_KV, HEAD_DIM)
    return q, k, v


def window_attention(q, k, v, kc, vc, sink):
    b, n, nh, hd = q.shape
    nb = n // BLOCK
    rep = nh // ATT_KV
    scale = hd ** -0.5
    qb = q.reshape(b, nb, BLOCK, ATT_KV, rep, hd)

    def band(t):
        tp = jnp.pad(t, ((0, 0), (BLOCK, BLOCK), (0, 0), (0, 0))).reshape(b, nb + 2, BLOCK, ATT_KV, hd)
        return jnp.concatenate([tp[:, :-2], tp[:, 1:-1], tp[:, 2:]], axis=2)

    kb, vb = band(k), band(v)
    qpos = jnp.arange(nb)[:, None] * BLOCK + jnp.arange(BLOCK)[None, :]
    kpos = jnp.arange(nb)[:, None] * BLOCK - BLOCK + jnp.arange(3 * BLOCK)[None, :]
    valid = ((jnp.abs(qpos[:, :, None] - kpos[:, None, :]) <= WINDOW)
             & (kpos[:, None, :] >= 0) & (kpos[:, None, :] < n))
    s_loc = jnp.einsum('bnqgrd,bnkgd->bngrqk', qb, kb, preferred_element_type=jnp.float32) * scale
    s_loc = jnp.where(valid[None, :, None, None], s_loc, -jnp.inf)
    s_ctx = jnp.einsum('bnqgrd,bcgd->bngrqc', qb, kc, preferred_element_type=jnp.float32) * scale
    snk = jnp.broadcast_to(sink.astype(jnp.float32).reshape(1, 1, ATT_KV, rep, 1, 1), s_loc.shape[:-1] + (1,))
    p = jax.nn.softmax(jnp.concatenate([s_loc, s_ctx, snk], axis=-1), axis=-1).astype(v.dtype)
    kl = 3 * BLOCK
    o = (jnp.einsum('bngrqk,bnkgd->bnqgrd', p[..., :kl], vb)
         + jnp.einsum('bngrqc,bcgd->bnqgrd', p[..., kl:kl + kc.shape[1]], vc))
    return o.reshape(b, n, nh * hd)


def dense_attention(q, k, v, kc, vc):
    b, n, nh, hd = q.shape
    nb = n // BLOCK
    rep = nh // ATT_KV
    k_all = jnp.concatenate([k, kc], axis=1)
    v_all = jnp.concatenate([v, vc], axis=1)
    qb = jnp.moveaxis(q.reshape(b, nb, BLOCK, ATT_KV, rep, hd), 1, 0)

    def one_block(q_blk):
        s = jnp.einsum('bqgrd,bkgd->bgrqk', q_blk, k_all, preferred_element_type=jnp.float32) * hd ** -0.5
        p = jax.nn.softmax(s, axis=-1).astype(v_all.dtype)
        return jnp.einsum('bgrqk,bkgd->bqgrd', p, v_all)

    o = lax.map(one_block, qb)
    return jnp.moveaxis(o, 0, 1).reshape(b, n, nh * hd)


def context_attention(q, k, v, sink):
    b, n, nh, hd = q.shape
    rep = nh // ATT_KV
    nk = k.shape[1]
    s = jnp.einsum('bqgrd,bkgd->bgrqk', q.reshape(b, n, ATT_KV, rep, hd), k,
                   preferred_element_type=jnp.float32) * hd ** -0.5
    if sink is not None:
        snk = jnp.broadcast_to(sink.astype(jnp.float32).reshape(1, ATT_KV, rep, 1, 1), s.shape[:-1] + (1,))
        s = jnp.concatenate([s, snk], axis=-1)
    p = jax.nn.softmax(s, axis=-1)[..., :nk].astype(v.dtype)
    return jnp.einsum('bgrqk,bkgd->bqgrd', p, v).reshape(b, n, nh * hd)


def token_mixers(h, hc, w_in, w_out, ssd_conv_w, ssd_conv_b, ssd_a_log, ssd_dt_bias, ssd_d, ssd_norm,
                 hy_conv_w, hy_conv_b, hy_filter, hy_bias, attn_sink, q_norm, k_norm, cos, sin, need_ctx):
    n, n_ctx = h.shape[1], hc.shape[1]
    proj = h @ w_in
    projc = hc @ w_in
    ya, yac = ssd_branch(proj[..., :OFF_B], projc[..., :OFF_B], ssd_conv_w, ssd_conv_b, ssd_a_log,
                         ssd_dt_bias, ssd_d, ssd_norm, need_ctx)
    yb = hyena_seq(proj[..., OFF_B:OFF_C], hy_conv_w, hy_conv_b, hyena_spectra(n, *hy_filter), hy_bias)
    qw, kw, vw = split_qkv(proj[..., OFF_C:OFF_D])
    qwc, kwc, vwc = split_qkv(projc[..., OFF_C:OFF_D])
    yw = window_attention(apply_rope(qw, cos, sin), apply_rope(kw, cos, sin), vw, kwc, vwc, attn_sink)
    qd, kd, vd = split_qkv(proj[..., OFF_D:])
    qdc, kdc, vdc = split_qkv(projc[..., OFF_D:])
    kdc = rms_norm(kdc, k_norm)
    yd = dense_attention(apply_rope(rms_norm(qd, q_norm), cos, sin), apply_rope(rms_norm(kd, k_norm), cos, sin),
                         vd, kdc, vdc)
    dt = h.dtype
    y = jnp.concatenate([ya, yb.astype(dt), yw, yd], axis=-1) @ w_out
    if not need_ctx:
        return y, None
    ybc = hyena_seq(projc[..., OFF_B:OFF_C], hy_conv_w, hy_conv_b, hyena_spectra(n_ctx, *hy_filter), hy_bias)
    ywc = context_attention(qwc, kwc, vwc, attn_sink)
    ydc = context_attention(rms_norm(qdc, q_norm), kdc, vdc, None)
    yc = jnp.concatenate([yac, ybc.astype(dt), ywc, ydc], axis=-1) @ w_out
    return y, yc


def squared_relu_mlp(h, w1, w2):
    return jnp.square(jax.nn.relu(h @ w1)) @ w2


def setup_inputs(seed: int = 0) -> dict:
    key = jax.random.key(seed)
    ks = jax.random.split(key, 40)
    f32 = jnp.float32

    def nrm(k, shape, scale):
        return jax.random.normal(k, shape, f32) * scale

    def gain(k, shape):
        return 1.0 + 0.05 * jax.random.normal(k, shape, f32)

    dt_init = jnp.exp(jax.random.uniform(ks[15], (DEPTH, 2, SSD_HEADS), f32, math.log(1e-3), math.log(1e-1)))
    return {
        'x': nrm(ks[0], (BATCH, SEQ, D_MODEL), 1.0),
        'c': nrm(ks[1], (BATCH, D_MODEL), 1.0),
        'ctx': nrm(ks[2], (BATCH, CTX_LEN, D_MODEL), 1.0),
        'c_ctx': nrm(ks[3], (D_MODEL,), 1.0),
        'w_mod': nrm(ks[4], (DEPTH, D_MODEL, 6 * D_MODEL), 0.5 * D_MODEL ** -0.5),
        'b_mod': nrm(ks[5], (DEPTH, 6 * D_MODEL), 0.02),
        'norm_mix_pre': gain(ks[6], (DEPTH, D_MODEL)),
        'norm_mix_post': gain(ks[7], (DEPTH, D_MODEL)),
        'norm_mlp_pre': gain(ks[8], (DEPTH, D_MODEL)),
        'norm_mlp_post': gain(ks[9], (DEPTH, D_MODEL)),
        'w_in': nrm(ks[10], (DEPTH, D_MODEL, D_IN), D_MODEL ** -0.5),
        'w_out': nrm(ks[11], (DEPTH, D_MIX, D_MODEL), D_MIX ** -0.5),
        'ssd_conv_w': nrm(ks[12], (DEPTH, SSD_CONV, SSD_XBC), SSD_CONV ** -0.5),
        'ssd_conv_b': nrm(ks[13], (DEPTH, SSD_XBC), 0.02),
        'ssd_a_log': jnp.log(jax.random.uniform(ks[14], (DEPTH, 2, SSD_HEADS), f32, 1.0, 16.0)),
        'ssd_dt_bias': dt_init + jnp.log(-jnp.expm1(-dt_init)),
        'ssd_d': gain(ks[16], (DEPTH, SSD_HEADS)),
        'ssd_norm': gain(ks[17], (DEPTH, W_GROUP)),
        'hy_conv_w': nrm(ks[18], (DEPTH, HY_SHORT, COLS_B), HY_SHORT ** -0.5),
        'hy_conv_b': nrm(ks[19], (DEPTH, COLS_B), 0.02),
        'hy_w1': nrm(ks[20], (DEPTH, HY_EMB, HY_FILT), HY_EMB ** -0.5),
        'hy_b1': nrm(ks[21], (DEPTH, HY_FILT), 0.1),
        'hy_freq1': gain(ks[22], (DEPTH, HY_FILT)),
        'hy_w2': nrm(ks[23], (DEPTH, HY_FILT, HY_FILT), HY_FILT ** -0.5),
        'hy_b2': nrm(ks[24], (DEPTH, HY_FILT), 0.1),
        'hy_freq2': gain(ks[25], (DEPTH, HY_FILT)),
        'hy_w3': nrm(ks[26], (DEPTH, HY_FILT, 2 * HY_ORDER * HY_CH), HY_FILT ** -0.5),
        'hy_b3': nrm(ks[27], (DEPTH, 2 * HY_ORDER * HY_CH), 0.02),
        'hy_bias': nrm(ks[28], (DEPTH, HY_ORDER, HY_CH), 0.5),
        'attn_sink': nrm(ks[29], (DEPTH, ATT_HEADS), 0.5),
        'q_norm': gain(ks[30], (DEPTH, HEAD_DIM)),
        'k_norm': gain(ks[31], (DEPTH, HEAD_DIM)),
        'mlp_w1': nrm(ks[32], (DEPTH, D_MODEL, D_FF), D_MODEL ** -0.5),
        'mlp_w2': nrm(ks[33], (DEPTH, D_FF, D_MODEL), D_FF ** -0.5),
    }


def reference(x, c, ctx, c_ctx, w_mod, b_mod, norm_mix_pre, norm_mix_post, norm_mlp_pre, norm_mlp_post,
              w_in, w_out, ssd_conv_w, ssd_conv_b, ssd_a_log, ssd_dt_bias, ssd_d, ssd_norm,
              hy_conv_w, hy_conv_b, hy_w1, hy_b1, hy_freq1, hy_w2, hy_b2, hy_freq2, hy_w3, hy_b3, hy_bias,
              attn_sink, q_norm, k_norm, mlp_w1, mlp_w2):
    rows = x.shape[1] // GRID_W
    cos, sin = rope_tables(rows)
    for i in range(DEPTH):
        need_ctx = i < DEPTH - 1
        mod = jax.nn.silu(c) @ w_mod[i] + b_mod[i]
        mod_c = jax.nn.silu(c_ctx) @ w_mod[i] + b_mod[i]
        sh1, sc1, g1, sh2, sc2, g2 = jnp.split(mod[:, None, :], 6, axis=-1)
        csh1, csc1, cg1, csh2, csc2, cg2 = jnp.split(mod_c, 6, axis=-1)
        h = rms_norm(x, norm_mix_pre[i]) * (1.0 + sc1) + sh1
        hc = rms_norm(ctx, norm_mix_pre[i]) * (1.0 + csc1) + csh1
        hy_filter = (hy_w1[i], hy_b1[i], hy_freq1[i], hy_w2[i], hy_b2[i], hy_freq2[i], hy_w3[i], hy_b3[i])
        y, yc = token_mixers(h, hc, w_in[i], w_out[i], ssd_conv_w[i], ssd_conv_b[i], ssd_a_log[i],
                             ssd_dt_bias[i], ssd_d[i], ssd_norm[i], hy_conv_w[i], hy_conv_b[i], hy_filter,
                             hy_bias[i], attn_sink[i], q_norm[i], k_norm[i], cos, sin, need_ctx)
        x = x + g1 * rms_norm(y, norm_mix_post[i])
        h = rms_norm(x, norm_mlp_pre[i]) * (1.0 + sc2) + sh2
        x = x + g2 * rms_norm(squared_relu_mlp(h, mlp_w1[i], mlp_w2[i]), norm_mlp_post[i])
        if need_ctx:
            ctx = ctx + cg1 * rms_norm(yc, norm_mix_post[i])
            hc = rms_norm(ctx, norm_mlp_pre[i]) * (1.0 + csc2) + csh2
            ctx = ctx + cg2 * rms_norm(squared_relu_mlp(hc, mlp_w1[i], mlp_w2[i]), norm_mlp_post[i])
    return x
```

```cpp
#include <hip/hip_runtime.h>
#include <hip/hip_cooperative_groups.h>
#include <stdint.h>
#include <stdio.h>
namespace cg = cooperative_groups;

#ifndef ONE_LAUNCH
#define ONE_LAUNCH 0
#endif

typedef unsigned short bf16;
typedef short bf16x8 __attribute__((ext_vector_type(8)));
typedef short s16x4 __attribute__((ext_vector_type(4)));
typedef float f32x16 __attribute__((ext_vector_type(16)));
typedef __bf16 bfv2 __attribute__((ext_vector_type(2)));
typedef float fv2 __attribute__((ext_vector_type(2)));

#define DI __device__ __forceinline__
#define MFMA(a, b, c) __builtin_amdgcn_mfma_f32_32x32x16_bf16((a), (b), (c), 0, 0, 0)

DI float bf2f(bf16 b) { return __uint_as_float(((unsigned)b) << 16); }
DI unsigned pack2(float a, float b) { fv2 v = {a, b}; return __builtin_bit_cast(unsigned, __builtin_convertvector(v, bfv2)); }
DI bf16 f2bf(float a) { return (bf16)(pack2(a, 0.f) & 0xffffu); }
DI float silu_f(float x) { return x / (1.f + expf(-x)); }

constexpr int NB = 4, SEQ = 8192, CTXL = 256, NLAT = NB * SEQ, NCTX = NB * CTXL, MROWS = NLAT + NCTX;
constexpr int KEYS = SEQ + CTXL;
constexpr float EPS = 1e-6f;
constexpr float LOG2E = 1.4426950408889634f;
constexpr int NORD = 132;
constexpr int SPEC_LD = 8200;

constexpr size_t OFF_WIN = 0;
constexpr size_t OFF_WOUT = OFF_WIN + (size_t)2 * 2560 * 1024 * 2;
constexpr size_t OFF_W1 = OFF_WOUT + (size_t)2 * 1024 * 1024 * 2;
constexpr size_t OFF_W2 = OFF_W1 + (size_t)2 * 4096 * 1024 * 2;
constexpr size_t OFF_SPEC = OFF_W2 + (size_t)2 * 4096 * 1024 * 2;
constexpr size_t OFF_KC = OFF_SPEC + (size_t)2 * 2 * 256 * SPEC_LD * 8;
constexpr size_t OFF_PART = OFF_KC + (size_t)1024 * 256 * 4;
constexpr size_t OFF_ROPE = OFF_PART + (size_t)3 * 256 * 1024 * 4;
constexpr size_t OFF_TW8 = OFF_ROPE + (size_t)8192 * 32 * 8;
constexpr size_t OFF_TW16 = OFF_TW8 + 4096 * 8;
constexpr size_t OFF_MOD = OFF_TW16 + 8192 * 8;
constexpr size_t OFF_DT = OFF_MOD + (size_t)2 * 5 * 6144 * 4;
constexpr size_t OFF_DEC = OFF_DT + (size_t)MROWS * 8 * 4;
constexpr size_t OFF_CTXS = OFF_DEC + 32 * NORD * 4 + 256;
constexpr size_t OFF_ARENA = ((OFF_CTXS + (size_t)1024 * 1024 * 4 + 4095) / 4096) * 4096;
constexpr size_t SZ_H = (size_t)MROWS * 1024 * 2;
constexpr size_t A_HBUF = OFF_ARENA;
constexpr size_t A_YOUT = A_HBUF + SZ_H;
constexpr size_t A_PROJ = A_YOUT + SZ_H;
constexpr size_t A_PROJA = A_PROJ;
constexpr size_t A_HYRAW = A_PROJA + (size_t)MROWS * 768 * 2;
constexpr size_t A_HYRAWC = A_HYRAW + (size_t)4 * 768 * 8192 * 2;
constexpr size_t A_QB = A_HYRAWC + (size_t)4 * 768 * 256 * 2;
constexpr size_t A_KB = A_QB + (size_t)2 * 4 * 4 * KEYS * 64 * 2;
constexpr size_t A_VT = A_KB + (size_t)2 * 4 * 2 * KEYS * 64 * 2;
constexpr size_t A_PROJ_END = A_VT + (size_t)2 * 4 * 2 * KEYS * 64 * 2;
constexpr size_t A_YMIX = A_PROJ_END;
constexpr size_t WS_END = A_YMIX + SZ_H;
constexpr size_t A_HID = A_PROJ;
constexpr size_t A_KRAW = A_PROJ;
constexpr size_t A_STATES = A_HBUF;
constexpr size_t A_YSSD = A_YOUT;
constexpr size_t A_HYOUT = A_YSSD + (size_t)MROWS * 256 * 4;
constexpr size_t A_ESCR1 = A_HYOUT + (size_t)4 * 256 * 8192 * 2;
constexpr size_t A_ESCR0 = WS_END;
constexpr size_t WS_TOTAL = A_ESCR0 + (size_t)256 * 8192 * 8;
static_assert(A_ESCR1 + (size_t)256 * 8192 * 8 <= A_PROJ, "escr1 alias");
static_assert((size_t)16896 * 4096 * 2 <= A_PROJ_END - A_PROJ, "hidden alias");
static_assert((size_t)2 * 1024 * 8192 * 4 <= A_PROJ_END - A_PROJ, "kraw alias");
static_assert((size_t)32 * NORD * 4096 * 4 <= SZ_H, "states alias");
static_assert(A_HYOUT + (size_t)4 * 256 * 8192 * 2 <= A_PROJ, "hyout alias");
static_assert(WS_TOTAL <= (size_t)536870912, "workspace");

struct Params {
  const float* in[34];
  float* out;
  char* ws;
  int ph0, ph1;
  int coop, pad;
};

constexpr int SMEM_BYTES = 73728;

DI float wave_sum(float v) {
#pragma unroll
  for (int o = 32; o >= 1; o >>= 1) v += __shfl_xor(v, o);
  return v;
}
DI float block_sum(float v, float* red) {
  v = wave_sum(v);
  if ((threadIdx.x & 63) == 0) red[threadIdx.x >> 6] = v;
  __syncthreads();
  float r = red[0] + red[1] + red[2] + red[3];
  __syncthreads();
  return r;
}

DI void fft_fwd(float2* X, const float2* __restrict__ tw) {
  const int tid = threadIdx.x;
  for (int s = 12; s >= 0; --s) {
    __syncthreads();
    const int half = 1 << s;
#pragma unroll 4
    for (int t = tid; t < 4096; t += 256) {
      int pos = t & (half - 1);
      int i0 = ((t >> s) << (s + 1)) + pos;
      int i1 = i0 + half;
      float2 a = X[i0], b = X[i1];
      float2 w = tw[pos << (12 - s)];
      float dx = a.x - b.x, dy = a.y - b.y;
      X[i0] = make_float2(a.x + b.x, a.y + b.y);
      X[i1] = make_float2(dx * w.x - dy * w.y, dx * w.y + dy * w.x);
    }
  }
  __syncthreads();
}
DI void fft_inv(float2* X, const float2* __restrict__ tw) {
  const int tid = threadIdx.x;
  for (int s = 0; s <= 12; ++s) {
    __syncthreads();
    const int half = 1 << s;
#pragma unroll 4
    for (int t = tid; t < 4096; t += 256) {
      int pos = t & (half - 1);
      int i0 = ((t >> s) << (s + 1)) + pos;
      int i1 = i0 + half;
      float2 a = X[i0], b = X[i1];
      float2 w = tw[pos << (12 - s)];
      float bx = b.x * w.x + b.y * w.y, by = b.y * w.x - b.x * w.y;
      X[i0] = make_float2(a.x + bx, a.y + by);
      X[i1] = make_float2(a.x - bx, a.y - by);
    }
  }
  __syncthreads();
}
DI int brev13(int j) { return (int)(__brev((unsigned)j) >> 19); }

DI void conv_tr_tile(const float* __restrict__ src, int src_ld, int k0, int n0, int shift,
                     bf16* __restrict__ dst, int dst_ld, float* lds) {
  const int tid = threadIdx.x, tx = tid & 63, ty = tid >> 6;
  int n = n0 + tx;
  int col = n + ((n >= 768) ? shift : 0);
#pragma unroll
  for (int i = 0; i < 16; ++i) { int kk = ty + 4 * i; lds[kk * 65 + tx] = src[(size_t)(k0 + kk) * src_ld + col]; }
  __syncthreads();
#pragma unroll
  for (int i = 0; i < 16; ++i) { int nn = ty + 4 * i; dst[(size_t)(n0 + nn) * dst_ld + k0 + tx] = f2bf(lds[tx * 65 + nn]); }
  __syncthreads();
}

DI void mod_item(const Params& p, int it, float* lds) {
  const int tid = threadIdx.x;
  const int layer = it / 96, col0 = (it % 96) * 64;
  float* sv = lds;
  for (int e = tid; e < 5120; e += 256) {
    int r = e >> 10, k = e & 1023;
    float c = (r < 4) ? p.in[1][r * 1024 + k] : p.in[3][k];
    sv[e] = silu_f(c);
  }
  __syncthreads();
  const int cx = tid & 63, kg = tid >> 6;
  float acc[5] = {0.f, 0.f, 0.f, 0.f, 0.f};
  const float* w = p.in[4] + (size_t)layer * 1024 * 6144 + col0 + cx;
#pragma unroll 8
  for (int k = kg; k < 1024; k += 4) {
    float wv = w[(size_t)k * 6144];
#pragma unroll
    for (int r = 0; r < 5; ++r) acc[r] += sv[r * 1024 + k] * wv;
  }
  float* red = lds + 5120;
#pragma unroll
  for (int r = 0; r < 5; ++r) red[(kg * 5 + r) * 64 + cx] = acc[r];
  __syncthreads();
  if (tid < 64) {
    float* mod = (float*)(p.ws + OFF_MOD);
#pragma unroll
    for (int r = 0; r < 5; ++r) {
      float s = red[(0 * 5 + r) * 64 + tid] + red[(1 * 5 + r) * 64 + tid] + red[(2 * 5 + r) * 64 + tid] + red[(3 * 5 + r) * 64 + tid];
      mod[(size_t)(layer * 5 + r) * 6144 + col0 + tid] = s + p.in[5][layer * 6144 + col0 + tid];
    }
  }
  __syncthreads();
}

DI void filt_f1(const Params& p, int fid, int tile, float* lds) {
  const int tid = threadIdx.x;
  const int layer = (fid == 1) ? 1 : 0;
  const int n = (fid < 2) ? 8192 : 256;
  const int pos0 = tile * 32;
  float* zf = lds;
  float* h1 = lds + 1056;
  float* h2 = h1 + 2048;
  const float* w1 = p.in[20] + layer * 33 * 64;
  const float* b1 = p.in[21] + layer * 64;
  const float* f1 = p.in[22] + layer * 64;
  const float* w2 = p.in[23] + layer * 4096;
  const float* b2 = p.in[24] + layer * 64;
  const float* f2 = p.in[25] + layer * 64;
  const float* w3 = p.in[26] + (size_t)layer * 64 * 1024;
  const float* b3 = p.in[27] + layer * 1024;
  for (int e = tid; e < 1056; e += 256) {
    int pp = e / 33, f = e % 33;
    float pos = (float)(pos0 + pp);
    float val;
    if (f == 0) val = pos / (float)(n - 1);
    else {
      int i = (f - 1) & 15;
      float fb = 1e-4f + (float)i * ((15.f - 1e-4f) / 15.f);
      float ang = ((6.2831855f * pos) * fb) / (float)n;
      val = (f <= 16) ? cosf(ang) : -sinf(ang);
    }
    zf[e] = val;
  }
  __syncthreads();
  {
    const int u = tid & 63;
    for (int q = 0; q < 8; ++q) {
      int pp = (tid >> 6) + 4 * q;
      float acc = b1[u];
      for (int f = 0; f < 33; ++f) acc += zf[pp * 33 + f] * w1[f * 64 + u];
      h1[pp * 64 + u] = sinf(f1[u] * acc);
    }
  }
  __syncthreads();
  {
    const int u = tid & 63;
    for (int q = 0; q < 8; ++q) {
      int pp = (tid >> 6) + 4 * q;
      float acc = b2[u];
      for (int k = 0; k < 64; ++k) acc += h1[pp * 64 + k] * w2[k * 64 + u];
      h2[pp * 64 + u] = sinf(f2[u] * acc);
    }
  }
  __syncthreads();
  const float dmin = -3.0701134573253945f, dmax = -15.350567286626973f;
  float* kraw = (float*)(p.ws + A_KRAW);
  float* kc = (float*)(p.ws + OFF_KC);
  float* part = (float*)(p.ws + OFF_PART);
  for (int q = 0; q < 4; ++q) {
    const int oc = tid + 256 * q, ch = oc & 255;
    float wc[64];
#pragma unroll
    for (int u = 0; u < 64; ++u) wc[u] = w3[u * 1024 + oc];
    const float bb = b3[oc];
    const float delta = fabsf(dmin + (dmax - dmin) * ((float)ch / 255.f));
    float ss = 0.f;
    float* dst = (fid < 2) ? (kraw + ((size_t)fid * 1024 + oc) * 8192 + pos0) : (kc + (size_t)oc * 256 + pos0);
    for (int pp = 0; pp < 32; ++pp) {
      float acc = bb;
#pragma unroll
      for (int u = 0; u < 64; ++u) acc += h2[pp * 64 + u] * wc[u];
      float t = (float)(pos0 + pp) / (float)(n - 1);
      float val = acc * expf(-t * delta);
      dst[pp] = val;
      ss += val * val;
    }
    part[((size_t)fid * 256 + tile) * 1024 + oc] = ss;
  }
  __syncthreads();
}

DI void filt_f2(const Params& p, int it, char* smem) {
  const int tid = threadIdx.x;
  const int layer = it >> 9, order = (it >> 8) & 1, ch = it & 255;
  float2* X = (float2*)smem;
  float* red = (float*)(smem + 65536);
  const float* part = (const float*)(p.ws + OFF_PART);
  const int ocf = order * 512 + ch, ocb = ocf + 256;
  float v = part[((size_t)layer * 256 + tid) * 1024 + ocf] + part[((size_t)layer * 256 + tid) * 1024 + ocb];
  float tot = block_sum(v, red);
  const float scale = rsqrtf(tot + EPS);
  const float* kf = (const float*)(p.ws + A_KRAW) + ((size_t)layer * 1024 + ocf) * 8192;
  const float* kb = (const float*)(p.ws + A_KRAW) + ((size_t)layer * 1024 + ocb) * 8192;
  const float2* tw8 = (const float2*)(p.ws + OFF_TW8);
  const float2* tw16 = (const float2*)(p.ws + OFF_TW16);
  float2* H = (float2*)(p.ws + OFF_SPEC) + ((size_t)(layer * 2 + order) * 256 + ch) * SPEC_LD;
#pragma unroll 2
  for (int i = 0; i < 32; ++i) {
    int n = tid + 256 * i;
    float e = kf[n] + ((n >= 1) ? kb[8192 - n] : 0.f);
    X[n] = make_float2(e * scale, 0.f);
  }
  fft_fwd(X, tw8);
#pragma unroll 2
  for (int i = 0; i < 32; ++i) {
    int j = tid + 256 * i, k = brev13(j);
    if (k <= 4096) H[2 * k] = X[j];
  }
  __syncthreads();
#pragma unroll 2
  for (int i = 0; i < 32; ++i) {
    int n = tid + 256 * i;
    float o = (kf[n] - ((n >= 1) ? kb[8192 - n] : 0.f)) * scale;
    float2 w = tw16[n];
    X[n] = make_float2(o * w.x, o * w.y);
  }
  fft_fwd(X, tw8);
#pragma unroll 2
  for (int i = 0; i < 32; ++i) {
    int j = tid + 256 * i, k = brev13(j);
    if (k <= 4095) H[2 * k + 1] = X[j];
  }
  __syncthreads();
}

DI void rowpass(int lane, const float* __restrict__ xsrc, float* __restrict__ xdst, const bf16* __restrict__ yrow,
                const float* __restrict__ wpost, const float* __restrict__ gate, bool has_y,
                const float* __restrict__ wpre, const float* __restrict__ scv, const float* __restrict__ shv, bool do_norm,
                bf16* __restrict__ hrow, const float* __restrict__ wdt, float* __restrict__ dtrow) {
  float xv[16];
#pragma unroll
  for (int q = 0; q < 4; ++q) {
    float4 t = *(const float4*)(xsrc + lane * 4 + 256 * q);
    xv[4 * q] = t.x; xv[4 * q + 1] = t.y; xv[4 * q + 2] = t.z; xv[4 * q + 3] = t.w;
  }
  if (has_y) {
    float yv[16];
    float ss = 0.f;
#pragma unroll
    for (int q = 0; q < 4; ++q) {
      uint2 t = *(const uint2*)(yrow + lane * 4 + 256 * q);
      yv[4 * q] = __uint_as_float(t.x << 16); yv[4 * q + 1] = __uint_as_float(t.x & 0xffff0000u);
      yv[4 * q + 2] = __uint_as_float(t.y << 16); yv[4 * q + 3] = __uint_as_float(t.y & 0xffff0000u);
    }
#pragma unroll
    for (int e = 0; e < 16; ++e) ss += yv[e] * yv[e];
    ss = wave_sum(ss);
    const float rstd = rsqrtf(ss * (1.f / 1024.f) + EPS);
#pragma unroll
    for (int q = 0; q < 4; ++q) {
      float4 g = *(const float4*)(gate + lane * 4 + 256 * q);
      float4 w = *(const float4*)(wpost + lane * 4 + 256 * q);
      xv[4 * q] += g.x * (yv[4 * q] * rstd * w.x);
      xv[4 * q + 1] += g.y * (yv[4 * q + 1] * rstd * w.y);
      xv[4 * q + 2] += g.z * (yv[4 * q + 2] * rstd * w.z);
      xv[4 * q + 3] += g.w * (yv[4 * q + 3] * rstd * w.w);
      *(float4*)(xdst + lane * 4 + 256 * q) = make_float4(xv[4 * q], xv[4 * q + 1], xv[4 * q + 2], xv[4 * q + 3]);
    }
  }
  if (do_norm) {
    float ss = 0.f;
#pragma unroll
    for (int e = 0; e < 16; ++e) ss += xv[e] * xv[e];
    ss = wave_sum(ss);
    const float rstd = rsqrtf(ss * (1.f / 1024.f) + EPS);
    float hv[16];
#pragma unroll
    for (int q = 0; q < 4; ++q) {
      float4 w = *(const float4*)(wpre + lane * 4 + 256 * q);
      float4 sc = *(const float4*)(scv + lane * 4 + 256 * q);
      float4 sh = *(const float4*)(shv + lane * 4 + 256 * q);
      hv[4 * q] = xv[4 * q] * rstd * w.x * (1.f + sc.x) + sh.x;
      hv[4 * q + 1] = xv[4 * q + 1] * rstd * w.y * (1.f + sc.y) + sh.y;
      hv[4 * q + 2] = xv[4 * q + 2] * rstd * w.z * (1.f + sc.z) + sh.z;
      hv[4 * q + 3] = xv[4 * q + 3] * rstd * w.w * (1.f + sc.w) + sh.w;
      uint2 o;
      o.x = pack2(hv[4 * q], hv[4 * q + 1]);
      o.y = pack2(hv[4 * q + 2], hv[4 * q + 3]);
      *(uint2*)(hrow + lane * 4 + 256 * q) = o;
    }
    if (wdt) {
      float d[8] = {0.f, 0.f, 0.f, 0.f, 0.f, 0.f, 0.f, 0.f};
#pragma unroll
      for (int q = 0; q < 4; ++q) {
        asm volatile("" ::: "memory");
#pragma unroll
        for (int e = 0; e < 4; ++e) {
          const float* w = wdt + (size_t)(lane * 4 + 256 * q + e) * 2568;
          float4 w0 = *(const float4*)w, w1 = *(const float4*)(w + 4);
          float hh = hv[4 * q + e];
          d[0] += hh * w0.x; d[1] += hh * w0.y; d[2] += hh * w0.z; d[3] += hh * w0.w;
          d[4] += hh * w1.x; d[5] += hh * w1.y; d[6] += hh * w1.z; d[7] += hh * w1.w;
        }
      }
#pragma unroll
      for (int k = 0; k < 8; ++k) d[k] = wave_sum(d[k]);
      if (lane == 0) {
        *(float4*)dtrow = make_float4(d[0], d[1], d[2], d[3]);
        *(float4*)(dtrow + 4) = make_float4(d[4], d[5], d[6], d[7]);
      }
    }
  }
}

DI void rowpass_phase(const Params& p, int layer, int mode) {
  const int lane = threadIdx.x & 63, wave = threadIdx.x >> 6;
  const int nrows = (mode == 0 || layer == 0) ? MROWS : NLAT;
  const float* modb = (const float*)(p.ws + OFF_MOD);
  for (int r4 = blockIdx.x; r4 * 4 < nrows; r4 += gridDim.x) {
    const int row = r4 * 4 + wave;
    if (row >= nrows) continue;
    const int mb = (row < NLAT) ? (row >> 13) : 4;
    const bool first = (layer == 0 && mode <= 1);
    const float* xsrc;
    float* xdst;
    if (row < NLAT) {
      xsrc = first ? (p.in[0] + (size_t)row * 1024) : (p.out + (size_t)row * 1024);
      xdst = p.out + (size_t)row * 1024;
    } else {
      xsrc = first ? (p.in[2] + (size_t)(row - NLAT) * 1024) : ((const float*)(p.ws + OFF_CTXS) + (size_t)(row - NLAT) * 1024);
      xdst = (float*)(p.ws + OFF_CTXS) + (size_t)(row - NLAT) * 1024;
    }
    const float* mv = modb + (size_t)(layer * 5 + mb) * 6144;
    const bf16* yrow = (const bf16*)(p.ws + A_YOUT) + (size_t)row * 1024;
    bf16* hrow = (bf16*)(p.ws + A_HBUF) + (size_t)row * 1024;
    float* dtrow = (float*)(p.ws + OFF_DT) + (size_t)row * 8;
    if (mode == 0) {
      rowpass(lane, xsrc, xdst, yrow, nullptr, nullptr, false, p.in[6] + layer * 1024, mv + 1024, mv, true, hrow,
              p.in[10] + (size_t)layer * 1024 * 2568 + 768, dtrow);
    } else if (mode == 1) {
      rowpass(lane, xsrc, xdst, yrow, p.in[7] + layer * 1024, mv + 2048, true, p.in[8] + layer * 1024, mv + 4 * 1024, mv + 3 * 1024,
              true, hrow, nullptr, dtrow);
    } else {
      const bool nxt = (layer + 1 < 2);
      const float* mvn = modb + (size_t)((layer + 1) * 5 + mb) * 6144;
      rowpass(lane, xsrc, xdst, yrow, p.in[9] + layer * 1024, mv + 5 * 1024, true, p.in[6] + (layer + 1) * 1024, mvn + 1024, mvn, nxt,
              hrow, nxt ? (p.in[10] + (size_t)(layer + 1) * 1024 * 2568 + 768) : nullptr, dtrow);
    }
  }
}

DI void gemm_tile(const bf16* __restrict__ A, int lda, const bf16* __restrict__ Bt, int ldb, int K, char* smem) {
  const int tid = threadIdx.x, lane = tid & 63, wave = tid >> 6, r = lane & 31, h = lane >> 5, wm = wave >> 1, wn = wave & 1;
  const int lrow = tid >> 3, lkc = tid & 7;
  const bf16* ag = A + (size_t)lrow * lda + lkc * 8;
  const bf16* bg = Bt + (size_t)lrow * ldb + lkc * 8;
  uint4 ra[4], rb[4];
#pragma unroll
  for (int i = 0; i < 4; ++i) {
    ra[i] = *(const uint4*)(ag + (size_t)i * 32 * lda);
    rb[i] = *(const uint4*)(bg + (size_t)i * 32 * ldb);
  }
  const int soff = lrow * 144 + lkc * 16;
#pragma unroll
  for (int i = 0; i < 4; ++i) {
    *(uint4*)(smem + soff + i * 32 * 144) = ra[i];
    *(uint4*)(smem + 18432 + soff + i * 32 * 144) = rb[i];
  }
  __syncthreads();
  f32x16 acc[2][2];
#pragma unroll
  for (int i = 0; i < 2; ++i)
#pragma unroll
    for (int j = 0; j < 2; ++j)
#pragma unroll
      for (int e = 0; e < 16; ++e) acc[i][j][e] = 0.f;
  const int KT = K >> 6;
  const int aoff = (wm * 64 + r) * 144 + h * 16;
  const int boff = 18432 + (wn * 64 + r) * 144 + h * 16;
  for (int kt = 0; kt < KT; ++kt) {
    if (kt + 1 < KT) {
#pragma unroll
      for (int i = 0; i < 4; ++i) {
        ra[i] = *(const uint4*)(ag + (size_t)i * 32 * lda + (kt + 1) * 64);
        rb[i] = *(const uint4*)(bg + (size_t)i * 32 * ldb + (kt + 1) * 64);
      }
    }
    const char* st = smem + (kt & 1) * 36864;
#pragma unroll
    for (int ks = 0; ks < 4; ++ks) {
      bf16x8 a0 = *(const bf16x8*)(st + aoff + ks * 32);
      bf16x8 a1 = *(const bf16x8*)(st + aoff + 32 * 144 + ks * 32);
      bf16x8 b0 = *(const bf16x8*)(st + boff + ks * 32);
      bf16x8 b1 = *(const bf16x8*)(st + boff + 32 * 144 + ks * 32);
      acc[0][0] = MFMA(a0, b0, acc[0][0]);
      acc[0][1] = MFMA(a0, b1, acc[0][1]);
      acc[1][0] = MFMA(a1, b0, acc[1][0]);
      acc[1][1] = MFMA(a1, b1, acc[1][1]);
    }
    if (kt + 1 < KT) {
      char* sn = smem + ((kt + 1) & 1) * 36864;
#pragma unroll
      for (int i = 0; i < 4; ++i) {
        *(uint4*)(sn + soff + i * 32 * 144) = ra[i];
        *(uint4*)(sn + 18432 + soff + i * 32 * 144) = rb[i];
      }
    }
    __syncthreads();
  }
  float* Cs = (float*)smem;
#pragma unroll
  for (int i = 0; i < 2; ++i)
#pragma unroll
    for (int j = 0; j < 2; ++j)
#pragma unroll
      for (int e = 0; e < 16; ++e) {
        int row = wm * 64 + i * 32 + (e & 3) + 8 * (e >> 2) + 4 * h;
        int col = wn * 64 + j * 32 + r;
        Cs[row * 132 + col] = acc[i][j][e];
      }
  __syncthreads();
}

DI void epi_store_bf16(const float* Cs, bf16* __restrict__ dst, int ld, bool sqrelu) {
  const int tid = threadIdx.x;
#pragma unroll
  for (int i = 0; i < 8; ++i) {
    int c = tid + 256 * i;
    int row = c >> 4, cc = (c & 15) * 8;
    float4 v0 = *(const float4*)(Cs + row * 132 + cc);
    float4 v1 = *(const float4*)(Cs + row * 132 + cc + 4);
    if (sqrelu) {
      v0.x = fmaxf(v0.x, 0.f); v0.x *= v0.x; v0.y = fmaxf(v0.y, 0.f); v0.y *= v0.y;
      v0.z = fmaxf(v0.z, 0.f); v0.z *= v0.z; v0.w = fmaxf(v0.w, 0.f); v0.w *= v0.w;
      v1.x = fmaxf(v1.x, 0.f); v1.x *= v1.x; v1.y = fmaxf(v1.y, 0.f); v1.y *= v1.y;
      v1.z = fmaxf(v1.z, 0.f); v1.z *= v1.z; v1.w = fmaxf(v1.w, 0.f); v1.w *= v1.w;
    }
    uint4 o;
    o.x = pack2(v0.x, v0.y); o.y = pack2(v0.z, v0.w); o.z = pack2(v1.x, v1.y); o.w = pack2(v1.z, v1.w);
    *(uint4*)(dst + (size_t)row * ld + cc) = o;
  }
}
DI void epi_store_tr(const float* Cs, bf16* __restrict__ dst, size_t ldc) {
  const int tid = threadIdx.x, col = tid & 127;
#pragma unroll
  for (int i = 0; i < 8; ++i) {
    int pc = (tid >> 7) + 2 * i;
    float v[8];
#pragma unroll
    for (int e = 0; e < 8; ++e) v[e] = Cs[(pc * 8 + e) * 132 + col];
    uint4 o;
    o.x = pack2(v[0], v[1]); o.y = pack2(v[2], v[3]); o.z = pack2(v[4], v[5]); o.w = pack2(v[6], v[7]);
    *(uint4*)(dst + (size_t)col * ldc + pc * 8) = o;
  }
}

DI void gemm1_epilogue(const Params& p, int layer, int m0, int nt, const float* Cs) {
  const int tid = threadIdx.x;
  const bool is_ctx = (m0 >= NLAT);
  const int b = is_ctx ? ((m0 - NLAT) >> 8) : (m0 >> 13);
  const int pos0 = is_ctx ? ((m0 - NLAT) & 255) : (m0 & 8191);
  if (nt < 6) {
    epi_store_bf16(Cs, (bf16*)(p.ws + A_PROJA) + (size_t)m0 * 768 + nt * 128, 768, false);
  } else if (nt < 12) {
    const int ch0 = (nt - 6) * 128;
    if (!is_ctx) epi_store_tr(Cs, (bf16*)(p.ws + A_HYRAW) + ((size_t)(b * 768 + ch0)) * 8192 + pos0, 8192);
    else epi_store_tr(Cs, (bf16*)(p.ws + A_HYRAWC) + ((size_t)(b * 768 + ch0)) * 256 + pos0, 256);
  } else {
    const int g = (nt - 12) >> 2, tt = (nt - 12) & 3;
    const int kpos0 = is_ctx ? (SEQ + pos0) : pos0;
    if (tt == 3) {
      bf16* dst = (bf16*)(p.ws + A_VT) + ((size_t)((g * 4 + b) * 2) * 64) * KEYS + kpos0;
      epi_store_tr(Cs, dst, KEYS);
    } else {
      const int row = tid & 127, hh = tid >> 7;
      float v[64];
#pragma unroll
      for (int d4 = 0; d4 < 16; ++d4) {
        float4 t = *(const float4*)(Cs + row * 132 + hh * 64 + d4 * 4);
        v[d4 * 4] = t.x; v[d4 * 4 + 1] = t.y; v[d4 * 4 + 2] = t.z; v[d4 * 4 + 3] = t.w;
      }
      const bool isq = (tt < 2);
      if (g == 1) {
        const float* wn = (isq ? p.in[30] : p.in[31]) + layer * 64;
        float ss = 0.f;
#pragma unroll
        for (int d = 0; d < 64; ++d) ss += v[d] * v[d];
        const float rstd = rsqrtf(ss * (1.f / 64.f) + EPS);
#pragma unroll
        for (int d = 0; d < 64; ++d) v[d] = v[d] * rstd * wn[d];
      }
      if (!is_ctx) {
        const float2* rp = (const float2*)(p.ws + OFF_ROPE) + (size_t)(pos0 + row) * 32;
#pragma unroll
        for (int i = 0; i < 32; ++i) {
          float2 cs = rp[i];
          float a = v[i], bb = v[i + 32];
          v[i] = a * cs.x - bb * cs.y;
          v[i + 32] = a * cs.y + bb * cs.x;
        }
      }
      bf16* dst;
      if (isq) {
        const int head = tt * 2 + hh;
#pragma unroll
        for (int d = 0; d < 64; ++d) v[d] *= (0.125f * LOG2E);
        dst = (bf16*)(p.ws + A_QB) + ((size_t)((g * 4 + b) * 4 + head) * KEYS + kpos0 + row) * 64;
      } else {
        dst = (bf16*)(p.ws + A_KB) + ((size_t)((g * 4 + b) * 2 + hh) * KEYS + kpos0 + row) * 64;
      }
#pragma unroll
      for (int c = 0; c < 8; ++c) {
        uint4 o;
        o.x = pack2(v[c * 8], v[c * 8 + 1]); o.y = pack2(v[c * 8 + 2], v[c * 8 + 3]);
        o.z = pack2(v[c * 8 + 4], v[c * 8 + 5]); o.w = pack2(v[c * 8 + 6], v[c * 8 + 7]);
        *(uint4*)(dst + c * 8) = o;
      }
    }
  }
}

DI void gemm_phase(const Params& p, int layer, int which, int half, char* smem) {
  const int mrows_all = (which == 1 || layer == 0) ? MROWS : NLAT;
  int mbase = 0, mrows = mrows_all;
  if (which >= 3) { mrows = mrows_all / 2; mbase = half * mrows; }
  const int MT = mrows / 128;
  int NT, K, lda, ldb;
  const bf16 *A, *Bt;
  if (which == 1) { NT = 20; K = 1024; A = (const bf16*)(p.ws + A_HBUF); lda = 1024; Bt = (const bf16*)(p.ws + OFF_WIN) + (size_t)layer * 2560 * 1024; ldb = 1024; }
  else if (which == 2) { NT = 8; K = 1024; A = (const bf16*)(p.ws + A_YMIX); lda = 1024; Bt = (const bf16*)(p.ws + OFF_WOUT) + (size_t)layer * 1024 * 1024; ldb = 1024; }
  else if (which == 3) { NT = 32; K = 1024; A = (const bf16*)(p.ws + A_HBUF) + (size_t)mbase * 1024; lda = 1024; Bt = (const bf16*)(p.ws + OFF_W1) + (size_t)layer * 4096 * 1024; ldb = 1024; }
  else { NT = 8; K = 4096; A = (const bf16*)(p.ws + A_HID); lda = 4096; Bt = (const bf16*)(p.ws + OFF_W2) + (size_t)layer * 1024 * 4096; ldb = 4096; }
  const int ntiles = MT * NT;
  for (int t = blockIdx.x; t < ntiles; t += gridDim.x) {
    const int mt = t / NT, nt = t % NT;
    gemm_tile(A + (size_t)mt * 128 * lda, lda, Bt + (size_t)nt * 128 * ldb, ldb, K, smem);
    const float* Cs = (const float*)smem;
    if (which == 1) gemm1_epilogue(p, layer, mt * 128, nt, Cs);
    else if (which == 2) epi_store_bf16(Cs, (bf16*)(p.ws + A_YOUT) + (size_t)(mt * 128) * 1024 + nt * 128, 1024, false);
    else if (which == 3) epi_store_bf16(Cs, (bf16*)(p.ws + A_HID) + (size_t)(mt * 128) * 4096 + nt * 128, 4096, true);
    else epi_store_bf16(Cs, (bf16*)(p.ws + A_YOUT) + (size_t)(mbase + mt * 128) * 1024 + nt * 128, 1024, false);
    __syncthreads();
  }
}

DI void attn_item(const bf16* __restrict__ Q, const bf16* __restrict__ Kb, const bf16* __restrict__ VT, int q0, int lo, int hi,
                  int nctx_tiles, bool window, bool has_sink, float sink_l2, bf16* __restrict__ out, char* smem) {
  const int tid = threadIdx.x, lane = tid & 63, wave = tid >> 6, r = lane & 31, h = lane >> 5;
  bf16x8 qf[4];
  {
    const bf16* qp = Q + (size_t)(q0 + wave * 32 + r) * 64 + h * 8;
#pragma unroll
    for (int ks = 0; ks < 4; ++ks) qf[ks] = *(const bf16x8*)(qp + ks * 16);
  }
  const int ntl = (hi - lo) >> 6;
  const int nt = ntl + nctx_tiles;
  f32x16 o0, o1;
#pragma unroll
  for (int e = 0; e < 16; ++e) { o0[e] = 0.f; o1[e] = 0.f; }
  float m = has_sink ? sink_l2 : -1e30f;
  float l = (has_sink && h == 0) ? 1.f : 0.f;
  const int qpos = q0 + wave * 32 + r;
  const int c0 = tid, c1 = tid + 256;
  const int lr0 = c0 >> 3, lk0 = c0 & 7, lr1 = c1 >> 3, lk1 = c1 & 7;
  uint4 rk0, rk1, rv0, rv1;
  {
    int key0 = (0 < ntl) ? lo : SEQ;
    rk0 = *(const uint4*)(Kb + (size_t)(key0 + lr0) * 64 + lk0 * 8);
    rk1 = *(const uint4*)(Kb + (size_t)(key0 + lr1) * 64 + lk1 * 8);
    rv0 = *(const uint4*)(VT + (size_t)lr0 * KEYS + key0 + lk0 * 8);
    rv1 = *(const uint4*)(VT + (size_t)lr1 * KEYS + key0 + lk1 * 8);
  }
  *(uint4*)(smem + lr0 * 144 + lk0 * 16) = rk0;
  *(uint4*)(smem + lr1 * 144 + lk1 * 16) = rk1;
  *(uint4*)(smem + 9216 + lr0 * 144 + lk0 * 16) = rv0;
  *(uint4*)(smem + 9216 + lr1 * 144 + lk1 * 16) = rv1;
  __syncthreads();
  for (int ti = 0; ti < nt; ++ti) {
    const int key0 = (ti < ntl) ? (lo + ti * 64) : (SEQ + (ti - ntl) * 64);
    if (ti + 1 < nt) {
      const int kn = (ti + 1 < ntl) ? (lo + (ti + 1) * 64) : (SEQ + (ti + 1 - ntl) * 64);
      rk0 = *(const uint4*)(Kb + (size_t)(kn + lr0) * 64 + lk0 * 8);
      rk1 = *(const uint4*)(Kb + (size_t)(kn + lr1) * 64 + lk1 * 8);
      rv0 = *(const uint4*)(VT + (size_t)lr0 * KEYS + kn + lk0 * 8);
      rv1 = *(const uint4*)(VT + (size_t)lr1 * KEYS + kn + lk1 * 8);
    }
    const char* Ks = smem + (ti & 1) * 18432;
    const char* Vs = Ks + 9216;
    f32x16 s0, s1;
#pragma unroll
    for (int e = 0; e < 16; ++e) { s0[e] = 0.f; s1[e] = 0.f; }
#pragma unroll
    for (int ks = 0; ks < 4; ++ks) {
      bf16x8 a0 = *(const bf16x8*)(Ks + r * 144 + ks * 32 + h * 16);
      bf16x8 a1 = *(const bf16x8*)(Ks + (32 + r) * 144 + ks * 32 + h * 16);
      s0 = MFMA(a0, qf[ks], s0);
      s1 = MFMA(a1, qf[ks], s1);
    }
    if (window && key0 < SEQ) {
#pragma unroll
      for (int e = 0; e < 16; ++e) {
        int kp = key0 + (e & 3) + 8 * (e >> 2) + 4 * h;
        int d0 = qpos - kp; d0 = d0 < 0 ? -d0 : d0;
        int d1 = qpos - (kp + 32); d1 = d1 < 0 ? -d1 : d1;
        if (d0 > 128) s0[e] = -1e30f;
        if (d1 > 128) s1[e] = -1e30f;
      }
    }
    float mx = s0[0];
#pragma unroll
    for (int e = 1; e < 16; ++e) mx = fmaxf(mx, s0[e]);
#pragma unroll
    for (int e = 0; e < 16; ++e) mx = fmaxf(mx, s1[e]);
    mx = fmaxf(mx, __shfl_xor(mx, 32));
    const float mnew = fmaxf(m, mx);
    const float alpha = __builtin_amdgcn_exp2f(m - mnew);
    m = mnew;
    float ls = 0.f;
#pragma unroll
    for (int e = 0; e < 16; ++e) {
      s0[e] = __builtin_amdgcn_exp2f(s0[e] - mnew);
      s1[e] = __builtin_amdgcn_exp2f(s1[e] - mnew);
      ls += s0[e] + s1[e];
    }
    l = l * alpha + ls;
#pragma unroll
    for (int e = 0; e < 16; ++e) { o0[e] *= alpha; o1[e] *= alpha; }
#pragma unroll
    for (int kb = 0; kb < 2; ++kb) {
#pragma unroll
      for (int s2 = 0; s2 < 2; ++s2) {
        unsigned pk[4];
#pragma unroll
        for (int j = 0; j < 4; ++j) {
          float x0 = kb ? s1[8 * s2 + 2 * j] : s0[8 * s2 + 2 * j];
          float x1 = kb ? s1[8 * s2 + 2 * j + 1] : s0[8 * s2 + 2 * j + 1];
          pk[j] = pack2(x0, x1);
        }
        uint4 pku = make_uint4(pk[0], pk[1], pk[2], pk[3]);
        bf16x8 pf = __builtin_bit_cast(bf16x8, pku);
        const char* vb = Vs + r * 144 + (kb * 32 + 16 * s2 + 4 * h) * 2;
        s16x4 lo0 = *(const s16x4*)(vb);
        s16x4 hi0 = *(const s16x4*)(vb + 16);
        s16x4 lo1 = *(const s16x4*)(vb + 32 * 144);
        s16x4 hi1 = *(const s16x4*)(vb + 32 * 144 + 16);
        bf16x8 v0 = __builtin_shufflevector(lo0, hi0, 0, 1, 2, 3, 4, 5, 6, 7);
        bf16x8 v1 = __builtin_shufflevector(lo1, hi1, 0, 1, 2, 3, 4, 5, 6, 7);
        o0 = MFMA(v0, pf, o0);
        o1 = MFMA(v1, pf, o1);
      }
    }
    if (ti + 1 < nt) {
      char* sn = smem + ((ti + 1) & 1) * 18432;
      *(uint4*)(sn + lr0 * 144 + lk0 * 16) = rk0;
      *(uint4*)(sn + lr1 * 144 + lk1 * 16) = rk1;
      *(uint4*)(sn + 9216 + lr0 * 144 + lk0 * 16) = rv0;
      *(uint4*)(sn + 9216 + lr1 * 144 + lk1 * 16) = rv1;
    }
    __syncthreads();
  }
  const float lt = l + __shfl_xor(l, 32);
  const float inv = 1.f / lt;
  bf16* Os = (bf16*)(smem + 36864);
  {
    const int q = wave * 32 + r;
#pragma unroll
    for (int e = 0; e < 16; e += 2) {
      int d = (e & 3) + 8 * (e >> 2) + 4 * h;
      *(unsigned*)(Os + q * 72 + d) = pack2(o0[e] * inv, o0[e + 1] * inv);
      *(unsigned*)(Os + q * 72 + 32 + d) = pack2(o1[e] * inv, o1[e + 1] * inv);
    }
  }
  __syncthreads();
#pragma unroll
  for (int i = 0; i < 4; ++i) {
    int c = tid + 256 * i;
    int row = c >> 3, ch = c & 7;
    *(uint4*)(out + (size_t)row * 1024 + ch * 8) = *(const uint4*)(Os + row * 72 + ch * 8);
  }
  __syncthreads();
}

DI float conv3_at(const bf16* __restrict__ raw, int n, int len, float w0, float w1, float w2, float bb) {
  float a = bb + w1 * bf2f(raw[n]);
  if (n >= 1) a += w0 * bf2f(raw[n - 1]);
  if (n + 1 < len) a += w2 * bf2f(raw[n + 1]);
  return a;
}

DI void hyena_fft_item(const Params& p, int layer, int it, char* smem) {
  const int tid = threadIdx.x;
  const int ch = it & 255, bp = it >> 8, b0 = 2 * bp, b1 = b0 + 1;
  float2* X = (float2*)smem;
  const bf16* hyraw = (const bf16*)(p.ws + A_HYRAW);
  const float* cw = p.in[18] + layer * 3 * 768;
  const float* cb = p.in[19] + layer * 768;
  const float* hb = p.in[28] + layer * 2 * 256;
  const float2* tw8 = (const float2*)(p.ws + OFF_TW8);
  const float2* tw16 = (const float2*)(p.ws + OFF_TW16);
  bf16* ho0 = (bf16*)(p.ws + A_HYOUT) + ((size_t)(b0 * 256 + ch)) * 8192;
  bf16* ho1 = (bf16*)(p.ws + A_HYOUT) + ((size_t)(b1 * 256 + ch)) * 8192;
  float2* escr = (blockIdx.x < 256) ? ((float2*)(p.ws + A_ESCR0) + (size_t)blockIdx.x * 8192)
                                    : ((float2*)(p.ws + A_ESCR1) + (size_t)(blockIdx.x - 256) * 8192);
  const float vw0 = cw[ch], vw1 = cw[768 + ch], vw2 = cw[1536 + ch], vbb = cb[ch];
  const bf16* r0 = hyraw + ((size_t)(b0 * 768 + ch)) * 8192;
  const bf16* r1 = hyraw + ((size_t)(b1 * 768 + ch)) * 8192;
#pragma unroll 1
  for (int o = 0; o < 2; ++o) {
    const float2* Hl = (const float2*)(p.ws + OFF_SPEC) + ((size_t)(layer * 2 + o) * 256 + ch) * SPEC_LD;
#pragma unroll 2
    for (int i = 0; i < 32; ++i) {
      int n = tid + 256 * i;
      float za, zb;
      if (o == 0) { za = conv3_at(r0, n, 8192, vw0, vw1, vw2, vbb); zb = conv3_at(r1, n, 8192, vw0, vw1, vw2, vbb); }
      else { za = bf2f(ho0[n]); zb = bf2f(ho1[n]); }
      X[n] = make_float2(za, zb);
    }
    fft_fwd(X, tw8);
#pragma unroll 2
    for (int i = 0; i < 32; ++i) {
      int j = tid + 256 * i, mI = 2 * brev13(j);
      float2 hv = (mI <= 8192) ? Hl[mI] : Hl[16384 - mI];
      if (mI > 8192) hv.y = -hv.y;
      float2 x = X[j];
      X[j] = make_float2(x.x * hv.x - x.y * hv.y, x.x * hv.y + x.y * hv.x);
    }
    fft_inv(X, tw8);
#pragma unroll 4
    for (int i = 0; i < 32; ++i) escr[tid + 256 * i] = X[tid + 256 * i];
#pragma unroll 2
    for (int i = 0; i < 32; ++i) {
      int n = tid + 256 * i;
      float za, zb;
      if (o == 0) { za = conv3_at(r0, n, 8192, vw0, vw1, vw2, vbb); zb = conv3_at(r1, n, 8192, vw0, vw1, vw2, vbb); }
      else { za = bf2f(ho0[n]); zb = bf2f(ho1[n]); }
      float2 w = tw16[n];
      X[n] = make_float2(za * w.x - zb * w.y, za * w.y + zb * w.x);
    }
    fft_fwd(X, tw8);
#pragma unroll 2
    for (int i = 0; i < 32; ++i) {
      int j = tid + 256 * i, mI = 2 * brev13(j) + 1;
      float2 hv = (mI <= 8192) ? Hl[mI] : Hl[16384 - mI];
      if (mI > 8192) hv.y = -hv.y;
      float2 x = X[j];
      X[j] = make_float2(x.x * hv.x - x.y * hv.y, x.x * hv.y + x.y * hv.x);
    }
    fft_inv(X, tw8);
    {
      const int gc = (o + 1) * 256 + ch;
      const float w0 = cw[gc], w1 = cw[768 + gc], w2 = cw[1536 + gc], bb = cb[gc];
      const bf16* g0p = hyraw + ((size_t)(b0 * 768 + gc)) * 8192;
      const bf16* g1p = hyraw + ((size_t)(b1 * 768 + gc)) * 8192;
      const float bias = hb[o * 256 + ch];
#pragma unroll 2
      for (int i = 0; i < 32; ++i) {
        int n = tid + 256 * i;
        float za, zb;
        if (o == 0) { za = conv3_at(r0, n, 8192, vw0, vw1, vw2, vbb); zb = conv3_at(r1, n, 8192, vw0, vw1, vw2, vbb); }
        else { za = bf2f(ho0[n]); zb = bf2f(ho1[n]); }
        float2 x = X[n];
        float2 w = tw16[n];
        float2 ev = escr[n];
        float cr = (ev.x + x.x * w.x + x.y * w.y) * (1.f / 16384.f);
        float ci = (ev.y + x.y * w.x - x.x * w.y) * (1.f / 16384.f);
        float g0 = conv3_at(g0p, n, 8192, w0, w1, w2, bb);
        float g1 = conv3_at(g1p, n, 8192, w0, w1, w2, bb);
        ho0[n] = f2bf(g0 * (cr + za * bias));
        ho1[n] = f2bf(g1 * (ci + zb * bias));
      }
    }
    __syncthreads();
  }
}

DI void hyena_ctx_item(const Params& p, int layer, int ch, float* lds) {
  const int tid = threadIdx.x;
  float* kf = lds;
  float* kb = lds + 512;
  float* z = lds + 1024;
  const float* part = (const float*)(p.ws + OFF_PART);
  const float* kc = (const float*)(p.ws + OFF_KC);
  const bf16* raw = (const bf16*)(p.ws + A_HYRAWC);
  const float* cw = p.in[18] + layer * 3 * 768;
  const float* cb = p.in[19] + layer * 768;
  const float* hb = p.in[28] + layer * 2 * 256;
  for (int o = 0; o < 2; ++o) {
    float s = 0.f;
    for (int t = 0; t < 8; ++t) s += part[((size_t)2 * 256 + t) * 1024 + o * 512 + ch] + part[((size_t)2 * 256 + t) * 1024 + o * 512 + 256 + ch];
    float sc = rsqrtf(s + EPS);
    kf[o * 256 + tid] = kc[(size_t)(o * 512 + ch) * 256 + tid] * sc;
    kb[o * 256 + tid] = kc[(size_t)(o * 512 + 256 + ch) * 256 + tid] * sc;
  }
  {
    const float w0 = cw[ch], w1 = cw[768 + ch], w2 = cw[1536 + ch], bb = cb[ch];
    for (int b = 0; b < 4; ++b) z[b * 256 + tid] = conv3_at(raw + ((size_t)(b * 768 + ch)) * 256, tid, 256, w0, w1, w2, bb);
  }
  __syncthreads();
  for (int o = 0; o < 2; ++o) {
    const int gc = (o + 1) * 256 + ch;
    const float w0 = cw[gc], w1 = cw[768 + gc], w2 = cw[1536 + gc], bb = cb[gc];
    const float bias = hb[o * 256 + ch];
    float zn[4];
    for (int b = 0; b < 4; ++b) {
      float y = 0.f;
      for (int j = 0; j <= tid; ++j) y += kf[o * 256 + tid - j] * z[b * 256 + j];
      for (int j = tid + 1; j < 256; ++j) y += kb[o * 256 + j - tid] * z[b * 256 + j];
      float g = conv3_at(raw + ((size_t)(b * 768 + gc)) * 256, tid, 256, w0, w1, w2, bb);
      zn[b] = g * (y + z[b * 256 + tid] * bias);
    }
    __syncthreads();
    for (int b = 0; b < 4; ++b) z[b * 256 + tid] = zn[b];
    __syncthreads();
  }
  bf16* ymix = (bf16*)(p.ws + A_YMIX);
  for (int b = 0; b < 4; ++b) ymix[((size_t)(NLAT + b * 256 + tid)) * 1024 + 256 + ch] = f2bf(z[b * 256 + tid]);
  __syncthreads();
}

DI void hyena_tr_item(const Params& p, int it, char* smem) {
  const int tid = threadIdx.x;
  const int b = it >> 9, ct = (it >> 7) & 3, ntile = it & 127;
  bf16* t = (bf16*)smem;
  const bf16* src = (const bf16*)(p.ws + A_HYOUT) + ((size_t)(b * 256 + ct * 64)) * 8192 + ntile * 64;
  {
    const int nx = tid & 63, cy = tid >> 6;
#pragma unroll
    for (int i = 0; i < 16; ++i) { int c = cy + 4 * i; t[c * 66 + nx] = src[(size_t)c * 8192 + nx]; }
  }
  __syncthreads();
  {
    const int cx = tid & 63, ny = tid >> 6;
    bf16* dst = (bf16*)(p.ws + A_YMIX) + ((size_t)(b * 8192 + ntile * 64)) * 1024 + 256 + ct * 64;
#pragma unroll
    for (int i = 0; i < 16; ++i) { int n = ny + 4 * i; dst[(size_t)n * 1024 + cx] = t[cx * 66 + n]; }
  }
  __syncthreads();
}

constexpr int TLD = 68;
constexpr int TSZ = 64 * TLD;

DI void ssd_tile_load(float* dst, bool transposed, const bf16* __restrict__ projA, int rowbase, int seqlen, int s0, bool rev,
                      int cofs, const float* __restrict__ cw, const float* __restrict__ cb) {
  const int tid = threadIdx.x, c = tid & 63, ii = tid >> 6;
  const float w0 = cw[cofs + c], w1 = cw[512 + cofs + c], w2 = cw[1024 + cofs + c], w3 = cw[1536 + cofs + c], w4 = cw[2048 + cofs + c];
  const float bb = cb[cofs + c];
  const bf16* base = projA + 256 + cofs + c;
#pragma unroll 4
  for (int q = 0; q < 16; ++q) {
    const int i = ii + 4 * q;
    const int t = rev ? (s0 + 63 - i) : (s0 + i);
    float acc = bb;
    if (t - 2 >= 0) acc += w0 * bf2f(base[(size_t)(rowbase + t - 2) * 768]);
    if (t - 1 >= 0) acc += w1 * bf2f(base[(size_t)(rowbase + t - 1) * 768]);
    acc += w2 * bf2f(base[(size_t)(rowbase + t) * 768]);
    if (t + 1 < seqlen) acc += w3 * bf2f(base[(size_t)(rowbase + t + 1) * 768]);
    if (t + 2 < seqlen) acc += w4 * bf2f(base[(size_t)(rowbase + t + 2) * 768]);
    const float v = silu_f(acc);
    if (transposed) dst[c * TLD + i] = v; else dst[i * TLD + c] = v;
  }
}

DI void ssd_dt(float* dtv, float* acum, const float* __restrict__ dtraw, int rowbase, int s0, bool rev, int dh, float bias, float a_h) {
  const int tid = threadIdx.x;
  if (tid < 64) {
    const int t = rev ? (s0 + 63 - tid) : (s0 + tid);
    float x = dtraw[(size_t)(rowbase + t) * 8 + dh] + bias;
    float dt = (x > 20.f) ? x : log1pf(expf(x));
    dtv[tid] = dt;
    float v = dt * a_h;
#pragma unroll
    for (int off = 1; off < 64; off <<= 1) {
      float u = __shfl_up(v, off);
      if (tid >= off) v += u;
    }
    acum[tid] = v;
  }
}

struct SsdItem { int b, dir, head, o, rowbase, seqlen, s0, seq; };
DI SsdItem ssd_decode(int it) {
  SsdItem s;
  s.seq = it / NORD; s.o = it % NORD;
  s.b = s.seq >> 3; s.dir = (s.seq >> 2) & 1; s.head = s.seq & 3;
  if (s.o < 4) { int c = s.dir ? (3 - s.o) : s.o; s.rowbase = NLAT + s.b * 256; s.seqlen = 256; s.s0 = c * 64; }
  else { int c = s.dir ? (127 - (s.o - 4)) : (s.o - 4); s.rowbase = s.b * 8192; s.seqlen = 8192; s.s0 = c * 64; }
  return s;
}

DI void ssd_s1_item(const Params& p, int layer, int it, float* lds) {
  const int tid = threadIdx.x;
  const SsdItem s = ssd_decode(it);
  float* Xs = lds;
  float* Bs = lds + TSZ;
  float* dtv = lds + 4 * TSZ;
  float* acum = dtv + 64;
  float* wj = acum + 64;
  const bf16* projA = (const bf16*)(p.ws + A_PROJA);
  const float* cw = p.in[12] + layer * 5 * 512;
  const float* cb = p.in[13] + layer * 512;
  const float a_h = -expf(p.in[14][layer * 8 + s.dir * 4 + s.head]);
  const float bias = p.in[15][layer * 8 + s.dir * 4 + s.head];
  ssd_tile_load(Xs, false, projA, s.rowbase, s.seqlen, s.s0, s.dir, s.head * 64, cw, cb);
  ssd_tile_load(Bs, false, projA, s.rowbase, s.seqlen, s.s0, s.dir, 256 + (s.head >> 1) * 64, cw, cb);
  ssd_dt(dtv, acum, (const float*)(p.ws + OFF_DT), s.rowbase, s.s0, s.dir, s.dir * 4 + s.head, bias, a_h);
  __syncthreads();
  if (tid < 64) wj[tid] = expf(acum[63] - acum[tid]) * dtv[tid];
  __syncthreads();
  const int tp = tid >> 4, tn = tid & 15;
  float acc[4][4];
#pragma unroll
  for (int a = 0; a < 4; ++a)
#pragma unroll
    for (int c = 0; c < 4; ++c) acc[a][c] = 0.f;
#pragma unroll 4
  for (int j = 0; j < 64; ++j) {
    const float w = wj[j];
    float4 xv = *(const float4*)(Xs + j * TLD + tp * 4);
    float4 bv = *(const float4*)(Bs + j * TLD + tn * 4);
    float xa[4] = {xv.x * w, xv.y * w, xv.z * w, xv.w * w};
    float ba[4] = {bv.x, bv.y, bv.z, bv.w};
#pragma unroll
    for (int a = 0; a < 4; ++a)
#pragma unroll
      for (int c = 0; c < 4; ++c) acc[a][c] += xa[a] * ba[c];
  }
  float* st = (float*)(p.ws + A_STATES) + ((size_t)s.seq * NORD + s.o) * 4096;
#pragma unroll
  for (int c = 0; c < 4; ++c) *(float4*)(st + (tn * 4 + c) * 64 + tp * 4) = make_float4(acc[0][c], acc[1][c], acc[2][c], acc[3][c]);
  if (tid == 0) ((float*)(p.ws + OFF_DEC))[s.seq * NORD + s.o] = expf(acum[63]);
  __syncthreads();
}

DI void ssd_scan_item(const Params& p, int it) {
  const int g = it * 256 + threadIdx.x;
  const int seq = g >> 12, e = g & 4095;
  float* st = (float*)(p.ws + A_STATES) + (size_t)seq * NORD * 4096 + e;
  const float* dec = (const float*)(p.ws + OFF_DEC) + seq * NORD;
  float hcur = 0.f;
#pragma unroll 4
  for (int o = 0; o < NORD; ++o) {
    float sv = st[(size_t)o * 4096];
    st[(size_t)o * 4096] = hcur;
    hcur = dec[o] * hcur + sv;
  }
}

DI void ssd_s3_item(const Params& p, int layer, int it, float* lds) {
  const int tid = threadIdx.x;
  const SsdItem s = ssd_decode(it);
  if (layer == 1 && s.o < 4) return;
  float* T0 = lds;
  float* T1 = lds + TSZ;
  float* T2 = lds + 2 * TSZ;
  float* T3 = lds + 3 * TSZ;
  float* dtv = lds + 4 * TSZ;
  float* acum = dtv + 64;
  const bf16* projA = (const bf16*)(p.ws + A_PROJA);
  const float* cw = p.in[12] + layer * 5 * 512;
  const float* cb = p.in[13] + layer * 512;
  const float a_h = -expf(p.in[14][layer * 8 + s.dir * 4 + s.head]);
  const float bias = p.in[15][layer * 8 + s.dir * 4 + s.head];
  ssd_tile_load(T0, false, projA, s.rowbase, s.seqlen, s.s0, s.dir, 384 + (s.head >> 1) * 64, cw, cb);
  ssd_tile_load(T1, true, projA, s.rowbase, s.seqlen, s.s0, s.dir, 256 + (s.head >> 1) * 64, cw, cb);
  ssd_tile_load(T3, false, projA, s.rowbase, s.seqlen, s.s0, s.dir, s.head * 64, cw, cb);
  ssd_dt(dtv, acum, (const float*)(p.ws + OFF_DT), s.rowbase, s.s0, s.dir, s.dir * 4 + s.head, bias, a_h);
  __syncthreads();
  const int ti = tid >> 4, tj = tid & 15;
  {
    float acc[4][4];
#pragma unroll
    for (int a = 0; a < 4; ++a)
#pragma unroll
      for (int c = 0; c < 4; ++c) acc[a][c] = 0.f;
#pragma unroll 4
    for (int n = 0; n < 64; ++n) {
      float ca[4];
#pragma unroll
      for (int a = 0; a < 4; ++a) ca[a] = T0[(ti * 4 + a) * TLD + n];
      float4 bv = *(const float4*)(T1 + n * TLD + tj * 4);
      float ba[4] = {bv.x, bv.y, bv.z, bv.w};
#pragma unroll
      for (int a = 0; a < 4; ++a)
#pragma unroll
        for (int c = 0; c < 4; ++c) acc[a][c] += ca[a] * ba[c];
    }
#pragma unroll
    for (int a = 0; a < 4; ++a) {
      const int i = ti * 4 + a;
      float o4[4];
#pragma unroll
      for (int c = 0; c < 4; ++c) {
        const int j = tj * 4 + c;
        o4[c] = (j <= i) ? acc[a][c] * expf(acum[i] - acum[j]) * dtv[j] : 0.f;
      }
      *(float4*)(T2 + i * TLD + tj * 4) = make_float4(o4[0], o4[1], o4[2], o4[3]);
    }
  }
  __syncthreads();
  {
    const float* st = (const float*)(p.ws + A_STATES) + ((size_t)s.seq * NORD + s.o) * 4096;
#pragma unroll
    for (int q = 0; q < 4; ++q) {
      int e4 = tid + 256 * q;
      int n = e4 >> 4, p4 = (e4 & 15) * 4;
      *(float4*)(T1 + n * TLD + p4) = *(const float4*)(st + n * 64 + p4);
    }
  }
  __syncthreads();
  {
    const int tp = tj;
    float acc1[4][4], acc2[4][4];
#pragma unroll
    for (int a = 0; a < 4; ++a)
#pragma unroll
      for (int c = 0; c < 4; ++c) { acc1[a][c] = 0.f; acc2[a][c] = 0.f; }
#pragma unroll 4
    for (int j = 0; j < 64; ++j) {
      float sa[4], ca[4];
#pragma unroll
      for (int a = 0; a < 4; ++a) { sa[a] = T2[(ti * 4 + a) * TLD + j]; ca[a] = T0[(ti * 4 + a) * TLD + j]; }
      float4 xv = *(const float4*)(T3 + j * TLD + tp * 4);
      float4 hv = *(const float4*)(T1 + j * TLD + tp * 4);
      float xa[4] = {xv.x, xv.y, xv.z, xv.w};
      float ha[4] = {hv.x, hv.y, hv.z, hv.w};
#pragma unroll
      for (int a = 0; a < 4; ++a)
#pragma unroll
        for (int c = 0; c < 4; ++c) { acc1[a][c] += sa[a] * xa[c]; acc2[a][c] += ca[a] * ha[c]; }
    }
    float* yssd = (float*)(p.ws + A_YSSD);
#pragma unroll
    for (int a = 0; a < 4; ++a) {
      const int i = ti * 4 + a;
      const float ei = expf(acum[i]);
      const int t = s.dir ? (s.s0 + 63 - i) : (s.s0 + i);
      float* yr = yssd + (size_t)(s.rowbase + t) * 256 + s.head * 64 + tp * 4;
#pragma unroll
      for (int c = 0; c < 4; ++c) atomicAdd(yr + c, acc1[a][c] + ei * acc2[a][c]);
    }
  }
  __syncthreads();
}

DI void ssd_gate_phase(const Params& p, int layer) {
  const int lane = threadIdx.x & 63, wave = threadIdx.x >> 6;
  const int nrows = (layer == 0) ? MROWS : NLAT;
  const bf16* projA = (const bf16*)(p.ws + A_PROJA);
  const float* yssd = (const float*)(p.ws + A_YSSD);
  const float* cw = p.in[12] + layer * 5 * 512;
  const float* cb = p.in[13] + layer * 512;
  const float dsk = p.in[16][layer * 4 + (lane >> 4)];
  const float* ng = p.in[17] + layer * 256;
  bf16* ymix = (bf16*)(p.ws + A_YMIX);
  for (int r4 = blockIdx.x; r4 * 4 < nrows; r4 += gridDim.x) {
    const int row = r4 * 4 + wave;
    if (row >= nrows) continue;
    int t, seqlen;
    if (row < NLAT) { t = row & 8191; seqlen = 8192; } else { t = (row - NLAT) & 255; seqlen = 256; }
    const int c0 = lane * 4;
    float xs[4];
#pragma unroll
    for (int e = 0; e < 4; ++e) xs[e] = cb[c0 + e];
#pragma unroll
    for (int k = 0; k < 5; ++k) {
      int tt = t + k - 2;
      if (tt >= 0 && tt < seqlen) {
        uint2 rv = *(const uint2*)(projA + (size_t)(row + k - 2) * 768 + 256 + c0);
        float4 w = *(const float4*)(cw + k * 512 + c0);
        xs[0] += w.x * __uint_as_float(rv.x << 16);
        xs[1] += w.y * __uint_as_float(rv.x & 0xffff0000u);
        xs[2] += w.z * __uint_as_float(rv.y << 16);
        xs[3] += w.w * __uint_as_float(rv.y & 0xffff0000u);
      }
    }
    float4 yv = *(const float4*)(yssd + (size_t)row * 256 + c0);
    uint2 zv = *(const uint2*)(projA + (size_t)row * 768 + c0);
    float z[4] = {__uint_as_float(zv.x << 16), __uint_as_float(zv.x & 0xffff0000u), __uint_as_float(zv.y << 16), __uint_as_float(zv.y & 0xffff0000u)};
    float y[4] = {yv.x, yv.y, yv.z, yv.w};
    float g[4];
    float ss = 0.f;
#pragma unroll
    for (int e = 0; e < 4; ++e) {
      float yy = y[e] + dsk * silu_f(xs[e]);
      g[e] = yy * silu_f(z[e]);
      ss += g[e] * g[e];
    }
    ss = wave_sum(ss);
    const float rstd = rsqrtf(ss * (1.f / 256.f) + EPS);
    float4 gw = *(const float4*)(ng + c0);
    uint2 o;
    o.x = pack2(g[0] * rstd * gw.x, g[1] * rstd * gw.y);
    o.y = pack2(g[2] * rstd * gw.z, g[3] * rstd * gw.w);
    *(uint2*)(ymix + (size_t)row * 1024 + c0) = o;
  }
}

DI void phase_pro0(const Params& p, char* smem) {
  float* lds = (float*)smem;
  const int tid = threadIdx.x;
  constexpr int N_W = 5888, N_MOD = 192, N_F1 = 520, N_ROPE = 1024, N_TW = 48;
  constexpr int TOTAL = N_W + N_MOD + N_F1 + N_ROPE + N_TW;
  for (int it = blockIdx.x; it < TOTAL; it += gridDim.x) {
    if (it < N_W) {
      if (it < 1280) {
        int layer = it / 640, r = it % 640, kt = r / 40, nt = r % 40;
        conv_tr_tile(p.in[10] + (size_t)layer * 1024 * 2568, 2568, kt * 64, nt * 64, 8, (bf16*)(p.ws + OFF_WIN) + (size_t)layer * 2560 * 1024, 1024, lds);
      } else if (it < 1792) {
        int r = it - 1280, layer = r / 256; r %= 256; int kt = r / 16, nt = r % 16;
        conv_tr_tile(p.in[11] + (size_t)layer * 1024 * 1024, 1024, kt * 64, nt * 64, 0, (bf16*)(p.ws + OFF_WOUT) + (size_t)layer * 1024 * 1024, 1024, lds);
      } else if (it < 3840) {
        int r = it - 1792, layer = r / 1024; r %= 1024; int kt = r / 64, nt = r % 64;
        conv_tr_tile(p.in[32] + (size_t)layer * 1024 * 4096, 4096, kt * 64, nt * 64, 0, (bf16*)(p.ws + OFF_W1) + (size_t)layer * 4096 * 1024, 1024, lds);
      } else {
        int r = it - 3840, layer = r / 1024; r %= 1024; int kt = r / 16, nt = r % 16;
        conv_tr_tile(p.in[33] + (size_t)layer * 4096 * 1024, 1024, kt * 64, nt * 64, 0, (bf16*)(p.ws + OFF_W2) + (size_t)layer * 1024 * 4096, 4096, lds);
      }
    } else if (it < N_W + N_MOD) {
      mod_item(p, it - N_W, lds);
    } else if (it < N_W + N_MOD + N_F1) {
      int r = it - N_W - N_MOD;
      int fid = (r < 256) ? 0 : (r < 512 ? 1 : 2);
      int tile = (r < 512) ? (r & 255) : (r - 512);
      filt_f1(p, fid, tile, lds);
    } else if (it < N_W + N_MOD + N_F1 + N_ROPE) {
      int idx = (it - N_W - N_MOD - N_F1) * 256 + tid;
      int pos = idx >> 5, i = idx & 31, fi = i & 15;
      float inv = powf(10000.f, -(float)fi / 16.f);
      int coord = (i < 16) ? (pos >> 6) : (pos & 63);
      float ang = (float)coord * inv;
      ((float2*)(p.ws + OFF_ROPE))[idx] = make_float2(cosf(ang), sinf(ang));
    } else {
      int idx = (it - N_W - N_MOD - N_F1 - N_ROPE) * 256 + tid;
      if (idx < 4096) ((float2*)(p.ws + OFF_TW8))[idx] = make_float2(cospif((float)idx / 4096.f), -sinpif((float)idx / 4096.f));
      else { int j = idx - 4096; ((float2*)(p.ws + OFF_TW16))[j] = make_float2(cospif((float)j / 8192.f), -sinpif((float)j / 8192.f)); }
    }
  }
}

DI void phase_pro1(const Params& p, char* smem) {
  for (int it = blockIdx.x; it < 1024; it += gridDim.x) filt_f2(p, it, smem);
  rowpass_phase(p, 0, 0);
}

DI void phase_mix1(const Params& p, int layer, char* smem) {
  const int tid = threadIdx.x;
  const int N_DENSE = 1024, N_FFT = 512, N_WIN = 1024, N_S1 = 32 * NORD, N_ZERO = 528;
  const int N_CH = (layer == 0) ? 256 : 0, N_CA = (layer == 0) ? 64 : 0;
  const int total = N_DENSE + N_FFT + N_WIN + N_S1 + N_ZERO + N_CH + N_CA;
  const bf16* QB = (const bf16*)(p.ws + A_QB);
  const bf16* KB = (const bf16*)(p.ws + A_KB);
  const bf16* VT = (const bf16*)(p.ws + A_VT);
  bf16* ymix = (bf16*)(p.ws + A_YMIX);
  for (int it = blockIdx.x; it < total; it += gridDim.x) {
    int r = it;
    int akind = -1, ar_ = 0;
    if (r < N_DENSE) { akind = 0; ar_ = r; }
    else if (r >= N_DENSE + N_FFT && r < N_DENSE + N_FFT + N_WIN) { akind = 1; ar_ = r - N_DENSE - N_FFT; }
    else if (r >= total - N_CA) { akind = 2; ar_ = r - (total - N_CA); }
    if (akind >= 0) {
      int g, b, head, q0, lo, hi, orow, ocol;
      bool window = false, has_sink = false;
      if (akind == 0) {
        g = 1; b = ar_ >> 8; head = (ar_ >> 6) & 3; q0 = (ar_ & 63) * 128; lo = 0; hi = SEQ; orow = b * 8192 + q0; ocol = 768;
      } else if (akind == 1) {
        g = 0; b = ar_ >> 8; head = (ar_ >> 6) & 3; q0 = (ar_ & 63) * 128;
        lo = (q0 - 128 < 0) ? 0 : (q0 - 128); hi = (q0 + 256 > SEQ) ? SEQ : (q0 + 256);
        window = true; has_sink = true; orow = b * 8192 + q0; ocol = 512;
      } else {
        g = ar_ >> 5; b = (ar_ >> 3) & 3; head = (ar_ >> 1) & 3; const int qt = ar_ & 1;
        q0 = SEQ + qt * 128; lo = 0; hi = 0; has_sink = (g == 0); orow = NLAT + b * 256 + qt * 128; ocol = (g == 0) ? 512 : 768;
      }
      attn_item(QB + ((size_t)((g * 4 + b) * 4 + head)) * KEYS * 64, KB + ((size_t)((g * 4 + b) * 2 + (head >> 1))) * KEYS * 64,
                VT + ((size_t)((g * 4 + b) * 2 + (head >> 1))) * 64 * KEYS, q0, lo, hi, 4, window, has_sink,
                p.in[29][layer * 4 + head] * LOG2E, ymix + (size_t)orow * 1024 + ocol + head * 64, smem);
      continue;
    }
    r -= N_DENSE;
    if (r < N_FFT) { hyena_fft_item(p, layer, r, smem); continue; }
    r -= N_FFT + N_WIN;
    if (r < N_S1) { ssd_s1_item(p, layer, r, (float*)smem); continue; }
    r -= N_S1;
    if (r < N_ZERO) {
      float4* y = (float4*)(p.ws + A_YSSD) + (size_t)r * 4096;
#pragma unroll
      for (int i = 0; i < 16; ++i) y[tid + 256 * i] = make_float4(0.f, 0.f, 0.f, 0.f);
      continue;
    }
    r -= N_ZERO;
    hyena_ctx_item(p, layer, r, (float*)smem);
  }
}

DI void phase_mix2(const Params& p, int layer, char* smem) {
  const int total = 512 + 2048;
  for (int it = blockIdx.x; it < total; it += gridDim.x) {
    if (it < 512) ssd_scan_item(p, it);
    else hyena_tr_item(p, it - 512, smem);
  }
}

DI void phase_mix3(const Params& p, int layer, char* smem) {
  for (int it = blockIdx.x; it < 32 * NORD; it += gridDim.x) ssd_s3_item(p, layer, it, (float*)smem);
}

template <int K>
DI void run_phase_k(const Params& p, int layer, char* smem) {
  if (K == -2) phase_pro0(p, smem);
  else if (K == -1) phase_pro1(p, smem);
  else if (K == 0) gemm_phase(p, layer, 1, 0, smem);
  else if (K == 1) phase_mix1(p, layer, smem);
  else if (K == 2) phase_mix2(p, layer, smem);
  else if (K == 3) phase_mix3(p, layer, smem);
  else if (K == 4) ssd_gate_phase(p, layer);
  else if (K == 5) gemm_phase(p, layer, 2, 0, smem);
  else if (K == 6) rowpass_phase(p, layer, 1);
  else if (K == 7) gemm_phase(p, layer, 3, 0, smem);
  else if (K == 8) gemm_phase(p, layer, 4, 0, smem);
  else if (K == 9) gemm_phase(p, layer, 3, 1, smem);
  else if (K == 10) gemm_phase(p, layer, 4, 1, smem);
  else rowpass_phase(p, layer, 2);
}
DI void run_phase(const Params& p, int ph, char* smem) {
  if (ph == 0) { run_phase_k<-2>(p, 0, smem); return; }
  if (ph == 1) { run_phase_k<-1>(p, 0, smem); return; }
  const int layer = (ph - 2) / 12, k = (ph - 2) % 12;
  switch (k) {
    case 0: run_phase_k<0>(p, layer, smem); break;
    case 1: run_phase_k<1>(p, layer, smem); break;
    case 2: run_phase_k<2>(p, layer, smem); break;
    case 3: run_phase_k<3>(p, layer, smem); break;
    case 4: run_phase_k<4>(p, layer, smem); break;
    case 5: run_phase_k<5>(p, layer, smem); break;
    case 6: run_phase_k<6>(p, layer, smem); break;
    case 7: run_phase_k<7>(p, layer, smem); break;
    case 8: run_phase_k<8>(p, layer, smem); break;
    case 9: run_phase_k<9>(p, layer, smem); break;
    case 10: run_phase_k<10>(p, layer, smem); break;
    default: run_phase_k<11>(p, layer, smem); break;
  }
}

constexpr int N_PHASES = 2 + 2 * 12;

#if ONE_LAUNCH
__global__ void __launch_bounds__(256, 2) fwd_megakernel(Params p) {
  __shared__ __attribute__((aligned(16))) char smem[SMEM_BYTES];
  for (int ph = p.ph0; ph < p.ph1; ++ph) {
    run_phase(p, ph, smem);
    if (ph + 1 < p.ph1) cg::this_grid().sync();
  }
}
#else
template <int K>
__global__ void __launch_bounds__(256, 2) phase_kernel(Params p) {
  __shared__ __attribute__((aligned(16))) char smem[SMEM_BYTES];
  run_phase_k<K>(p, p.ph0, smem);
}
template <int K>
static void launch_phase(Params p, int layer, int grid, hipStream_t stream) {
  p.ph0 = layer; p.ph1 = layer + 1;
  hipLaunchKernelGGL(phase_kernel<K>, dim3(grid), dim3(256), 0, stream, p);
}
#endif

extern "C" void kernel_launch(void* const* d_in, const int* in_sizes, int n_in, void* d_out, int out_size, void* d_ws,
                              size_t ws_size, hipStream_t stream) {
  static int grid_blocks = 0;
  if (!grid_blocks) {
    int dev = 0, cus = 0, per_cu = 0;
    (void)hipGetDevice(&dev);
    (void)hipDeviceGetAttribute(&cus, hipDeviceAttributeMultiprocessorCount, dev);
#if ONE_LAUNCH
    (void)hipOccupancyMaxActiveBlocksPerMultiprocessor(&per_cu, fwd_megakernel, 256, 0);
#else
    per_cu = 2;
#endif
    if (per_cu < 1) per_cu = 1;
    if (per_cu > 2) per_cu = 2;
    grid_blocks = cus * per_cu;
  }
  Params p{};
  for (int i = 0; i < 34; ++i) p.in[i] = (const float*)d_in[i];
  p.out = (float*)d_out;
  p.ws = (char*)d_ws;
  p.pad = 0;
  if (ws_size < WS_TOTAL) { fprintf(stderr, "workspace too small: %zu < %zu\n", ws_size, (size_t)WS_TOTAL); return; }
#if ONE_LAUNCH
  p.ph0 = 0; p.ph1 = N_PHASES; p.coop = 1;
  void* args[] = {&p};
  hipError_t e = hipLaunchCooperativeKernel((void*)fwd_megakernel, dim3(grid_blocks), dim3(256), args, 0, stream);
  if (e != hipSuccess) fprintf(stderr, "cooperative launch failed: %s (grid %d)\n", hipGetErrorString(e), grid_blocks);
#else
  p.coop = 0;
  launch_phase<-2>(p, 0, grid_blocks, stream);
  launch_phase<-1>(p, 0, grid_blocks, stream);
  for (int layer = 0; layer < 2; ++layer) {
    launch_phase<0>(p, layer, grid_blocks, stream);
    launch_phase<1>(p, layer, grid_blocks, stream);
    launch_phase<2>(p, layer, grid_blocks, stream);
    launch_phase<3>(p, layer, grid_blocks, stream);
    launch_phase<4>(p, layer, grid_blocks, stream);
    launch_phase<5>(p, layer, grid_blocks, stream);
    launch_phase<6>(p, layer, grid_blocks, stream);
    launch_phase<7>(p, layer, grid_blocks, stream);
    launch_phase<8>(p, layer, grid_blocks, stream);
    launch_phase<9>(p, layer, grid_blocks, stream);
    launch_phase<10>(p, layer, grid_blocks, stream);
    launch_phase<11>(p, layer, grid_blocks, stream);
  }
#endif
}
```

```cpp
#include <hip/hip_runtime.h>
#include <hip/hip_cooperative_groups.h>
#include <stdint.h>
#include <stdio.h>
namespace cg = cooperative_groups;

#ifndef ONE_LAUNCH
#define ONE_LAUNCH 1
#endif

typedef unsigned short bf16;
typedef short bf16x8 __attribute__((ext_vector_type(8)));
typedef unsigned u32x4 __attribute__((ext_vector_type(4)));
typedef short s16x4 __attribute__((ext_vector_type(4)));
typedef float f32x16 __attribute__((ext_vector_type(16)));
typedef __bf16 bfv2 __attribute__((ext_vector_type(2)));
typedef float fv2 __attribute__((ext_vector_type(2)));
typedef float v2f __attribute__((ext_vector_type(2)));
typedef float f32x4 __attribute__((ext_vector_type(4)));
typedef unsigned u32x2 __attribute__((ext_vector_type(2)));

#define DI __device__ __forceinline__
#define MFMA(a, b, c) __builtin_amdgcn_mfma_f32_32x32x16_bf16((a), (b), (c), 0, 0, 0)

DI int otid() { int t = (int)__builtin_amdgcn_workitem_id_x(); asm volatile("" : "+v"(t)); return t; }
DI float bf2f(bf16 b) { return __uint_as_float(((unsigned)b) << 16); }
DI unsigned pack2(float a, float b) { fv2 v = {a, b}; return __builtin_bit_cast(unsigned, __builtin_convertvector(v, bfv2)); }
DI bf16 f2bf(float a) { return (bf16)(pack2(a, 0.f) & 0xffffu); }
DI float fexp(float x) { return __builtin_amdgcn_exp2f(x * 1.4426950408889634f); }
DI float silu_f(float x) { return x * __builtin_amdgcn_rcpf(1.f + fexp(-x)); }

constexpr int NB = 4, SEQ = 8192, CTXL = 256, NLAT = NB * SEQ, NCTX = NB * CTXL, MROWS = NLAT + NCTX;
constexpr int KEYS = SEQ + CTXL;
constexpr float EPS = 1e-6f;
constexpr float LOG2E = 1.4426950408889634f;
constexpr int NORD = 132;
constexpr int SPEC_LD = 8200;

constexpr size_t OFF_WIN = 0;
constexpr size_t OFF_WOUT = OFF_WIN + (size_t)2 * 2560 * 1024 * 2;
constexpr size_t OFF_W1 = OFF_WOUT + (size_t)2 * 1024 * 1024 * 2;
constexpr size_t OFF_W2 = OFF_W1 + (size_t)2 * 4096 * 1024 * 2;
constexpr size_t OFF_SPEC = OFF_W2 + (size_t)2 * 4096 * 1024 * 2;
constexpr size_t OFF_KC = OFF_SPEC + (size_t)2 * 2 * 256 * SPEC_LD * 8;
constexpr size_t OFF_PART = OFF_KC + (size_t)1024 * 256 * 4;
constexpr size_t OFF_ROPE = OFF_PART + (size_t)3 * 256 * 1024 * 4;
constexpr size_t OFF_TW8 = OFF_ROPE + (size_t)8192 * 32 * 8;
constexpr size_t OFF_TW16 = OFF_TW8 + 4096 * 8;
constexpr size_t OFF_MOD = OFF_TW16 + 8192 * 8;
constexpr size_t OFF_DT = OFF_MOD + (size_t)2 * 5 * 6144 * 4;
constexpr size_t OFF_DEC = OFF_DT + (size_t)MROWS * 8 * 4;
constexpr size_t OFF_BAR = OFF_DEC + 32 * NORD * 4 + 256;
constexpr size_t OFF_CTXS = OFF_BAR + 16384;
constexpr size_t OFF_ARENA = ((OFF_CTXS + (size_t)1024 * 1024 * 4 + 4095) / 4096) * 4096;
constexpr size_t SZ_H = (size_t)MROWS * 1024 * 2;
constexpr size_t A_HBUF = OFF_ARENA;
constexpr size_t A_YOUT = A_HBUF + SZ_H;
constexpr size_t A_PROJ = A_YOUT + SZ_H;
constexpr size_t A_PROJA = A_PROJ;
constexpr size_t A_HYRAW = A_PROJA + (size_t)MROWS * 768 * 2;
constexpr size_t A_HYRAWC = A_HYRAW + (size_t)4 * 768 * 8192 * 2;
constexpr size_t A_QB = A_HYRAWC + (size_t)4 * 768 * 256 * 2;
constexpr size_t A_KB = A_QB + (size_t)2 * 4 * 4 * KEYS * 64 * 2;
constexpr size_t A_VT = A_KB + (size_t)2 * 4 * 2 * KEYS * 64 * 2;
constexpr size_t A_PROJ_END = A_VT + (size_t)2 * 4 * 2 * KEYS * 64 * 2;
constexpr size_t A_YMIX = A_PROJ_END;
constexpr size_t WS_END = A_YMIX + SZ_H;
constexpr size_t A_HID = A_PROJ;
constexpr size_t A_KRAW = A_PROJ;
constexpr size_t A_STATES = A_HBUF;
constexpr size_t A_YSSD = A_YOUT;
constexpr size_t A_HYOUT = A_YSSD + (size_t)MROWS * 256 * 4;
constexpr size_t A_ESCR1 = A_HYOUT + (size_t)4 * 256 * 8192 * 2;
constexpr size_t A_ESCR0 = WS_END;
constexpr size_t WS_TOTAL = A_ESCR0 + (size_t)256 * 8192 * 8;
static_assert(A_ESCR1 + (size_t)256 * 8192 * 8 <= A_PROJ, "escr1 alias");
static_assert((size_t)17408 * 4096 * 2 <= A_PROJ_END - A_PROJ, "hidden alias");
static_assert((size_t)2 * 1024 * 8192 * 4 <= A_PROJ_END - A_PROJ, "kraw alias");
static_assert((size_t)32 * NORD * 4096 * 4 <= SZ_H, "states alias");
static_assert(A_HYOUT + (size_t)4 * 256 * 8192 * 2 <= A_PROJ, "hyout alias");
static_assert(WS_TOTAL <= (size_t)536870912, "workspace");

struct Params {
  const float* in[34];
  float* out;
  char* ws;
  int ph0, ph1;
  int coop, pad;
};

constexpr int SMEM_BYTES = 73728;

DI float wave_sum(float v) {
#pragma unroll
  for (int o = 32; o >= 1; o >>= 1) v += __shfl_xor(v, o);
  return v;
}
DI float block_sum(float v, float* red) {
  v = wave_sum(v);
  if ((otid() & 63) == 0) red[otid() >> 6] = v;
  __syncthreads();
  float r = red[0] + red[1] + red[2] + red[3];
  __syncthreads();
  return r;
}


#define XB_TMO      128
#define XB_XCNT(j)  (256  + 64 * (j))
#define XB_XSUB(j)  (1280 + 64 * (j))
#define XB_XGEN(j)  (2304 + 64 * (j))
#define XB_TOP      3328
#define XB_TOPGEN   3392
#define XCD_BAR_WORDS 3456
#define XB_SPIN_CAP (1u << 22)
#define LAS __attribute__((address_space(3)))
DI unsigned xb_ld(unsigned* p) { return __hip_atomic_load(p, __ATOMIC_RELAXED, __HIP_MEMORY_SCOPE_AGENT); }
DI unsigned xb_add(unsigned* p, unsigned v) { return __hip_atomic_fetch_add(p, v, __ATOMIC_RELAXED, __HIP_MEMORY_SCOPE_AGENT); }
DI unsigned xb_xcc_id() { return (unsigned)__builtin_amdgcn_s_getreg((3 << 11) | 20) & 0xFu; }
#define XB_SPIN(cond, bar) do { unsigned _sp = 0; while (cond) { __builtin_amdgcn_s_sleep(1); \
    if ((++_sp & 255u) == 0u) { if (xb_ld(&(bar)[XB_TMO])) break; if (_sp > XB_SPIN_CAP) { atomicAdd(&(bar)[XB_TMO], 1u); break; } } } } while (0)
struct XcdBarrier { unsigned* bar; unsigned x; volatile LAS unsigned* st; };
DI XcdBarrier xcd_barrier_post(unsigned* bar, volatile LAS unsigned* st) {
  XcdBarrier b; b.bar = bar; b.x = xb_xcc_id(); b.st = st;
  if (threadIdx.x == 0) (void)xb_add(&bar[XB_XCNT(b.x)], 1u);
  return b;
}
DI void xcd_barrier_complete(unsigned* bar, unsigned x, unsigned& nloc, unsigned& nx) {
  const unsigned G = gridDim.x * gridDim.y * gridDim.z;
  unsigned sum, cnt, mine, sp = 0u;
  for (;;) {
    sum = 0u; cnt = 0u; mine = 0u;
#pragma unroll
    for (unsigned j = 0; j < 16; ++j) { const unsigned c = xb_ld(&bar[XB_XCNT(j)]); sum += c; cnt += (c > 0u) ? 1u : 0u; mine = (j == x) ? c : mine; }
    if (sum == G) break;
    __builtin_amdgcn_s_sleep(1);
    if ((++sp & 255u) == 0u) { if (xb_ld(&bar[XB_TMO])) break; if (sp > XB_SPIN_CAP) { atomicAdd(&bar[XB_TMO], 1u); break; } }
  }
  nloc = mine > 0u ? mine : 1u; nx = cnt > 0u ? cnt : 1u;
}
DI void xcd_barrier(const XcdBarrier& b) {
  asm volatile("s_waitcnt vmcnt(0)" ::: "memory");
  __syncthreads();
  if (threadIdx.x == 0) {
    unsigned* bar = b.bar;
    __builtin_amdgcn_s_waitcnt(0);
    unsigned nloc = b.st[0], nx = b.st[1];
    if (nloc == 0u) { xcd_barrier_complete(bar, b.x, nloc, nx); b.st[0] = nloc; b.st[1] = nx; }
    const unsigned old = xb_add(&bar[XB_XSUB(b.x)], 1u);
    const unsigned gen = old / nloc;
    if (old + 1u == (gen + 1u) * nloc) {
      __builtin_amdgcn_fence(__ATOMIC_RELEASE, "agent");
      asm volatile("s_waitcnt vmcnt(0)" ::: "memory");
      const unsigned og = xb_add(&bar[XB_TOP], 1u);
      const unsigned tg = og / nx;
      if (og + 1u == (tg + 1u) * nx) xb_add(&bar[XB_TOPGEN], 1u);
      else XB_SPIN(xb_ld(&bar[XB_TOPGEN]) == tg, bar);
      __builtin_amdgcn_fence(__ATOMIC_ACQUIRE, "agent");
      xb_add(&bar[XB_XGEN(b.x)], 1u);
      asm volatile("s_waitcnt vmcnt(0)" ::: "memory");
    } else {
      XB_SPIN(xb_ld(&bar[XB_XGEN(b.x)]) == gen, bar);
      __builtin_amdgcn_fence(__ATOMIC_ACQUIRE, "agent");
      asm volatile("s_waitcnt vmcnt(0)" ::: "memory");
    }
  }
  __syncthreads();
}

DI float2 cmul(float2 a, float2 w) { return make_float2(a.x * w.x - a.y * w.y, a.x * w.y + a.y * w.x); }
DI float2 cmulc(float2 a, float2 w) { return make_float2(a.x * w.x + a.y * w.y, a.y * w.x - a.x * w.y); }
template <int S>
DI void fft_pass_fwd(float2* X, const float2* __restrict__ tw) {
  constexpr int Q = 1 << (S - 2);
  const int tid = otid();
#pragma unroll 2
  for (int gi = 0; gi < 4; ++gi) {
    const int g = tid + 256 * gi;
    const int pos = g & (Q - 1), blk = g >> (S - 2);
    const int base = (blk << (S + 1)) + pos;
    float2 x[8];
#pragma unroll
    for (int m = 0; m < 8; ++m) x[m] = X[base + m * Q];
    const float2 wa = tw[pos << (12 - S)];
    const float2 wb = make_float2(wa.x * wa.x - wa.y * wa.y, 2.f * wa.x * wa.y);
    const float2 wc = make_float2(wb.x * wb.x - wb.y * wb.y, 2.f * wb.x * wb.y);
    const float R2 = 0.70710678118654752f;
    const float2 ws[4] = {wa, make_float2(R2 * (wa.x + wa.y), R2 * (wa.y - wa.x)), make_float2(wa.y, -wa.x),
                          make_float2(R2 * (wa.y - wa.x), -R2 * (wa.x + wa.y))};
#pragma unroll
    for (int m = 0; m < 4; ++m) {
      const float2 w = ws[m];
      const float2 a = x[m], b = x[m + 4];
      x[m] = make_float2(a.x + b.x, a.y + b.y);
      x[m + 4] = cmul(make_float2(a.x - b.x, a.y - b.y), w);
    }
    {
      const float2 w0 = wb, w1 = make_float2(wb.y, -wb.x);
#pragma unroll
      for (int b2 = 0; b2 < 8; b2 += 4)
#pragma unroll
        for (int m = 0; m < 2; ++m) {
          const float2 a = x[b2 + m], b = x[b2 + m + 2];
          x[b2 + m] = make_float2(a.x + b.x, a.y + b.y);
          x[b2 + m + 2] = cmul(make_float2(a.x - b.x, a.y - b.y), m ? w1 : w0);
        }
    }
    {
      const float2 w = wc;
#pragma unroll
      for (int m = 0; m < 8; m += 2) {
        const float2 a = x[m], b = x[m + 1];
        x[m] = make_float2(a.x + b.x, a.y + b.y);
        x[m + 1] = cmul(make_float2(a.x - b.x, a.y - b.y), w);
      }
    }
#pragma unroll
    for (int m = 0; m < 8; ++m) X[base + m * Q] = x[m];
  }
}
template <int S>
DI void fft_pass_inv(float2* X, const float2* __restrict__ tw) {
  constexpr int Q = 1 << (S - 2);
  const int tid = otid();
#pragma unroll 2
  for (int gi = 0; gi < 4; ++gi) {
    const int g = tid + 256 * gi;
    const int pos = g & (Q - 1), blk = g >> (S - 2);
    const int base = (blk << (S + 1)) + pos;
    float2 x[8];
#pragma unroll
    for (int m = 0; m < 8; ++m) x[m] = X[base + m * Q];
    const float2 wa = tw[pos << (12 - S)];
    const float2 wb = make_float2(wa.x * wa.x - wa.y * wa.y, 2.f * wa.x * wa.y);
    const float2 wc = make_float2(wb.x * wb.x - wb.y * wb.y, 2.f * wb.x * wb.y);
    const float R2 = 0.70710678118654752f;
    const float2 ws[4] = {wa, make_float2(R2 * (wa.x + wa.y), R2 * (wa.y - wa.x)), make_float2(wa.y, -wa.x),
                          make_float2(R2 * (wa.y - wa.x), -R2 * (wa.x + wa.y))};
    {
      const float2 w = wc;
#pragma unroll
      for (int m = 0; m < 8; m += 2) {
        const float2 a = x[m], b = cmulc(x[m + 1], w);
        x[m] = make_float2(a.x + b.x, a.y + b.y);
        x[m + 1] = make_float2(a.x - b.x, a.y - b.y);
      }
    }
    {
      const float2 w0 = wb, w1 = make_float2(wb.y, -wb.x);
#pragma unroll
      for (int b2 = 0; b2 < 8; b2 += 4)
#pragma unroll
        for (int m = 0; m < 2; ++m) {
          const float2 a = x[b2 + m], b = cmulc(x[b2 + m + 2], m ? w1 : w0);
          x[b2 + m] = make_float2(a.x + b.x, a.y + b.y);
          x[b2 + m + 2] = make_float2(a.x - b.x, a.y - b.y);
        }
    }
#pragma unroll
    for (int m = 0; m < 4; ++m) {
      const float2 w = ws[m];
      const float2 a = x[m], b = cmulc(x[m + 4], w);
      x[m] = make_float2(a.x + b.x, a.y + b.y);
      x[m + 4] = make_float2(a.x - b.x, a.y - b.y);
    }
#pragma unroll
    for (int m = 0; m < 8; ++m) X[base + m * Q] = x[m];
  }
}
DI void fft_stage0(float2* X) {
  const int tid = otid();
#pragma unroll 4
  for (int tt = 0; tt < 16; ++tt) {
    const int t = tid + 256 * tt;
    float4 v = *(const float4*)(X + 2 * t);
    *(float4*)(X + 2 * t) = make_float4(v.x + v.z, v.y + v.w, v.x - v.z, v.y - v.w);
  }
}
DI void fft_fwd(float2* X, const float2* __restrict__ tw) {
  __syncthreads();
  fft_pass_fwd<12>(X, tw);
  __syncthreads();
  fft_pass_fwd<9>(X, tw);
  __syncthreads();
  fft_pass_fwd<6>(X, tw);
  __syncthreads();
  fft_pass_fwd<3>(X, tw);
  __syncthreads();
  fft_stage0(X);
  __syncthreads();
}
DI void fft_inv(float2* X, const float2* __restrict__ tw) {
  __syncthreads();
  fft_stage0(X);
  __syncthreads();
  fft_pass_inv<3>(X, tw);
  __syncthreads();
  fft_pass_inv<6>(X, tw);
  __syncthreads();
  fft_pass_inv<9>(X, tw);
  __syncthreads();
  fft_pass_inv<12>(X, tw);
  __syncthreads();
}
DI int brev13(int j) { return (int)(__brev((unsigned)j) >> 19); }

DI void conv_tr_tile(const float* __restrict__ src, int src_ld, int k0, int n0, int shift,
                     bf16* __restrict__ dst, int dst_ld, float* lds) {
  const int tid = otid(), tx = tid & 63, ty = tid >> 6;
  int n = n0 + tx;
  int col = n + ((n >= 768) ? shift : 0);
#pragma unroll
  for (int i = 0; i < 16; ++i) { int kk = ty + 4 * i; lds[kk * 65 + tx] = src[(size_t)(k0 + kk) * src_ld + col]; }
  __syncthreads();
#pragma unroll
  for (int i = 0; i < 16; ++i) { int nn = ty + 4 * i; dst[(size_t)(n0 + nn) * dst_ld + k0 + tx] = f2bf(lds[tx * 65 + nn]); }
  __syncthreads();
}

DI void mod_item(const Params& p, int it, float* lds) {
  const int tid = otid();
  const int layer = it / 96, col0 = (it % 96) * 64;
  float* sv = lds;
  for (int e = tid; e < 5120; e += 256) {
    int r = e >> 10, k = e & 1023;
    float c = (r < 4) ? p.in[1][r * 1024 + k] : p.in[3][k];
    sv[e] = silu_f(c);
  }
  __syncthreads();
  const int cx = tid & 63, kg = tid >> 6;
  float acc[5] = {0.f, 0.f, 0.f, 0.f, 0.f};
  const float* w = p.in[4] + (size_t)layer * 1024 * 6144 + col0 + cx;
#pragma unroll 32
  for (int k = kg; k < 1024; k += 4) {
    float wv = w[(size_t)k * 6144];
#pragma unroll
    for (int r = 0; r < 5; ++r) acc[r] += sv[r * 1024 + k] * wv;
  }
  float* red = lds + 5120;
#pragma unroll
  for (int r = 0; r < 5; ++r) red[(kg * 5 + r) * 64 + cx] = acc[r];
  __syncthreads();
  if (tid < 64) {
    float* mod = (float*)(p.ws + OFF_MOD);
#pragma unroll
    for (int r = 0; r < 5; ++r) {
      float s = red[(0 * 5 + r) * 64 + tid] + red[(1 * 5 + r) * 64 + tid] + red[(2 * 5 + r) * 64 + tid] + red[(3 * 5 + r) * 64 + tid];
      mod[(size_t)(layer * 5 + r) * 6144 + col0 + tid] = s + p.in[5][layer * 6144 + col0 + tid];
    }
  }
  __syncthreads();
}

DI void filt_f1(const Params& p, int fid, int tile, float* lds) {
  const int tid = otid();
  const int layer = (fid == 1) ? 1 : 0;
  const int n = (fid < 2) ? 8192 : 256;
  const int pos0 = tile * 32;
  float* zf = lds;
  float* h1 = lds + 1056;
  float* h2 = h1 + 2048;
  const float* w1 = p.in[20] + layer * 33 * 64;
  const float* b1 = p.in[21] + layer * 64;
  const float* f1 = p.in[22] + layer * 64;
  const float* w2 = p.in[23] + layer * 4096;
  const float* b2 = p.in[24] + layer * 64;
  const float* f2 = p.in[25] + layer * 64;
  const float* w3 = p.in[26] + (size_t)layer * 64 * 1024;
  const float* b3 = p.in[27] + layer * 1024;
  for (int e = tid; e < 1056; e += 256) {
    int pp = e / 33, f = e % 33;
    float pos = (float)(pos0 + pp);
    float val;
    if (f == 0) val = pos / (float)(n - 1);
    else {
      int i = (f - 1) & 15;
      float fb = 1e-4f + (float)i * ((15.f - 1e-4f) / 15.f);
      float ang = ((6.2831855f * pos) * fb) / (float)n;
      val = (f <= 16) ? cosf(ang) : -sinf(ang);
    }
    zf[e] = val;
  }
  __syncthreads();
  {
    const int u = tid & 63;
    for (int q = 0; q < 8; ++q) {
      int pp = (tid >> 6) + 4 * q;
      float acc = b1[u];
      for (int f = 0; f < 33; ++f) acc += zf[pp * 33 + f] * w1[f * 64 + u];
      h1[pp * 64 + u] = __builtin_amdgcn_sinf(f1[u] * acc * 0.15915494309189535f);
    }
  }
  __syncthreads();
  {
    const int u = tid & 63;
    for (int q = 0; q < 8; ++q) {
      int pp = (tid >> 6) + 4 * q;
      float acc = b2[u];
      for (int k = 0; k < 64; ++k) acc += h1[pp * 64 + k] * w2[k * 64 + u];
      h2[pp * 64 + u] = __builtin_amdgcn_sinf(f2[u] * acc * 0.15915494309189535f);
    }
  }
  __syncthreads();
  const float dmin = -3.0701134573253945f, dmax = -15.350567286626973f;
  float* kraw = (float*)(p.ws + A_KRAW);
  float* kc = (float*)(p.ws + OFF_KC);
  float* part = (float*)(p.ws + OFF_PART);
  for (int q = 0; q < 4; ++q) {
    const int oc = tid + 256 * q, ch = oc & 255;
    float wc[64];
#pragma unroll
    for (int u = 0; u < 64; ++u) wc[u] = w3[u * 1024 + oc];
    const float bb = b3[oc];
    const float delta = fabsf(dmin + (dmax - dmin) * ((float)ch / 255.f));
    float ss = 0.f;
    float* obuf = lds + 5184;
    for (int pp = 0; pp < 32; ++pp) {
      float acc = bb;
#pragma unroll
      for (int u = 0; u < 64; ++u) acc += h2[pp * 64 + u] * wc[u];
      float t = (float)(pos0 + pp) / (float)(n - 1);
      float val = acc * expf(-t * delta);
      obuf[tid * 33 + pp] = val;
      ss += val * val;
    }
    part[((size_t)fid * 256 + tile) * 1024 + oc] = ss;
    __syncthreads();
#pragma unroll 4
    for (int r = 0; r < 32; ++r) {
      const int idx = tid + 256 * r, ol = idx >> 5, pp = idx & 31;
      const int oc2 = ol + 256 * q;
      float* dst = (fid < 2) ? (kraw + ((size_t)fid * 1024 + oc2) * 8192 + pos0) : (kc + (size_t)oc2 * 256 + pos0);
      dst[pp] = obuf[ol * 33 + pp];
    }
    __syncthreads();
  }
}

DI void filt_f2(const Params& p, int it, char* smem) {
  const int tid = otid();
  const int layer = it >> 9, order = (it >> 8) & 1, ch = it & 255;
  float2* X = (float2*)smem;
  float* red = (float*)(smem + 65536);
  const float* part = (const float*)(p.ws + OFF_PART);
  const int ocf = order * 512 + ch, ocb = ocf + 256;
  float v = part[((size_t)layer * 256 + tid) * 1024 + ocf] + part[((size_t)layer * 256 + tid) * 1024 + ocb];
  float tot = block_sum(v, red);
  const float scale = rsqrtf(tot + EPS);
  const float* kf = (const float*)(p.ws + A_KRAW) + ((size_t)layer * 1024 + ocf) * 8192;
  const float* kb = (const float*)(p.ws + A_KRAW) + ((size_t)layer * 1024 + ocb) * 8192;
  const float2* tw8 = (const float2*)(p.ws + OFF_TW8);
  const float2* tw16 = (const float2*)(p.ws + OFF_TW16);
  float2* H = (float2*)(p.ws + OFF_SPEC) + ((size_t)(layer * 2 + order) * 256 + ch) * SPEC_LD;
#pragma unroll 8
  for (int i = 0; i < 32; ++i) {
    int n = tid + 256 * i;
    float e = kf[n] + ((n >= 1) ? kb[8192 - n] : 0.f);
    X[n] = make_float2(e * scale, 0.f);
  }
  fft_fwd(X, tw8);
#pragma unroll 8
  for (int i = 0; i < 32; ++i) {
    int j = tid + 256 * i, k = brev13(j);
    if (k <= 4096) H[2 * k] = X[j];
  }
  __syncthreads();
#pragma unroll 8
  for (int i = 0; i < 32; ++i) {
    int n = tid + 256 * i;
    float o = (kf[n] - ((n >= 1) ? kb[8192 - n] : 0.f)) * scale;
    float2 w = tw16[n];
    X[n] = make_float2(o * w.x, o * w.y);
  }
  fft_fwd(X, tw8);
#pragma unroll 8
  for (int i = 0; i < 32; ++i) {
    int j = tid + 256 * i, k = brev13(j);
    if (k <= 4095) H[2 * k + 1] = X[j];
  }
  __syncthreads();
}

struct RowIn { f32x4 x0, x1, x2, x3; u32x2 y0, y1, y2, y3; };
DI RowIn row_load(int lane, const float* __restrict__ xsrc, const bf16* __restrict__ yrow, bool has_y) {
  RowIn r;
  r.x0 = *(const f32x4*)(xsrc + lane * 4); r.x1 = *(const f32x4*)(xsrc + lane * 4 + 256);
  r.x2 = *(const f32x4*)(xsrc + lane * 4 + 512); r.x3 = *(const f32x4*)(xsrc + lane * 4 + 768);
  if (has_y) {
    r.y0 = *(const u32x2*)(yrow + lane * 4); r.y1 = *(const u32x2*)(yrow + lane * 4 + 256);
    r.y2 = *(const u32x2*)(yrow + lane * 4 + 512); r.y3 = *(const u32x2*)(yrow + lane * 4 + 768);
  } else { r.y0 = u32x2{0u, 0u}; r.y1 = r.y0; r.y2 = r.y0; r.y3 = r.y0; }
  return r;
}
DI void rowpass(int lane, const RowIn& in, float* __restrict__ xdst,
                const float* __restrict__ wpost, const float* __restrict__ gate, bool has_y,
                const float* __restrict__ wpre, const float* __restrict__ scv, const float* __restrict__ shv, bool do_norm,
                bf16* __restrict__ hrow, const float* __restrict__ wdt, float* __restrict__ dtrow) {
  float xv[16] = {in.x0.x, in.x0.y, in.x0.z, in.x0.w, in.x1.x, in.x1.y, in.x1.z, in.x1.w,
                  in.x2.x, in.x2.y, in.x2.z, in.x2.w, in.x3.x, in.x3.y, in.x3.z, in.x3.w};
  if (has_y) {
    float yv[16];
    float ss = 0.f;
    {
      const unsigned yy[8] = {in.y0.x, in.y0.y, in.y1.x, in.y1.y, in.y2.x, in.y2.y, in.y3.x, in.y3.y};
#pragma unroll
      for (int q = 0; q < 8; ++q) { yv[2 * q] = __uint_as_float(yy[q] << 16); yv[2 * q + 1] = __uint_as_float(yy[q] & 0xffff0000u); }
    }
#pragma unroll
    for (int e = 0; e < 16; ++e) ss += yv[e] * yv[e];
    ss = wave_sum(ss);
    const float rstd = rsqrtf(ss * (1.f / 1024.f) + EPS);
#pragma unroll
    for (int q = 0; q < 4; ++q) {
      float4 g = *(const float4*)(gate + lane * 4 + 256 * q);
      float4 w = *(const float4*)(wpost + lane * 4 + 256 * q);
      xv[4 * q] += g.x * (yv[4 * q] * rstd * w.x);
      xv[4 * q + 1] += g.y * (yv[4 * q + 1] * rstd * w.y);
      xv[4 * q + 2] += g.z * (yv[4 * q + 2] * rstd * w.z);
      xv[4 * q + 3] += g.w * (yv[4 * q + 3] * rstd * w.w);
      *(float4*)(xdst + lane * 4 + 256 * q) = make_float4(xv[4 * q], xv[4 * q + 1], xv[4 * q + 2], xv[4 * q + 3]);
    }
  }
  if (do_norm) {
    float ss = 0.f;
#pragma unroll
    for (int e = 0; e < 16; ++e) ss += xv[e] * xv[e];
    ss = wave_sum(ss);
    const float rstd = rsqrtf(ss * (1.f / 1024.f) + EPS);
    float hv[16];
#pragma unroll
    for (int q = 0; q < 4; ++q) {
      float4 w = *(const float4*)(wpre + lane * 4 + 256 * q);
      float4 sc = *(const float4*)(scv + lane * 4 + 256 * q);
      float4 sh = *(const float4*)(shv + lane * 4 + 256 * q);
      hv[4 * q] = xv[4 * q] * rstd * w.x * (1.f + sc.x) + sh.x;
      hv[4 * q + 1] = xv[4 * q + 1] * rstd * w.y * (1.f + sc.y) + sh.y;
      hv[4 * q + 2] = xv[4 * q + 2] * rstd * w.z * (1.f + sc.z) + sh.z;
      hv[4 * q + 3] = xv[4 * q + 3] * rstd * w.w * (1.f + sc.w) + sh.w;
      uint2 o;
      o.x = pack2(hv[4 * q], hv[4 * q + 1]);
      o.y = pack2(hv[4 * q + 2], hv[4 * q + 3]);
      *(uint2*)(hrow + lane * 4 + 256 * q) = o;
    }
    if (wdt) {
      float d[8] = {0.f, 0.f, 0.f, 0.f, 0.f, 0.f, 0.f, 0.f};
#pragma unroll
      for (int q = 0; q < 4; ++q) {
#pragma unroll
        for (int dd = 0; dd < 8; ++dd) {
          float4 w = *(const float4*)(wdt + dd * 1028 + lane * 4 + 256 * q);
          d[dd] += hv[4 * q] * w.x + hv[4 * q + 1] * w.y + hv[4 * q + 2] * w.z + hv[4 * q + 3] * w.w;
        }
      }
#pragma unroll
      for (int k = 0; k < 8; ++k) d[k] = wave_sum(d[k]);
      if (lane == 0) {
        *(float4*)dtrow = make_float4(d[0], d[1], d[2], d[3]);
        *(float4*)(dtrow + 4) = make_float4(d[4], d[5], d[6], d[7]);
      }
    }
  }
}

DI void rowpass_phase(const Params& p, int layer, int mode, char* smem) {
  const int lane = otid() & 63, wave = otid() >> 6;
  const int nrows = (mode == 0 || layer == 0) ? MROWS : NLAT;
  const float* modb = (const float*)(p.ws + OFF_MOD);
  float* wl = (float*)smem;
  if (mode == 0 || (mode == 2 && layer + 1 < 2)) {
    const int nl = (mode == 0) ? layer : (layer + 1);
    const float* wsrc = p.in[10] + (size_t)nl * 1024 * 2568 + 768;
    for (int e = otid(); e < 8192; e += 256) wl[(e & 7) * 1028 + (e >> 3)] = wsrc[(size_t)(e >> 3) * 2568 + (e & 7)];
    __syncthreads();
  }
  const bool first = (layer == 0 && mode <= 1);
  const bool has_y = (mode != 0);
  const bf16* ybase = (const bf16*)(p.ws + A_YOUT);
  auto xsrc_of = [&](int row) -> const float* {
    if (row < NLAT) return first ? (p.in[0] + (size_t)row * 1024) : (p.out + (size_t)row * 1024);
    return first ? (p.in[2] + (size_t)(row - NLAT) * 1024) : ((const float*)(p.ws + OFF_CTXS) + (size_t)(row - NLAT) * 1024);
  };
  int r4 = blockIdx.x;
  if (r4 * 4 >= nrows) return;
  RowIn cur = row_load(lane, xsrc_of(r4 * 4 + wave), ybase + (size_t)(r4 * 4 + wave) * 1024, has_y);
  for (; r4 * 4 < nrows; r4 += gridDim.x) {
    const int row = r4 * 4 + wave;
    const int rn = row + 4 * (int)gridDim.x;
    RowIn nxt = cur;
    if (rn < nrows) nxt = row_load(lane, xsrc_of(rn), ybase + (size_t)rn * 1024, has_y);
    const int mb = (row < NLAT) ? (row >> 13) : 4;
    float* xdst = (row < NLAT) ? (p.out + (size_t)row * 1024) : ((float*)(p.ws + OFF_CTXS) + (size_t)(row - NLAT) * 1024);
    const float* mv = modb + (size_t)(layer * 5 + mb) * 6144;
    bf16* hrow = (bf16*)(p.ws + A_HBUF) + (size_t)row * 1024;
    float* dtrow = (float*)(p.ws + OFF_DT) + (size_t)row * 8;
    if (mode == 0) {
      rowpass(lane, cur, xdst, nullptr, nullptr, false, p.in[6] + layer * 1024, mv + 1024, mv, true, hrow, wl, dtrow);
    } else if (mode == 1) {
      rowpass(lane, cur, xdst, p.in[7] + layer * 1024, mv + 2048, true, p.in[8] + layer * 1024, mv + 4 * 1024, mv + 3 * 1024,
              true, hrow, nullptr, dtrow);
    } else {
      const bool nxtl = (layer + 1 < 2);
      const float* mvn = modb + (size_t)((layer + 1) * 5 + mb) * 6144;
      rowpass(lane, cur, xdst, p.in[9] + layer * 1024, mv + 5 * 1024, true, p.in[6] + (layer + 1) * 1024, mvn + 1024, mvn, nxtl,
              hrow, nxtl ? wl : nullptr, dtrow);
    }
    cur = nxt;
  }
}

DI void gload16(u32x4& dst, const bf16* sbase, unsigned voff) {
  asm volatile("global_load_dwordx4 %0, %1, %2" : "=&v"(dst) : "v"(voff), "s"(sbase) : "memory");
}
DI const bf16* uniform_ptr(const bf16* p) {
  unsigned long long v = (unsigned long long)p;
  unsigned lo = __builtin_amdgcn_readfirstlane((unsigned)v), hi = __builtin_amdgcn_readfirstlane((unsigned)(v >> 32));
  return (const bf16*)(((unsigned long long)hi << 32) | lo);
}
#define GEMM_GROUP(ks)                                                                         \
    {                                                                                          \
      bf16x8 a0 = *(const bf16x8*)(st + aoff + (ks) * 32);                                     \
      bf16x8 a1 = *(const bf16x8*)(st + aoff + 32 * 144 + (ks) * 32);                          \
      bf16x8 b0 = *(const bf16x8*)(st + boff + (ks) * 32);                                     \
      bf16x8 b1 = *(const bf16x8*)(st + boff + 32 * 144 + (ks) * 32);                          \
      acc00 = MFMA(a0, b0, acc00);                                                             \
      acc01 = MFMA(a0, b1, acc01);                                                             \
      acc10 = MFMA(a1, b0, acc10);                                                             \
      acc11 = MFMA(a1, b1, acc11);                                                             \
    }
#define GEMM_ITER(KT_, LA, LB, SA, SB)                                                        \
  {                                                                                            \
    const int kt_ = (KT_);                                                                     \
    const char* st = smem + (kt_ & 1) * 36864;                                                 \
    char* sn = smem + ((kt_ + 1) & 1) * 36864;                                                 \
    GEMM_GROUP(0)                                                                              \
    if (kt_ + 2 < KT) {                                                                        \
      gload16(LA[0], As + (kt_ + 2) * 64, voa);               gload16(LB[0], Bs + (kt_ + 2) * 64, vob);  \
      gload16(LA[1], As + (kt_ + 2) * 64, voa + sa32);        gload16(LB[1], Bs + (kt_ + 2) * 64, vob + sb32); \
    }                                                                                          \
    __builtin_amdgcn_sched_barrier(0);                                                         \
    GEMM_GROUP(1)                                                                              \
    if (kt_ + 2 < KT) {                                                                        \
      gload16(LA[2], As + (kt_ + 2) * 64, voa + 2 * sa32);    gload16(LB[2], Bs + (kt_ + 2) * 64, vob + 2 * sb32); \
      gload16(LA[3], As + (kt_ + 2) * 64, voa + 3 * sa32);    gload16(LB[3], Bs + (kt_ + 2) * 64, vob + 3 * sb32); \
    }                                                                                          \
    __builtin_amdgcn_sched_barrier(0);                                                         \
    if (kt_ + 2 < KT) asm volatile("s_waitcnt vmcnt(8)" ::: "memory");                         \
    else asm volatile("s_waitcnt vmcnt(0)" ::: "memory");                                      \
    GEMM_GROUP(2)                                                                              \
    if (kt_ + 1 < KT) {                                                                        \
      *(u32x4*)(sn + soff) = SA[0];                  *(u32x4*)(sn + 18432 + soff) = SB[0];     \
      *(u32x4*)(sn + soff + 32 * 144) = SA[1];       *(u32x4*)(sn + 18432 + soff + 32 * 144) = SB[1]; \
    }                                                                                          \
    __builtin_amdgcn_sched_barrier(0);                                                         \
    GEMM_GROUP(3)                                                                              \
    if (kt_ + 1 < KT) {                                                                        \
      *(u32x4*)(sn + soff + 64 * 144) = SA[2];       *(u32x4*)(sn + 18432 + soff + 64 * 144) = SB[2]; \
      *(u32x4*)(sn + soff + 96 * 144) = SA[3];       *(u32x4*)(sn + 18432 + soff + 96 * 144) = SB[3]; \
    }                                                                                          \
    __builtin_amdgcn_sched_barrier(0);                                                         \
    __syncthreads();                                                                           \
  }

DI void gemm_tile(const bf16* __restrict__ A, int lda, const bf16* __restrict__ Bt, int ldb, int K, char* smem) {
  const int tid = otid(), lane = tid & 63, wave = tid >> 6, r = lane & 31, h = lane >> 5, wm = wave >> 1, wn = wave & 1;
  const int lrow = tid >> 3, lkc = tid & 7;
  const bf16* ag = A + (size_t)lrow * lda + lkc * 8;
  const bf16* bg = Bt + (size_t)lrow * ldb + lkc * 8;
  const size_t lda32 = (size_t)32 * lda, ldb32 = (size_t)32 * ldb;
  const int soff = lrow * 144 + lkc * 16;
  const int aoff = (wm * 64 + r) * 144 + h * 16;
  const int boff = 18432 + (wn * 64 + r) * 144 + h * 16;
  const int KT = K >> 6;
  u32x4 ra0[4], rb0[4], ra1[4], rb1[4];
#pragma unroll
  for (int i = 0; i < 4; ++i) {
    ra0[i] = *(const u32x4*)(ag + i * lda32);
    rb0[i] = *(const u32x4*)(bg + i * ldb32);
  }
#pragma unroll
  for (int i = 0; i < 4; ++i) {
    *(u32x4*)(smem + soff + i * 32 * 144) = ra0[i];
    *(u32x4*)(smem + 18432 + soff + i * 32 * 144) = rb0[i];
  }
  const bf16* As = uniform_ptr(A);
  const bf16* Bs = uniform_ptr(Bt);
  const unsigned voa = (unsigned)(lrow * lda + lkc * 8) * 2u, vob = (unsigned)(lrow * ldb + lkc * 8) * 2u;
  const unsigned sa32 = (unsigned)lda * 64u, sb32 = (unsigned)ldb * 64u;
#pragma unroll
  for (int i = 0; i < 4; ++i) {
    gload16(ra1[i], As + 64, voa + i * sa32);
    gload16(rb1[i], Bs + 64, vob + i * sb32);
  }
  __syncthreads();
  f32x16 acc00, acc01, acc10, acc11;
#pragma unroll
  for (int e = 0; e < 16; ++e) { acc00[e] = 0.f; acc01[e] = 0.f; acc10[e] = 0.f; acc11[e] = 0.f; }
#pragma unroll 1
  for (int kt = 0; kt < KT; kt += 2) {
    GEMM_ITER(kt, ra0, rb0, ra1, rb1)
    GEMM_ITER(kt + 1, ra1, rb1, ra0, rb0)
  }
  float* Cs = (float*)smem;
#pragma unroll
  for (int e = 0; e < 16; ++e) {
    const int rr = (e & 3) + 8 * (e >> 2) + 4 * h;
    Cs[(wm * 64 + rr) * 132 + wn * 64 + r] = acc00[e];
    Cs[(wm * 64 + rr) * 132 + wn * 64 + 32 + r] = acc01[e];
    Cs[(wm * 64 + 32 + rr) * 132 + wn * 64 + r] = acc10[e];
    Cs[(wm * 64 + 32 + rr) * 132 + wn * 64 + 32 + r] = acc11[e];
  }
  __syncthreads();
}

DI void epi_store_bf16(const float* Cs, bf16* __restrict__ dst, int ld, bool sqrelu) {
  const int tid = otid();
#pragma unroll
  for (int i = 0; i < 8; ++i) {
    int c = tid + 256 * i;
    int row = c >> 4, cc = (c & 15) * 8;
    float4 v0 = *(const float4*)(Cs + row * 132 + cc);
    float4 v1 = *(const float4*)(Cs + row * 132 + cc + 4);
    if (sqrelu) {
      v0.x = fmaxf(v0.x, 0.f); v0.x *= v0.x; v0.y = fmaxf(v0.y, 0.f); v0.y *= v0.y;
      v0.z = fmaxf(v0.z, 0.f); v0.z *= v0.z; v0.w = fmaxf(v0.w, 0.f); v0.w *= v0.w;
      v1.x = fmaxf(v1.x, 0.f); v1.x *= v1.x; v1.y = fmaxf(v1.y, 0.f); v1.y *= v1.y;
      v1.z = fmaxf(v1.z, 0.f); v1.z *= v1.z; v1.w = fmaxf(v1.w, 0.f); v1.w *= v1.w;
    }
    uint4 o;
    o.x = pack2(v0.x, v0.y); o.y = pack2(v0.z, v0.w); o.z = pack2(v1.x, v1.y); o.w = pack2(v1.z, v1.w);
    *(uint4*)(dst + (size_t)row * ld + cc) = o;
  }
}
DI void epi_store_tr(const float* Cs, bf16* __restrict__ dst, size_t ldc) {
  const int tid = otid(), pcl = tid & 3, colb = tid >> 2;
#pragma unroll
  for (int i = 0; i < 8; ++i) {
    const int col = colb + 64 * (i & 1);
    const int pc = pcl + 4 * (i >> 1);
    float v[8];
#pragma unroll
    for (int e = 0; e < 8; ++e) v[e] = Cs[(pc * 8 + e) * 132 + col];
    uint4 o;
    o.x = pack2(v[0], v[1]); o.y = pack2(v[2], v[3]); o.z = pack2(v[4], v[5]); o.w = pack2(v[6], v[7]);
    *(uint4*)(dst + (size_t)col * ldc + pc * 8) = o;
  }
}

DI void gemm1_epilogue(const Params& p, int layer, int m0, int nt, const float* Cs) {
  const int tid = otid();
  const bool is_ctx = (m0 >= NLAT);
  const int b = is_ctx ? ((m0 - NLAT) >> 8) : (m0 >> 13);
  const int pos0 = is_ctx ? ((m0 - NLAT) & 255) : (m0 & 8191);
  if (nt < 6) {
    epi_store_bf16(Cs, (bf16*)(p.ws + A_PROJA) + (size_t)m0 * 768 + nt * 128, 768, false);
  } else if (nt < 12) {
    const int ch0 = (nt - 6) * 128;
    if (!is_ctx) epi_store_tr(Cs, (bf16*)(p.ws + A_HYRAW) + ((size_t)(b * 768 + ch0)) * 8192 + pos0, 8192);
    else epi_store_tr(Cs, (bf16*)(p.ws + A_HYRAWC) + ((size_t)(b * 768 + ch0)) * 256 + pos0, 256);
  } else {
    const int g = (nt - 12) >> 2, tt = (nt - 12) & 3;
    const int kpos0 = is_ctx ? (SEQ + pos0) : pos0;
    if (tt == 3) {
      bf16* dst = (bf16*)(p.ws + A_VT) + ((size_t)((g * 4 + b) * 2) * 64) * KEYS + kpos0;
      epi_store_tr(Cs, dst, KEYS);
    } else {
      const int row = tid & 127, hh = tid >> 7;
      float v[64];
#pragma unroll
      for (int d4 = 0; d4 < 16; ++d4) {
        float4 t = *(const float4*)(Cs + row * 132 + hh * 64 + d4 * 4);
        v[d4 * 4] = t.x; v[d4 * 4 + 1] = t.y; v[d4 * 4 + 2] = t.z; v[d4 * 4 + 3] = t.w;
      }
      const bool isq = (tt < 2);
      if (g == 1) {
        const float* wn = (isq ? p.in[30] : p.in[31]) + layer * 64;
        float ss = 0.f;
#pragma unroll
        for (int d = 0; d < 64; ++d) ss += v[d] * v[d];
        const float rstd = rsqrtf(ss * (1.f / 64.f) + EPS);
#pragma unroll
        for (int d = 0; d < 64; ++d) v[d] = v[d] * rstd * wn[d];
      }
      if (!is_ctx) {
        constexpr float kInvRev[16] = {
            1.591549431e-01f, 8.949940161e-02f, 5.032921210e-02f, 2.830219583e-02f, 1.591549431e-02f, 8.949940161e-03f, 5.032921210e-03f, 2.830219583e-03f, 1.591549431e-03f, 8.949940161e-04f, 5.032921210e-04f, 2.830219583e-04f, 1.591549431e-04f, 8.949940161e-05f, 5.032921210e-05f, 2.830219583e-05f};
        const float frow = (float)((pos0 + row) >> 6), fcol = (float)((pos0 + row) & 63);
#pragma unroll
        for (int i = 0; i < 32; ++i) {
          const float rev = ((i < 16) ? frow : fcol) * kInvRev[i & 15];
          const float cs_x = __builtin_amdgcn_cosf(rev), cs_y = __builtin_amdgcn_sinf(rev);
          float a = v[i], bb = v[i + 32];
          v[i] = a * cs_x - bb * cs_y;
          v[i + 32] = a * cs_y + bb * cs_x;
        }
      }
      bf16* dst;
      if (isq) {
        const int head = tt * 2 + hh;
#pragma unroll
        for (int d = 0; d < 64; ++d) v[d] *= (0.125f * LOG2E);
        dst = (bf16*)(p.ws + A_QB) + ((size_t)((g * 4 + b) * 4 + head) * KEYS + kpos0 + row) * 64;
      } else {
        dst = (bf16*)(p.ws + A_KB) + ((size_t)((g * 4 + b) * 2 + hh) * KEYS + kpos0 + row) * 64;
      }
#pragma unroll
      for (int c = 0; c < 8; ++c) {
        uint4 o;
        o.x = pack2(v[c * 8], v[c * 8 + 1]); o.y = pack2(v[c * 8 + 2], v[c * 8 + 3]);
        o.z = pack2(v[c * 8 + 4], v[c * 8 + 5]); o.w = pack2(v[c * 8 + 6], v[c * 8 + 7]);
        *(uint4*)(dst + c * 8) = o;
      }
    }
  }
}

DI void gemm_epilogue(const Params& p, int layer, int which, int mt, int mt_lo, int nt, const float* Cs) {
  if (which == 1) gemm1_epilogue(p, layer, mt * 128, nt, Cs);
  else if (which == 2) epi_store_bf16(Cs, (bf16*)(p.ws + A_YOUT) + (size_t)(mt * 128) * 1024 + nt * 128, 1024, false);
  else if (which == 3) epi_store_bf16(Cs, (bf16*)(p.ws + A_HID) + (size_t)((mt - mt_lo) * 128) * 4096 + nt * 128, 4096, true);
  else epi_store_bf16(Cs, (bf16*)(p.ws + A_YOUT) + (size_t)(mt * 128) * 1024 + nt * 128, 1024, false);
}

DI void glds16(const bf16* sbase, unsigned voff, unsigned lds_dst) {
  unsigned keep;
  asm volatile("s_mov_b32 %0, m0\n\ts_mov_b32 m0, %3\n\ts_nop 0\n\tglobal_load_lds_dwordx4 %1, %2\n\ts_mov_b32 m0, %0"
               : "=&s"(keep) : "v"(voff), "s"(sbase), "s"(lds_dst) : "memory");
}
#define G2_GROUP(AO, BO)                                                                       \
    {                                                                                          \
      bf16x8 a0 = *(const bf16x8*)(st + (AO));                                                 \
      bf16x8 a1 = *(const bf16x8*)(st + (AO) + 2048);                                          \
      bf16x8 b0 = *(const bf16x8*)(st + (BO));                                                 \
      bf16x8 b1 = *(const bf16x8*)(st + (BO) + 2048);                                          \
      bf16x8 b2 = *(const bf16x8*)(st + (BO) + 4096);                                          \
      bf16x8 b3 = *(const bf16x8*)(st + (BO) + 6144);                                          \
      c00 = MFMA(a0, b0, c00); c01 = MFMA(a0, b1, c01); c02 = MFMA(a0, b2, c02); c03 = MFMA(a0, b3, c03); \
      c10 = MFMA(a1, b0, c10); c11 = MFMA(a1, b1, c11); c12 = MFMA(a1, b2, c12); c13 = MFMA(a1, b3, c13); \
    }
#define G2_DMA(KT_, STG)                                                                       \
  {                                                                                            \
    const unsigned lb_ = ldsbase + (STG) * 24576u;                                             \
    glds16(As + (KT_) * 32, voa0, lb_ + wq * 2048u);                                           \
    glds16(As + (KT_) * 32, voa0 + ra16, lb_ + wq * 2048u + 1024u);                            \
    glds16(Bs + (KT_) * 32, vob0, lb_ + 8192u + wq * 4096u);                                   \
    glds16(Bs + (KT_) * 32, vob0 + rb16, lb_ + 8192u + wq * 4096u + 1024u);                    \
    glds16(Bs + (KT_) * 32, vob0 + 2 * rb16, lb_ + 8192u + wq * 4096u + 2048u);                \
    glds16(Bs + (KT_) * 32, vob0 + 3 * rb16, lb_ + 8192u + wq * 4096u + 3072u);                \
  }

DI void gemm_tile2(const Params& p, int layer, int which, int mt, int mt_lo, int nt2, const bf16* __restrict__ A, int lda,
                   const bf16* __restrict__ Bt, int ldb, int K, char* smem) {
  const int tid = otid(), lane = tid & 63, wave = tid >> 6, r = lane & 31, h = lane >> 5, wm = wave >> 1, wn = wave & 1;
  const unsigned wq = (unsigned)__builtin_amdgcn_readfirstlane(wave);
  const unsigned ldsbase = (unsigned)(size_t)(LAS char*)smem;
  const bf16* As = uniform_ptr(A);
  const bf16* Bs = uniform_ptr(Bt);
  const int lr = lane >> 2, cp = lane & 3, gc = cp ^ ((lr >> 2) & 3);
  const unsigned voa0 = (unsigned)((wave * 32 + lr) * lda + gc * 8) * 2u;
  const unsigned vob0 = (unsigned)((wave * 64 + lr) * ldb + gc * 8) * 2u;
  const unsigned ra16 = (unsigned)lda * 32u, rb16 = (unsigned)ldb * 32u;
  const int sw = (r >> 2) & 3;
  const int cx0 = ((h ^ sw) * 16), cx1 = (((2 + h) ^ sw) * 16);
  const int arow = (wm * 64 + r) * 64, brow = 8192 + (wn * 128 + r) * 64;
  const int KT = K >> 5;
  G2_DMA(0, 0u)
  G2_DMA(1, 1u)
  asm volatile("s_waitcnt vmcnt(6)" ::: "memory");
  __syncthreads();
  f32x16 c00, c01, c02, c03, c10, c11, c12, c13;
#pragma unroll
  for (int e = 0; e < 16; ++e) { c00[e] = 0.f; c01[e] = 0.f; c02[e] = 0.f; c03[e] = 0.f; c10[e] = 0.f; c11[e] = 0.f; c12[e] = 0.f; c13[e] = 0.f; }
  unsigned cur = 0u, nx2 = 2u;
#pragma unroll 1
  for (int kt = 0; kt < KT; ++kt) {
    if (kt + 2 < KT) G2_DMA(kt + 2, nx2)
    __builtin_amdgcn_sched_barrier(0);
    const char* st = smem + cur * 24576u;
    G2_GROUP(arow + cx0, brow + cx0)
    G2_GROUP(arow + cx1, brow + cx1)
    __builtin_amdgcn_sched_barrier(0);
    if (kt + 2 < KT) asm volatile("s_waitcnt vmcnt(6)" ::: "memory");
    else asm volatile("s_waitcnt vmcnt(0)" ::: "memory");
    __syncthreads();
    cur = (cur == 2u) ? 0u : cur + 1u;
    nx2 = (nx2 == 2u) ? 0u : nx2 + 1u;
  }
  float* Cs = (float*)smem;
#pragma unroll 1
  for (int nh = 0; nh < 2; ++nh) {
    if (wn == nh) {
#pragma unroll
      for (int e = 0; e < 16; ++e) {
        const int rr = (e & 3) + 8 * (e >> 2) + 4 * h;
        float* c0 = Cs + (wm * 64 + rr) * 132 + r;
        float* c1 = Cs + (wm * 64 + 32 + rr) * 132 + r;
        c0[0] = c00[e]; c0[32] = c01[e]; c0[64] = c02[e]; c0[96] = c03[e];
        c1[0] = c10[e]; c1[32] = c11[e]; c1[64] = c12[e]; c1[96] = c13[e];
      }
    }
    __syncthreads();
    gemm_epilogue(p, layer, which, mt, mt_lo, nt2 * 2 + nh, Cs);
    __syncthreads();
  }
}

DI void gemm_phase(const Params& p, int layer, int which, int half, char* smem) {
  const int mt_all = ((which == 1 || layer == 0) ? MROWS : NLAT) / 128;
  const int mt_lo = (which >= 3 && half) ? 128 : 0;
  const int mt_hi = (which >= 3 && !half) ? 128 : mt_all;
  const int mt_big_hi = (which == 1) ? mt_lo : ((mt_hi < 256) ? mt_hi : 256);
  int NT, K, lda, ldb;
  const bf16 *A, *Bt;
  if (which == 1) { NT = 20; K = 1024; A = (const bf16*)(p.ws + A_HBUF); lda = 1024; Bt = (const bf16*)(p.ws + OFF_WIN) + (size_t)layer * 2560 * 1024; ldb = 1024; }
  else if (which == 2) { NT = 8; K = 1024; A = (const bf16*)(p.ws + A_YMIX); lda = 1024; Bt = (const bf16*)(p.ws + OFF_WOUT) + (size_t)layer * 1024 * 1024; ldb = 1024; }
  else if (which == 3) { NT = 32; K = 1024; A = (const bf16*)(p.ws + A_HBUF); lda = 1024; Bt = (const bf16*)(p.ws + OFF_W1) + (size_t)layer * 4096 * 1024; ldb = 1024; }
  else { NT = 8; K = 4096; A = (const bf16*)(p.ws + A_HID) - (size_t)mt_lo * 128 * 4096; lda = 4096; Bt = (const bf16*)(p.ws + OFF_W2) + (size_t)layer * 1024 * 4096; ldb = 4096; }
  const int NT2 = NT >> 1;
  const int nbig = (mt_big_hi - mt_lo) * NT2;
  if (which != 1)
  for (int t = blockIdx.x; t < nbig; t += gridDim.x) {
    const int mt = mt_lo + t / NT2, nt2 = t % NT2;
    gemm_tile2(p, layer, which, mt, mt_lo, nt2, A + (size_t)mt * 128 * lda, lda, Bt + (size_t)nt2 * 256 * ldb, ldb, K, smem);
  }
  const int nsmall = (mt_hi - mt_big_hi) * NT;
  for (int t = blockIdx.x; t < nsmall; t += gridDim.x) {
    const int mt = mt_big_hi + t / NT, nt = t % NT;
    gemm_tile(A + (size_t)mt * 128 * lda, lda, Bt + (size_t)nt * 128 * ldb, ldb, K, smem);
    gemm_epilogue(p, layer, which, mt, mt_lo, nt, (const float*)smem);
    __syncthreads();
  }
}

DI void attn_item(const bf16* __restrict__ Q, const bf16* __restrict__ Kb, const bf16* __restrict__ VT, int q0, int lo, int hi,
                  int nctx_tiles, bool window, bool has_sink, float sink_l2, bf16* __restrict__ out, char* smem) {
  const int tid = otid(), lane = tid & 63, wave = tid >> 6, r = lane & 31, h = lane >> 5;
  bf16x8 qf[4];
  {
    const bf16* qp = Q + (size_t)(q0 + wave * 32 + r) * 64 + h * 8;
#pragma unroll
    for (int ks = 0; ks < 4; ++ks) qf[ks] = *(const bf16x8*)(qp + ks * 16);
  }
  const int ntl = (hi - lo) >> 6;
  const int nt = ntl + nctx_tiles;
  f32x16 o0, o1;
#pragma unroll
  for (int e = 0; e < 16; ++e) { o0[e] = 0.f; o1[e] = 0.f; }
  float m = has_sink ? sink_l2 : -1e30f;
  float l = (has_sink && h == 0) ? 1.f : 0.f;
  const int qpos = q0 + wave * 32 + r;
  const int c0 = tid, c1 = tid + 256;
  const int lr0 = c0 >> 3, lk0 = c0 & 7, lr1 = c1 >> 3, lk1 = c1 & 7;
  uint4 rk0, rk1, rv0, rv1;
  {
    int key0 = (0 < ntl) ? lo : SEQ;
    rk0 = *(const uint4*)(Kb + (size_t)(key0 + lr0) * 64 + lk0 * 8);
    rk1 = *(const uint4*)(Kb + (size_t)(key0 + lr1) * 64 + lk1 * 8);
    rv0 = *(const uint4*)(VT + (size_t)lr0 * KEYS + key0 + lk0 * 8);
    rv1 = *(const uint4*)(VT + (size_t)lr1 * KEYS + key0 + lk1 * 8);
  }
  *(uint4*)(smem + lr0 * 144 + lk0 * 16) = rk0;
  *(uint4*)(smem + lr1 * 144 + lk1 * 16) = rk1;
  *(uint4*)(smem + 9216 + lr0 * 144 + lk0 * 16) = rv0;
  *(uint4*)(smem + 9216 + lr1 * 144 + lk1 * 16) = rv1;
  __syncthreads();
  for (int ti = 0; ti < nt; ++ti) {
    const int key0 = (ti < ntl) ? (lo + ti * 64) : (SEQ + (ti - ntl) * 64);
    if (ti + 1 < nt) {
      const int kn = (ti + 1 < ntl) ? (lo + (ti + 1) * 64) : (SEQ + (ti + 1 - ntl) * 64);
      rk0 = *(const uint4*)(Kb + (size_t)(kn + lr0) * 64 + lk0 * 8);
      rk1 = *(const uint4*)(Kb + (size_t)(kn + lr1) * 64 + lk1 * 8);
      rv0 = *(const uint4*)(VT + (size_t)lr0 * KEYS + kn + lk0 * 8);
      rv1 = *(const uint4*)(VT + (size_t)lr1 * KEYS + kn + lk1 * 8);
    }
    __builtin_amdgcn_sched_barrier(0);
    const char* Ks = smem + (ti & 1) * 18432;
    const char* Vs = Ks + 9216;
    f32x16 s0, s1;
#pragma unroll
    for (int e = 0; e < 16; ++e) { s0[e] = 0.f; s1[e] = 0.f; }
#pragma unroll
    for (int ks = 0; ks < 4; ++ks) {
      bf16x8 a0 = *(const bf16x8*)(Ks + r * 144 + ks * 32 + h * 16);
      bf16x8 a1 = *(const bf16x8*)(Ks + (32 + r) * 144 + ks * 32 + h * 16);
      s0 = MFMA(a0, qf[ks], s0);
      s1 = MFMA(a1, qf[ks], s1);
    }
    if (window && key0 < SEQ) {
#pragma unroll
      for (int e = 0; e < 16; ++e) {
        int kp = key0 + (e & 3) + 8 * (e >> 2) + 4 * h;
        int d0 = qpos - kp; d0 = d0 < 0 ? -d0 : d0;
        int d1 = qpos - (kp + 32); d1 = d1 < 0 ? -d1 : d1;
        if (d0 > 128) s0[e] = -1e30f;
        if (d1 > 128) s1[e] = -1e30f;
      }
    }
    float mx = s0[0];
#pragma unroll
    for (int e = 1; e < 16; ++e) mx = fmaxf(mx, s0[e]);
#pragma unroll
    for (int e = 0; e < 16; ++e) mx = fmaxf(mx, s1[e]);
    mx = fmaxf(mx, __shfl_xor(mx, 32));
    const float mnew = fmaxf(m, mx);
    const float alpha = __builtin_amdgcn_exp2f(m - mnew);
    m = mnew;
    float ls = 0.f;
#pragma unroll
    for (int e = 0; e < 16; ++e) {
      s0[e] = __builtin_amdgcn_exp2f(s0[e] - mnew);
      s1[e] = __builtin_amdgcn_exp2f(s1[e] - mnew);
      ls += s0[e] + s1[e];
    }
    l = l * alpha + ls;
#pragma unroll
    for (int e = 0; e < 16; ++e) { o0[e] *= alpha; o1[e] *= alpha; }
#pragma unroll
    for (int kb = 0; kb < 2; ++kb) {
#pragma unroll
      for (int s2 = 0; s2 < 2; ++s2) {
        unsigned pk[4];
#pragma unroll
        for (int j = 0; j < 4; ++j) {
          float x0 = kb ? s1[8 * s2 + 2 * j] : s0[8 * s2 + 2 * j];
          float x1 = kb ? s1[8 * s2 + 2 * j + 1] : s0[8 * s2 + 2 * j + 1];
          pk[j] = pack2(x0, x1);
        }
        uint4 pku = make_uint4(pk[0], pk[1], pk[2], pk[3]);
        bf16x8 pf = __builtin_bit_cast(bf16x8, pku);
        const char* vb = Vs + r * 144 + (kb * 32 + 16 * s2 + 4 * h) * 2;
        s16x4 lo0 = *(const s16x4*)(vb);
        s16x4 hi0 = *(const s16x4*)(vb + 16);
        s16x4 lo1 = *(const s16x4*)(vb + 32 * 144);
        s16x4 hi1 = *(const s16x4*)(vb + 32 * 144 + 16);
        bf16x8 v0 = __builtin_shufflevector(lo0, hi0, 0, 1, 2, 3, 4, 5, 6, 7);
        bf16x8 v1 = __builtin_shufflevector(lo1, hi1, 0, 1, 2, 3, 4, 5, 6, 7);
        o0 = MFMA(v0, pf, o0);
        o1 = MFMA(v1, pf, o1);
      }
    }
    if (ti + 1 < nt) {
      char* sn = smem + ((ti + 1) & 1) * 18432;
      *(uint4*)(sn + lr0 * 144 + lk0 * 16) = rk0;
      *(uint4*)(sn + lr1 * 144 + lk1 * 16) = rk1;
      *(uint4*)(sn + 9216 + lr0 * 144 + lk0 * 16) = rv0;
      *(uint4*)(sn + 9216 + lr1 * 144 + lk1 * 16) = rv1;
    }
    __syncthreads();
  }
  const float lt = l + __shfl_xor(l, 32);
  const float inv = 1.f / lt;
  bf16* Os = (bf16*)(smem + 36864);
  {
    const int q = wave * 32 + r;
#pragma unroll
    for (int e = 0; e < 16; e += 2) {
      int d = (e & 3) + 8 * (e >> 2) + 4 * h;
      *(unsigned*)(Os + q * 72 + d) = pack2(o0[e] * inv, o0[e + 1] * inv);
      *(unsigned*)(Os + q * 72 + 32 + d) = pack2(o1[e] * inv, o1[e + 1] * inv);
    }
  }
  __syncthreads();
#pragma unroll
  for (int i = 0; i < 4; ++i) {
    int c = tid + 256 * i;
    int row = c >> 3, ch = c & 7;
    *(uint4*)(out + (size_t)row * 1024 + ch * 8) = *(const uint4*)(Os + row * 72 + ch * 8);
  }
  __syncthreads();
}

DI float conv3_at(const bf16* __restrict__ raw, int n, int len, float w0, float w1, float w2, float bb) {
  const int nm = (n >= 1) ? (n - 1) : 0, np = (n + 1 < len) ? (n + 1) : (len - 1);
  const float vm = bf2f(raw[nm]), v0 = bf2f(raw[n]), vp = bf2f(raw[np]);
  return bb + w1 * v0 + ((n >= 1) ? w0 * vm : 0.f) + ((n + 1 < len) ? w2 * vp : 0.f);
}

DI void hyena_fft_item(const Params& p, int layer, int it, char* smem) {
  const int tid = otid();
  const int ch = it & 255, bp = it >> 8, b0 = 2 * bp, b1 = b0 + 1;
  float2* X = (float2*)smem;
  const bf16* hyraw = (const bf16*)(p.ws + A_HYRAW);
  const float* cw = p.in[18] + layer * 3 * 768;
  const float* cb = p.in[19] + layer * 768;
  const float* hb = p.in[28] + layer * 2 * 256;
  const float2* tw8 = (const float2*)(p.ws + OFF_TW8);
  const float2* tw16 = (const float2*)(p.ws + OFF_TW16);
  bf16* ho0 = (bf16*)(p.ws + A_HYOUT) + ((size_t)(b0 * 256 + ch)) * 8192;
  bf16* ho1 = (bf16*)(p.ws + A_HYOUT) + ((size_t)(b1 * 256 + ch)) * 8192;
  float2* escr = (blockIdx.x < 256) ? ((float2*)(p.ws + A_ESCR0) + (size_t)blockIdx.x * 8192)
                                    : ((float2*)(p.ws + A_ESCR1) + (size_t)(blockIdx.x - 256) * 8192);
  const float vw0 = cw[ch], vw1 = cw[768 + ch], vw2 = cw[1536 + ch], vbb = cb[ch];
  const bf16* r0 = hyraw + ((size_t)(b0 * 768 + ch)) * 8192;
  const bf16* r1 = hyraw + ((size_t)(b1 * 768 + ch)) * 8192;
#pragma unroll 1
  for (int o = 0; o < 2; ++o) {
    const float2* Hl = (const float2*)(p.ws + OFF_SPEC) + ((size_t)(layer * 2 + o) * 256 + ch) * SPEC_LD;
#pragma unroll 8
    for (int i = 0; i < 32; ++i) {
      int n = tid + 256 * i;
      float za, zb;
      if (o == 0) {
        const bf16 qa = f2bf(conv3_at(r0, n, 8192, vw0, vw1, vw2, vbb)), qb = f2bf(conv3_at(r1, n, 8192, vw0, vw1, vw2, vbb));
        ho0[n] = qa; ho1[n] = qb;
        za = bf2f(qa); zb = bf2f(qb);
      } else { za = bf2f(ho0[n]); zb = bf2f(ho1[n]); }
      X[n] = make_float2(za, zb);
    }
    fft_fwd(X, tw8);
#pragma unroll 8
    for (int i = 0; i < 32; ++i) {
      int j = tid + 256 * i, mI = 2 * brev13(j);
      float2 hv = (mI <= 8192) ? Hl[mI] : Hl[16384 - mI];
      if (mI > 8192) hv.y = -hv.y;
      float2 x = X[j];
      X[j] = make_float2(x.x * hv.x - x.y * hv.y, x.x * hv.y + x.y * hv.x);
    }
    fft_inv(X, tw8);
#pragma unroll 8
    for (int i = 0; i < 32; ++i) escr[tid + 256 * i] = X[tid + 256 * i];
#pragma unroll 8
    for (int i = 0; i < 32; ++i) {
      int n = tid + 256 * i;
      const float za = bf2f(ho0[n]), zb = bf2f(ho1[n]);
      float2 w = tw16[n];
      X[n] = make_float2(za * w.x - zb * w.y, za * w.y + zb * w.x);
    }
    fft_fwd(X, tw8);
#pragma unroll 8
    for (int i = 0; i < 32; ++i) {
      int j = tid + 256 * i, mI = 2 * brev13(j) + 1;
      float2 hv = (mI <= 8192) ? Hl[mI] : Hl[16384 - mI];
      if (mI > 8192) hv.y = -hv.y;
      float2 x = X[j];
      X[j] = make_float2(x.x * hv.x - x.y * hv.y, x.x * hv.y + x.y * hv.x);
    }
    fft_inv(X, tw8);
    {
      const int gc = (o + 1) * 256 + ch;
      const float w0 = cw[gc], w1 = cw[768 + gc], w2 = cw[1536 + gc], bb = cb[gc];
      const bf16* g0p = hyraw + ((size_t)(b0 * 768 + gc)) * 8192;
      const bf16* g1p = hyraw + ((size_t)(b1 * 768 + gc)) * 8192;
      const float bias = hb[o * 256 + ch];
#pragma unroll 8
      for (int i = 0; i < 32; ++i) {
        int n = tid + 256 * i;
        const float za = bf2f(ho0[n]), zb = bf2f(ho1[n]);
        float2 x = X[n];
        float2 w = tw16[n];
        float2 ev = escr[n];
        float cr = (ev.x + x.x * w.x + x.y * w.y) * (1.f / 16384.f);
        float ci = (ev.y + x.y * w.x - x.x * w.y) * (1.f / 16384.f);
        float g0 = conv3_at(g0p, n, 8192, w0, w1, w2, bb);
        float g1 = conv3_at(g1p, n, 8192, w0, w1, w2, bb);
        ho0[n] = f2bf(g0 * (cr + za * bias));
        ho1[n] = f2bf(g1 * (ci + zb * bias));
      }
    }
    __syncthreads();
  }
}

DI void hyena_ctx_item(const Params& p, int layer, int ch, float* lds) {
  const int tid = otid();
  float* kf = lds;
  float* kb = lds + 512;
  float* z = lds + 1024;
  const float* part = (const float*)(p.ws + OFF_PART);
  const float* kc = (const float*)(p.ws + OFF_KC);
  const bf16* raw = (const bf16*)(p.ws + A_HYRAWC);
  const float* cw = p.in[18] + layer * 3 * 768;
  const float* cb = p.in[19] + layer * 768;
  const float* hb = p.in[28] + layer * 2 * 256;
  for (int o = 0; o < 2; ++o) {
    float s = 0.f;
    for (int t = 0; t < 8; ++t) s += part[((size_t)2 * 256 + t) * 1024 + o * 512 + ch] + part[((size_t)2 * 256 + t) * 1024 + o * 512 + 256 + ch];
    float sc = rsqrtf(s + EPS);
    kf[o * 256 + tid] = kc[(size_t)(o * 512 + ch) * 256 + tid] * sc;
    kb[o * 256 + tid] = kc[(size_t)(o * 512 + 256 + ch) * 256 + tid] * sc;
  }
  {
    const float w0 = cw[ch], w1 = cw[768 + ch], w2 = cw[1536 + ch], bb = cb[ch];
    for (int b = 0; b < 4; ++b) z[b * 256 + tid] = conv3_at(raw + ((size_t)(b * 768 + ch)) * 256, tid, 256, w0, w1, w2, bb);
  }
  __syncthreads();
  for (int o = 0; o < 2; ++o) {
    const int gc = (o + 1) * 256 + ch;
    const float w0 = cw[gc], w1 = cw[768 + gc], w2 = cw[1536 + gc], bb = cb[gc];
    const float bias = hb[o * 256 + ch];
    float zn[4];
    for (int b = 0; b < 4; ++b) {
      float y = 0.f;
      for (int j = 0; j <= tid; ++j) y += kf[o * 256 + tid - j] * z[b * 256 + j];
      for (int j = tid + 1; j < 256; ++j) y += kb[o * 256 + j - tid] * z[b * 256 + j];
      float g = conv3_at(raw + ((size_t)(b * 768 + gc)) * 256, tid, 256, w0, w1, w2, bb);
      zn[b] = g * (y + z[b * 256 + tid] * bias);
    }
    __syncthreads();
    for (int b = 0; b < 4; ++b) z[b * 256 + tid] = zn[b];
    __syncthreads();
  }
  bf16* ymix = (bf16*)(p.ws + A_YMIX);
  for (int b = 0; b < 4; ++b) ymix[((size_t)(NLAT + b * 256 + tid)) * 1024 + 256 + ch] = f2bf(z[b * 256 + tid]);
  __syncthreads();
}

DI void hyena_tr_item(const Params& p, int it, char* smem) {
  const int tid = otid();
  const int b = it >> 9, ct = (it >> 7) & 3, ntile = it & 127;
  bf16* t = (bf16*)smem;
  const bf16* src = (const bf16*)(p.ws + A_HYOUT) + ((size_t)(b * 256 + ct * 64)) * 8192 + ntile * 64;
  {
    const int nx = tid & 63, cy = tid >> 6;
#pragma unroll
    for (int i = 0; i < 16; ++i) { int c = cy + 4 * i; t[c * 66 + nx] = src[(size_t)c * 8192 + nx]; }
  }
  __syncthreads();
  {
    const int cx = tid & 63, ny = tid >> 6;
    bf16* dst = (bf16*)(p.ws + A_YMIX) + ((size_t)(b * 8192 + ntile * 64)) * 1024 + 256 + ct * 64;
#pragma unroll
    for (int i = 0; i < 16; ++i) { int n = ny + 4 * i; dst[(size_t)n * 1024 + cx] = t[cx * 66 + n]; }
  }
  __syncthreads();
}

constexpr int TLD = 68;
constexpr int TSZ = 64 * TLD;

DI void ssd_stage_raw(bf16* dstraw, const bf16* __restrict__ projA, int rowbase, int seqlen, int s0, int cofs) {
  const int tid = otid();
#pragma unroll
  for (int q = 0; q < 3; ++q) {
    const int c = tid + 256 * q;
    if (c < 544) {
      const int rr = c >> 3, ck = c & 7;
      const int t = s0 - 2 + rr;
      u32x4 v = {0u, 0u, 0u, 0u};
      if (t >= 0 && t < seqlen) v = *(const u32x4*)(projA + (size_t)(rowbase + t) * 768 + 256 + cofs + ck * 8);
      *(u32x4*)(dstraw + rr * 64 + ck * 8) = v;
    }
  }
}
DI void ssd_conv_tile(float* dst, bool transposed, const bf16* raw, int cofs, const float* __restrict__ cw, const float* __restrict__ cb) {
  const int tid = otid(), c = tid & 63, i0 = (tid >> 6) * 16;
  const float w0 = cw[cofs + c], w1 = cw[512 + cofs + c], w2 = cw[1024 + cofs + c], w3 = cw[1536 + cofs + c], w4 = cw[2048 + cofs + c];
  const float bb = cb[cofs + c];
  float x0 = bf2f(raw[(i0 + 0) * 64 + c]), x1 = bf2f(raw[(i0 + 1) * 64 + c]);
  float x2 = bf2f(raw[(i0 + 2) * 64 + c]), x3 = bf2f(raw[(i0 + 3) * 64 + c]);
#pragma unroll
  for (int q = 0; q < 16; ++q) {
    const int i = i0 + q;
    const float x4 = bf2f(raw[(i + 4) * 64 + c]);
    const float acc = bb + w0 * x0 + w1 * x1 + w2 * x2 + w3 * x3 + w4 * x4;
    const float v = silu_f(acc);
    if (transposed) dst[c * TLD + i] = v; else dst[i * TLD + c] = v;
    x0 = x1; x1 = x2; x2 = x3; x3 = x4;
  }
}
DI void ssd_dt2(float* misc, const float* __restrict__ dtraw, int rowbase, int s0, int head, const float* __restrict__ alog, const float* __restrict__ dtbias) {
  const int tid = otid();
  if (tid < 128) {
    const int dir = tid >> 6, l = tid & 63;
    const int j = dir ? (63 - l) : l;
    const float a_h = -expf(alog[dir * 4 + head]);
    float x = dtraw[(size_t)(rowbase + s0 + j) * 8 + dir * 4 + head] + dtbias[dir * 4 + head];
    float dt = (x > 20.f) ? x : log1pf(expf(x));
    float v = dt * a_h;
#pragma unroll
    for (int off = 1; off < 64; off <<= 1) {
      float u = __shfl_up(v, off);
      if (l >= off) v += u;
    }
    misc[dir * 64 + j] = dt;
    misc[128 + dir * 64 + j] = v;
  }
}

struct SsdItem2 { int b, head, c, rowbase, seqlen, s0, of, ob, seqf, seqb; bool ctx; };
DI SsdItem2 ssd_decode2(int it) {
  SsdItem2 s;
  const int bh = it / NORD, o = it % NORD;
  s.b = bh >> 2; s.head = bh & 3;
  s.ctx = (o < 4);
  if (s.ctx) { s.c = o; s.rowbase = NLAT + s.b * 256; s.seqlen = 256; s.of = o; s.ob = 3 - o; }
  else { s.c = o - 4; s.rowbase = s.b * 8192; s.seqlen = 8192; s.of = o; s.ob = 4 + 127 - s.c; }
  s.s0 = s.c * 64;
  s.seqf = (s.b * 2 + 0) * 4 + s.head;
  s.seqb = (s.b * 2 + 1) * 4 + s.head;
  return s;
}

DI void ssd_s1_item(const Params& p, int layer, int it, float* lds) {
  const int tid = otid();
  const SsdItem2 s = ssd_decode2(it);
  float* Xs = lds;
  float* Bs = lds + TSZ;
  bf16* raw = (bf16*)(lds + 2 * TSZ);
  float* misc = lds + 4 * TSZ;
  const bf16* projA = (const bf16*)(p.ws + A_PROJA);
  const float* cw = p.in[12] + layer * 5 * 512;
  const float* cb = p.in[13] + layer * 512;
  ssd_stage_raw(raw, projA, s.rowbase, s.seqlen, s.s0, s.head * 64);
  ssd_stage_raw(raw + 68 * 64, projA, s.rowbase, s.seqlen, s.s0, 256 + (s.head >> 1) * 64);
  ssd_dt2(misc, (const float*)(p.ws + OFF_DT), s.rowbase, s.s0, s.head, p.in[14] + layer * 8, p.in[15] + layer * 8);
  __syncthreads();
  ssd_conv_tile(Xs, false, raw, s.head * 64, cw, cb);
  ssd_conv_tile(Bs, false, raw + 68 * 64, 256 + (s.head >> 1) * 64, cw, cb);
  if (tid < 64) {
    misc[256 + tid] = fexp(misc[128 + 63] - misc[128 + tid]) * misc[tid];
    misc[320 + tid] = fexp(misc[192 + 0] - misc[192 + tid]) * misc[64 + tid];
  }
  __syncthreads();
  const int tp = tid >> 4, tn = tid & 15;
  v2f af2[4][2], ab2[4][2];
#pragma unroll
  for (int a = 0; a < 4; ++a)
#pragma unroll
    for (int c = 0; c < 2; ++c) { af2[a][c] = v2f{0.f, 0.f}; ab2[a][c] = v2f{0.f, 0.f}; }
#pragma unroll 2
  for (int j = 0; j < 64; ++j) {
    const float wf = misc[256 + j], wb = misc[320 + j];
    float4 xv = *(const float4*)(Xs + j * TLD + tp * 4);
    float4 bv = *(const float4*)(Bs + j * TLD + tn * 4);
    const v2f b01 = {bv.x, bv.y}, b23 = {bv.z, bv.w};
    float xa[4] = {xv.x, xv.y, xv.z, xv.w};
#pragma unroll
    for (int a = 0; a < 4; ++a) {
      const float xf = xa[a] * wf, xb = xa[a] * wb;
      const v2f xf2 = {xf, xf}, xb2 = {xb, xb};
      af2[a][0] += xf2 * b01; af2[a][1] += xf2 * b23;
      ab2[a][0] += xb2 * b01; ab2[a][1] += xb2 * b23;
    }
  }
  float accf[4][4], accb[4][4];
#pragma unroll
  for (int a = 0; a < 4; ++a) {
    accf[a][0] = af2[a][0].x; accf[a][1] = af2[a][0].y; accf[a][2] = af2[a][1].x; accf[a][3] = af2[a][1].y;
    accb[a][0] = ab2[a][0].x; accb[a][1] = ab2[a][0].y; accb[a][2] = ab2[a][1].x; accb[a][3] = ab2[a][1].y;
  }
  float* stf = (float*)(p.ws + A_STATES) + ((size_t)s.seqf * NORD + s.of) * 4096;
  float* stb = (float*)(p.ws + A_STATES) + ((size_t)s.seqb * NORD + s.ob) * 4096;
#pragma unroll
  for (int c = 0; c < 4; ++c) {
    *(float4*)(stf + (tn * 4 + c) * 64 + tp * 4) = make_float4(accf[0][c], accf[1][c], accf[2][c], accf[3][c]);
    *(float4*)(stb + (tn * 4 + c) * 64 + tp * 4) = make_float4(accb[0][c], accb[1][c], accb[2][c], accb[3][c]);
  }
  if (tid == 0) {
    ((float*)(p.ws + OFF_DEC))[s.seqf * NORD + s.of] = expf(misc[128 + 63]);
    ((float*)(p.ws + OFF_DEC))[s.seqb * NORD + s.ob] = expf(misc[192 + 0]);
  }
  __syncthreads();
}

DI void ssd_scan_item(const Params& p, int it) {
  const int g = it * 256 + otid();
  const int seq = g >> 12, e = g & 4095;
  float* st = (float*)(p.ws + A_STATES) + (size_t)seq * NORD * 4096 + e;
  const float* dec = (const float*)(p.ws + OFF_DEC) + seq * NORD;
  float hcur = 0.f;
#pragma unroll 12
  for (int o = 0; o < NORD; ++o) {
    float sv = st[(size_t)o * 4096];
    st[(size_t)o * 4096] = hcur;
    hcur = dec[o] * hcur + sv;
  }
}

DI void ssd_s3_item(const Params& p, int layer, int it, float* lds) {
  const int tid = otid();
  const SsdItem2 s = ssd_decode2(it);
  if (layer == 1 && s.ctx) return;
  float* T0 = lds;
  float* T1 = lds + TSZ;
  float* T2 = lds + 2 * TSZ;
  float* T3 = lds + 3 * TSZ;
  float* misc = lds + 4 * TSZ;
  bf16* raw = (bf16*)T2;
  const bf16* projA = (const bf16*)(p.ws + A_PROJA);
  const float* cw = p.in[12] + layer * 5 * 512;
  const float* cb = p.in[13] + layer * 512;
  ssd_stage_raw(raw, projA, s.rowbase, s.seqlen, s.s0, 384 + (s.head >> 1) * 64);
  ssd_stage_raw(raw + 68 * 64, projA, s.rowbase, s.seqlen, s.s0, 256 + (s.head >> 1) * 64);
  ssd_dt2(misc, (const float*)(p.ws + OFF_DT), s.rowbase, s.s0, s.head, p.in[14] + layer * 8, p.in[15] + layer * 8);
  __syncthreads();
  ssd_conv_tile(T0, true, raw, 384 + (s.head >> 1) * 64, cw, cb);
  ssd_conv_tile(T1, true, raw + 68 * 64, 256 + (s.head >> 1) * 64, cw, cb);
  __syncthreads();
  ssd_stage_raw(raw, projA, s.rowbase, s.seqlen, s.s0, s.head * 64);
  __syncthreads();
  ssd_conv_tile(T3, false, raw, s.head * 64, cw, cb);
  __syncthreads();
  const float* dtf = misc; const float* dtb = misc + 64; const float* af = misc + 128; const float* ab = misc + 192;
  const int ti = tid >> 4, tj = tid & 15;
  {
    float acc[4][4];
#pragma unroll
    for (int a = 0; a < 4; ++a)
#pragma unroll
      for (int c = 0; c < 4; ++c) acc[a][c] = 0.f;
    v2f g2[4][2];
#pragma unroll
    for (int a = 0; a < 4; ++a) { g2[a][0] = v2f{0.f, 0.f}; g2[a][1] = v2f{0.f, 0.f}; }
#pragma unroll 4
    for (int n = 0; n < 64; ++n) {
      float4 bv = *(const float4*)(T1 + n * TLD + tj * 4);
      const v2f b01 = {bv.x, bv.y}, b23 = {bv.z, bv.w};
      const float4 c4 = *(const float4*)(T0 + n * TLD + ti * 4);
      const float cva[4] = {c4.x, c4.y, c4.z, c4.w};
#pragma unroll
      for (int a = 0; a < 4; ++a) {
        const v2f c2 = {cva[a], cva[a]};
        g2[a][0] += c2 * b01; g2[a][1] += c2 * b23;
      }
    }
#pragma unroll
    for (int a = 0; a < 4; ++a) { acc[a][0] = g2[a][0].x; acc[a][1] = g2[a][0].y; acc[a][2] = g2[a][1].x; acc[a][3] = g2[a][1].y; }
#pragma unroll
    for (int c = 0; c < 4; ++c) {
      const int j = tj * 4 + c;
      float o4[4];
#pragma unroll
      for (int a = 0; a < 4; ++a) {
        const int i = ti * 4 + a;
        float m = 0.f;
        if (j <= i) m += fexp(af[i] - af[j]) * dtf[j];
        if (j >= i) m += fexp(ab[i] - ab[j]) * dtb[j];
        o4[a] = acc[a][c] * m;
      }
      *(float4*)(T2 + j * TLD + ti * 4) = make_float4(o4[0], o4[1], o4[2], o4[3]);
    }
  }
  __syncthreads();
  {
    const float* st = (const float*)(p.ws + A_STATES) + ((size_t)s.seqf * NORD + s.of) * 4096;
#pragma unroll
    for (int q = 0; q < 4; ++q) {
      int e4 = tid + 256 * q;
      int n = e4 >> 4, p4 = (e4 & 15) * 4;
      *(float4*)(T1 + n * TLD + p4) = *(const float4*)(st + n * 64 + p4);
    }
  }
  __syncthreads();
  const int tp = tj;
  float acc1[4][4], acc2[4][4];
#pragma unroll
  for (int a = 0; a < 4; ++a)
#pragma unroll
    for (int c = 0; c < 4; ++c) { acc1[a][c] = 0.f; acc2[a][c] = 0.f; }
  {
    v2f p1[4][2], p2[4][2];
#pragma unroll
    for (int a = 0; a < 4; ++a) { p1[a][0] = v2f{0.f, 0.f}; p1[a][1] = v2f{0.f, 0.f}; p2[a][0] = v2f{0.f, 0.f}; p2[a][1] = v2f{0.f, 0.f}; }
#pragma unroll 2
    for (int j = 0; j < 64; ++j) {
      float4 xv = *(const float4*)(T3 + j * TLD + tp * 4);
      float4 hv = *(const float4*)(T1 + j * TLD + tp * 4);
      const v2f x01 = {xv.x, xv.y}, x23 = {xv.z, xv.w}, h01 = {hv.x, hv.y}, h23 = {hv.z, hv.w};
      const float4 s4 = *(const float4*)(T2 + j * TLD + ti * 4), c4 = *(const float4*)(T0 + j * TLD + ti * 4);
      const float sva[4] = {s4.x, s4.y, s4.z, s4.w}, cva[4] = {c4.x, c4.y, c4.z, c4.w};
#pragma unroll
      for (int a = 0; a < 4; ++a) {
        const v2f s2 = {sva[a], sva[a]}, c2 = {cva[a], cva[a]};
        p1[a][0] += s2 * x01; p1[a][1] += s2 * x23;
        p2[a][0] += c2 * h01; p2[a][1] += c2 * h23;
      }
    }
#pragma unroll
    for (int a = 0; a < 4; ++a) {
      acc1[a][0] = p1[a][0].x; acc1[a][1] = p1[a][0].y; acc1[a][2] = p1[a][1].x; acc1[a][3] = p1[a][1].y;
      acc2[a][0] = p2[a][0].x; acc2[a][1] = p2[a][0].y; acc2[a][2] = p2[a][1].x; acc2[a][3] = p2[a][1].y;
    }
  }
#pragma unroll
  for (int a = 0; a < 4; ++a) {
    const float ei = fexp(af[ti * 4 + a]);
#pragma unroll
    for (int c = 0; c < 4; ++c) acc1[a][c] += ei * acc2[a][c];
  }
  __syncthreads();
  {
    const float* st = (const float*)(p.ws + A_STATES) + ((size_t)s.seqb * NORD + s.ob) * 4096;
#pragma unroll
    for (int q = 0; q < 4; ++q) {
      int e4 = tid + 256 * q;
      int n = e4 >> 4, p4 = (e4 & 15) * 4;
      *(float4*)(T1 + n * TLD + p4) = *(const float4*)(st + n * 64 + p4);
    }
  }
  __syncthreads();
#pragma unroll
  for (int a = 0; a < 4; ++a)
#pragma unroll
    for (int c = 0; c < 4; ++c) acc2[a][c] = 0.f;
  {
    v2f p2[4][2];
#pragma unroll
    for (int a = 0; a < 4; ++a) { p2[a][0] = v2f{0.f, 0.f}; p2[a][1] = v2f{0.f, 0.f}; }
#pragma unroll 4
    for (int n = 0; n < 64; ++n) {
      float4 hv = *(const float4*)(T1 + n * TLD + tp * 4);
      const v2f h01 = {hv.x, hv.y}, h23 = {hv.z, hv.w};
      const float4 c4 = *(const float4*)(T0 + n * TLD + ti * 4);
      const float cva[4] = {c4.x, c4.y, c4.z, c4.w};
#pragma unroll
      for (int a = 0; a < 4; ++a) {
        const v2f c2 = {cva[a], cva[a]};
        p2[a][0] += c2 * h01; p2[a][1] += c2 * h23;
      }
    }
#pragma unroll
    for (int a = 0; a < 4; ++a) { acc2[a][0] = p2[a][0].x; acc2[a][1] = p2[a][0].y; acc2[a][2] = p2[a][1].x; acc2[a][3] = p2[a][1].y; }
  }
  const float dsk = p.in[16][layer * 4 + s.head];
  float* yssd = (float*)(p.ws + A_YSSD);
#pragma unroll
  for (int a = 0; a < 4; ++a) {
    const int i = ti * 4 + a;
    const float eb = fexp(ab[i]);
    float4 xv = *(const float4*)(T3 + i * TLD + tp * 4);
    float4 o;
    o.x = acc1[a][0] + eb * acc2[a][0] + dsk * xv.x;
    o.y = acc1[a][1] + eb * acc2[a][1] + dsk * xv.y;
    o.z = acc1[a][2] + eb * acc2[a][2] + dsk * xv.z;
    o.w = acc1[a][3] + eb * acc2[a][3] + dsk * xv.w;
    *(float4*)(yssd + (size_t)(s.rowbase + s.s0 + i) * 256 + s.head * 64 + tp * 4) = o;
  }
  __syncthreads();
}

DI void ssd_gate_row(int lane, int row, f32x4 yv, u32x2 zv, const float* __restrict__ ng, bf16* __restrict__ ymix) {
  const int c0 = lane * 4;
  const float z[4] = {__uint_as_float(zv.x << 16), __uint_as_float(zv.x & 0xffff0000u), __uint_as_float(zv.y << 16), __uint_as_float(zv.y & 0xffff0000u)};
  const float y[4] = {yv.x, yv.y, yv.z, yv.w};
  float g[4];
  float ss = 0.f;
#pragma unroll
  for (int e = 0; e < 4; ++e) {
    g[e] = y[e] * silu_f(z[e]);
    ss += g[e] * g[e];
  }
  ss = wave_sum(ss);
  const float rstd = rsqrtf(ss * (1.f / 256.f) + EPS);
  float4 gw = *(const float4*)(ng + c0);
  uint2 o;
  o.x = pack2(g[0] * rstd * gw.x, g[1] * rstd * gw.y);
  o.y = pack2(g[2] * rstd * gw.z, g[3] * rstd * gw.w);
  *(uint2*)(ymix + (size_t)row * 1024 + c0) = o;
}
DI void ssd_gate_phase(const Params& p, int layer) {
  const int lane = otid() & 63, wave = otid() >> 6;
  const int nrows = (layer == 0) ? MROWS : NLAT;
  const bf16* projA = (const bf16*)(p.ws + A_PROJA);
  const float* yssd = (const float*)(p.ws + A_YSSD);
  const float* ng = p.in[17] + layer * 256;
  bf16* ymix = (bf16*)(p.ws + A_YMIX);
  const int c0 = lane * 4;
  for (int r4 = blockIdx.x; r4 * 4 < nrows; r4 += 2 * gridDim.x) {
    const int rowA = r4 * 4 + wave, rowB = rowA + 4 * (int)gridDim.x;
    const bool hasB = ((r4 + (int)gridDim.x) * 4 < nrows);
    const f32x4 yA = *(const f32x4*)(yssd + (size_t)rowA * 256 + c0);
    const u32x2 zA = *(const u32x2*)(projA + (size_t)rowA * 768 + c0);
    f32x4 yB = yA; u32x2 zB = zA;
    if (hasB) {
      yB = *(const f32x4*)(yssd + (size_t)rowB * 256 + c0);
      zB = *(const u32x2*)(projA + (size_t)rowB * 768 + c0);
    }
    ssd_gate_row(lane, rowA, yA, zA, ng, ymix);
    if (hasB) ssd_gate_row(lane, rowB, yB, zB, ng, ymix);
  }
}

DI void phase_pro0(const Params& p, char* smem) {
  float* lds = (float*)smem;
  const int tid = otid();
  constexpr int N_W = 5888, N_MOD = 192, N_F1 = 520, N_ROPE = 1024, N_TW = 48;
  const int rb = gridDim.x - 1 - blockIdx.x;
  for (int it = blockIdx.x; it < 512; it += gridDim.x) filt_f1(p, it >> 8, it & 255, lds);
  for (int it = rb; it < N_MOD; it += gridDim.x) mod_item(p, it, lds);
  for (int it = rb - N_MOD; it < N_F1 - 512; it += gridDim.x) if (it >= 0) filt_f1(p, 2, it, lds);
  {
    struct WT { const float* src; bf16* dst; int sld, dld, k0, n0, shift; };
    auto decode = [&](int it) -> WT {
      WT w; int kt, nt; w.shift = 0;
      if (it < 1280) {
        int layer = it / 640, r = it % 640; kt = r / 40; nt = r % 40; w.shift = 8;
        w.src = p.in[10] + (size_t)layer * 1024 * 2568; w.sld = 2568; w.dst = (bf16*)(p.ws + OFF_WIN) + (size_t)layer * 2560 * 1024; w.dld = 1024;
      } else if (it < 1792) {
        int r = it - 1280, layer = r / 256; r %= 256; kt = r / 16; nt = r % 16;
        w.src = p.in[11] + (size_t)layer * 1024 * 1024; w.sld = 1024; w.dst = (bf16*)(p.ws + OFF_WOUT) + (size_t)layer * 1024 * 1024; w.dld = 1024;
      } else if (it < 3840) {
        int r = it - 1792, layer = r / 1024; r %= 1024; kt = r / 64; nt = r % 64;
        w.src = p.in[32] + (size_t)layer * 1024 * 4096; w.sld = 4096; w.dst = (bf16*)(p.ws + OFF_W1) + (size_t)layer * 4096 * 1024; w.dld = 1024;
      } else {
        int r = it - 3840, layer = r / 1024; r %= 1024; kt = r / 16; nt = r % 16;
        w.src = p.in[33] + (size_t)layer * 4096 * 1024; w.sld = 1024; w.dst = (bf16*)(p.ws + OFF_W2) + (size_t)layer * 1024 * 4096; w.dld = 4096;
      }
      w.k0 = kt * 64; w.n0 = nt * 64;
      return w;
    };
    const int tx = tid & 63, ty = tid >> 6;
    const int kx2 = tid & 31, ny = tid >> 5;
    for (int it = blockIdx.x; it < N_W; it += 2 * gridDim.x) {
      const int itb = it + gridDim.x;
      const bool hasb = (itb < N_W);
      const WT wa = decode(it);
      const WT wb = decode(hasb ? itb : it);
      float va[16], vb[16];
      {
        const int na = wa.n0 + tx, ca = na + ((na >= 768) ? wa.shift : 0);
        const int nb = wb.n0 + tx, cb_ = nb + ((nb >= 768) ? wb.shift : 0);
#pragma unroll
        for (int i = 0; i < 16; ++i) va[i] = wa.src[(size_t)(wa.k0 + ty + 4 * i) * wa.sld + ca];
        if (hasb) {
#pragma unroll
          for (int i = 0; i < 16; ++i) vb[i] = wb.src[(size_t)(wb.k0 + ty + 4 * i) * wb.sld + cb_];
        }
      }
#pragma unroll
      for (int i = 0; i < 16; ++i) lds[(ty + 4 * i) * 65 + tx] = va[i];
      if (hasb) {
#pragma unroll
        for (int i = 0; i < 16; ++i) lds[4160 + (ty + 4 * i) * 65 + tx] = vb[i];
      }
      __syncthreads();
#pragma unroll
      for (int i = 0; i < 8; ++i) {
        const int nn = ny + 8 * i;
        *(unsigned*)(wa.dst + (size_t)(wa.n0 + nn) * wa.dld + wa.k0 + 2 * kx2) = pack2(lds[(2 * kx2) * 65 + nn], lds[(2 * kx2 + 1) * 65 + nn]);
      }
      if (hasb) {
#pragma unroll
        for (int i = 0; i < 8; ++i) {
          const int nn = ny + 8 * i;
          *(unsigned*)(wb.dst + (size_t)(wb.n0 + nn) * wb.dld + wb.k0 + 2 * kx2) = pack2(lds[4160 + (2 * kx2) * 65 + nn], lds[4160 + (2 * kx2 + 1) * 65 + nn]);
        }
      }
      __syncthreads();
    }
  }
  for (int it = blockIdx.x; it < N_TW; it += gridDim.x) {
    int idx = it * 256 + tid;
    if (idx < 4096) ((float2*)(p.ws + OFF_TW8))[idx] = make_float2(cospif((float)idx / 4096.f), -sinpif((float)idx / 4096.f));
    else { int j = idx - 4096; ((float2*)(p.ws + OFF_TW16))[j] = make_float2(cospif((float)j / 8192.f), -sinpif((float)j / 8192.f)); }
  }
}

DI void phase_pro1(const Params& p, char* smem) {
  for (int it = blockIdx.x; it < 1024; it += gridDim.x) filt_f2(p, it, smem);
  rowpass_phase(p, 0, 0, smem);
}

DI void attn_dispatch(const Params& p, int layer, int akind, int ar_, char* smem) {
  const bf16* QB = (const bf16*)(p.ws + A_QB);
  const bf16* KB = (const bf16*)(p.ws + A_KB);
  const bf16* VT = (const bf16*)(p.ws + A_VT);
  bf16* ymix = (bf16*)(p.ws + A_YMIX);
  int g, b, head, q0, lo, hi, orow, ocol;
  bool window = false, has_sink = false;
  if (akind == 0) {
    g = 1; b = ar_ >> 8; head = (ar_ >> 6) & 3; q0 = (ar_ & 63) * 128; lo = 0; hi = SEQ; orow = b * 8192 + q0; ocol = 768;
  } else if (akind == 1) {
    g = 0; b = ar_ >> 8; head = (ar_ >> 6) & 3; q0 = (ar_ & 63) * 128;
    lo = (q0 - 128 < 0) ? 0 : (q0 - 128); hi = (q0 + 256 > SEQ) ? SEQ : (q0 + 256);
    window = true; has_sink = true; orow = b * 8192 + q0; ocol = 512;
  } else {
    g = ar_ >> 5; b = (ar_ >> 3) & 3; head = (ar_ >> 1) & 3; const int qt = ar_ & 1;
    q0 = SEQ + qt * 128; lo = 0; hi = 0; has_sink = (g == 0); orow = NLAT + b * 256 + qt * 128; ocol = (g == 0) ? 512 : 768;
  }
  attn_item(QB + ((size_t)((g * 4 + b) * 4 + head)) * KEYS * 64, KB + ((size_t)((g * 4 + b) * 2 + (head >> 1))) * KEYS * 64,
            VT + ((size_t)((g * 4 + b) * 2 + (head >> 1))) * 64 * KEYS, q0, lo, hi, 4, window, has_sink,
            p.in[29][layer * 4 + head] * LOG2E, ymix + (size_t)orow * 1024 + ocol + head * 64, smem);
}

DI void phase_mix1(const Params& p, int layer, char* smem) {
  const int tid = otid();
  const int N_DENSE = 1024, N_FFT = 512, N_WIN = 1024, N_S1 = 16 * NORD;
  const int N_CH = (layer == 0) ? 256 : 0, N_CA = (layer == 0) ? 64 : 0;
  const int n_att = N_DENSE + N_WIN + N_CA;
  for (int it = blockIdx.x; it < n_att; it += gridDim.x) {
    int akind, ar_;
    if (it < N_DENSE) { akind = 0; ar_ = it; }
    else if (it < N_DENSE + N_WIN) { akind = 1; ar_ = it - N_DENSE; }
    else { akind = 2; ar_ = it - N_DENSE - N_WIN; }
    attn_dispatch(p, layer, akind, ar_, smem);
  }
  for (int it = blockIdx.x; it < N_FFT; it += gridDim.x) hyena_fft_item(p, layer, it, smem);
  for (int it = blockIdx.x; it < N_S1; it += gridDim.x) ssd_s1_item(p, layer, it, (float*)smem);
  for (int it = blockIdx.x; it < N_CH; it += gridDim.x) hyena_ctx_item(p, layer, it, (float*)smem);
}

DI void phase_mix2(const Params& p, int layer, char* smem) {
  const int total = 512 + 2048;
  for (int it = blockIdx.x; it < total; it += gridDim.x) {
    if (it < 512) ssd_scan_item(p, it);
    else hyena_tr_item(p, it - 512, smem);
  }
}

DI void phase_mix3(const Params& p, int layer, char* smem) {
  for (int it = blockIdx.x; it < 16 * NORD; it += gridDim.x) ssd_s3_item(p, layer, it, (float*)smem);
}

template <int K>
DI void run_phase_k(const Params& p, int layer, char* smem) {
  if (K == -2) phase_pro0(p, smem);
  else if (K == -1) phase_pro1(p, smem);
  else if (K == 0) gemm_phase(p, layer, 1, 0, smem);
  else if (K == 1) phase_mix1(p, layer, smem);
  else if (K == 2) phase_mix2(p, layer, smem);
  else if (K == 3) phase_mix3(p, layer, smem);
  else if (K == 4) ssd_gate_phase(p, layer);
  else if (K == 5) gemm_phase(p, layer, 2, 0, smem);
  else if (K == 6) rowpass_phase(p, layer, 1, smem);
  else if (K == 7) gemm_phase(p, layer, 3, 0, smem);
  else if (K == 8) gemm_phase(p, layer, 4, 0, smem);
  else if (K == 9) gemm_phase(p, layer, 3, 1, smem);
  else if (K == 10) gemm_phase(p, layer, 4, 1, smem);
  else rowpass_phase(p, layer, 2, smem);
}
#ifndef PHASE_MASK
#define PHASE_MASK 0xffff
#endif
#define PM(k) ((PHASE_MASK >> (k)) & 1)
DI void run_phase(const Params& p, int ph, char* smem) {
  if (ph == 0) { if (PM(12)) run_phase_k<-2>(p, 0, smem); return; }
  if (ph == 1) { if (PM(13)) run_phase_k<-1>(p, 0, smem); return; }
  const int layer = (ph - 2) / 12, k = (ph - 2) % 12;
  switch (k) {
    case 0: if (PM(0)) run_phase_k<0>(p, layer, smem); break;
    case 1: if (PM(1)) run_phase_k<1>(p, layer, smem); break;
    case 2: if (PM(2)) run_phase_k<2>(p, layer, smem); break;
    case 3: if (PM(3)) run_phase_k<3>(p, layer, smem); break;
    case 4: if (PM(4)) run_phase_k<4>(p, layer, smem); break;
    case 5: if (PM(5)) run_phase_k<5>(p, layer, smem); break;
    case 6: if (PM(6)) run_phase_k<6>(p, layer, smem); break;
    case 7: if (PM(7)) run_phase_k<7>(p, layer, smem); break;
    case 8: if (PM(8)) run_phase_k<8>(p, layer, smem); break;
    case 9: if (PM(9)) run_phase_k<9>(p, layer, smem); break;
    case 10: if (PM(10)) run_phase_k<10>(p, layer, smem); break;
    default: if (PM(11)) run_phase_k<11>(p, layer, smem); break;
  }
}

constexpr int N_PHASES = 2 + 2 * 12;

#if 1
__global__ void __launch_bounds__(256, 2) fwd_megakernel(Params p) {
  __shared__ __attribute__((aligned(16))) char smem[SMEM_BYTES];
  __shared__ uint4 xb_words;
  if (threadIdx.x == 0) xb_words = make_uint4(0u, 0u, 0u, 0u);
  __syncthreads();
  XcdBarrier xb = xcd_barrier_post((unsigned*)(p.ws + OFF_BAR), (volatile LAS unsigned*)&xb_words);
  for (int ph = p.ph0; ph < p.ph1; ++ph) {
    run_phase(p, ph, smem);
    if (ph + 1 < p.ph1) {
      if (ph == p.ph0) cg::this_grid().sync();
      else xcd_barrier(xb);
    }
  }
}
#endif
#if 1
template <int K>
__global__ void __launch_bounds__(256, 2) phase_kernel(Params p) {
  __shared__ __attribute__((aligned(16))) char smem[SMEM_BYTES];
  run_phase_k<K>(p, p.ph0, smem);
}
template <int K>
static void launch_phase(Params p, int layer, int grid, hipStream_t stream) {
  p.ph0 = layer; p.ph1 = layer + 1;
  hipLaunchKernelGGL(phase_kernel<K>, dim3(grid), dim3(256), 0, stream, p);
}
#endif

extern "C" void kernel_launch(void* const* d_in, const int* in_sizes, int n_in, void* d_out, int out_size, void* d_ws,
                              size_t ws_size, hipStream_t stream) {
  static int grid_blocks = 0, grid_fallback = 0;
  if (!grid_blocks) {
    int dev = 0, cus = 0, per_cu = 0;
    (void)hipGetDevice(&dev);
    (void)hipDeviceGetAttribute(&cus, hipDeviceAttributeMultiprocessorCount, dev);
#if ONE_LAUNCH
    (void)hipOccupancyMaxActiveBlocksPerMultiprocessor(&per_cu, fwd_megakernel, 256, 0);
#else
    per_cu = 2;
#endif
    if (per_cu < 1) per_cu = 1;
    if (per_cu > 2) per_cu = 2;
    grid_fallback = cus * per_cu;
    grid_blocks = cus * 2;
  }
  Params p{};
  for (int i = 0; i < 34; ++i) p.in[i] = (const float*)d_in[i];
  p.out = (float*)d_out;
  p.ws = (char*)d_ws;
  p.pad = 0;
  if (ws_size < WS_TOTAL) { fprintf(stderr, "workspace too small: %zu < %zu\n", ws_size, (size_t)WS_TOTAL); return; }
#if ONE_LAUNCH == 2
#ifndef SEP_MASK
#define SEP_MASK 0x7A1
#endif
  for (int ph = 0; ph < N_PHASES; ++ph) {
    p.coop = 0;
    const int k = (ph < 2) ? (12 + ph) : ((ph - 2) % 12), layer = (ph < 2) ? 0 : (ph - 2) / 12;
    if ((SEP_MASK >> k) & 1) {
      switch (k) {
        case 0: launch_phase<0>(p, layer, 512, stream); break;
        case 1: launch_phase<1>(p, layer, 512, stream); break;
        case 2: launch_phase<2>(p, layer, 512, stream); break;
        case 3: launch_phase<3>(p, layer, 512, stream); break;
        case 4: launch_phase<4>(p, layer, 512, stream); break;
        case 5: launch_phase<5>(p, layer, 512, stream); break;
        case 6: launch_phase<6>(p, layer, 512, stream); break;
        case 7: launch_phase<7>(p, layer, 512, stream); break;
        case 8: launch_phase<8>(p, layer, 512, stream); break;
        case 9: launch_phase<9>(p, layer, 512, stream); break;
        case 10: launch_phase<10>(p, layer, 512, stream); break;
        case 11: launch_phase<11>(p, layer, 512, stream); break;
        case 12: launch_phase<-2>(p, 0, 512, stream); break;
        default: launch_phase<-1>(p, 0, 512, stream); break;
      }
    } else {
      p.ph0 = ph; p.ph1 = ph + 1;
      hipLaunchKernelGGL(fwd_megakernel, dim3(512), dim3(256), 0, stream, p);
    }
  }
#elif ONE_LAUNCH
  p.ph0 = 0; p.ph1 = N_PHASES; p.coop = 1;
  void* args[] = {&p};
  (void)hipMemsetAsync(p.ws + OFF_BAR, 0, XCD_BAR_WORDS * 4, stream);
  hipError_t e = hipLaunchCooperativeKernel((void*)fwd_megakernel, dim3(grid_blocks), dim3(256), args, 0, stream);
  if (e != hipSuccess && grid_blocks != grid_fallback) {
    (void)hipGetLastError();
    grid_blocks = grid_fallback;
    e = hipLaunchCooperativeKernel((void*)fwd_megakernel, dim3(grid_blocks), dim3(256), args, 0, stream);
  }
  if (e != hipSuccess) fprintf(stderr, "cooperative launch failed: %s (grid %d)\n", hipGetErrorString(e), grid_blocks);
#else
  p.coop = 0;
  launch_phase<-2>(p, 0, grid_blocks, stream);
  launch_phase<-1>(p, 0, grid_blocks, stream);
  for (int layer = 0; layer < 2; ++layer) {
    launch_phase<0>(p, layer, grid_blocks, stream);
    launch_phase<1>(p, layer, grid_blocks, stream);
    launch_phase<2>(p, layer, grid_blocks, stream);
    launch_phase<3>(p, layer, grid_blocks, stream);
    launch_phase<4>(p, layer, grid_blocks, stream);
    launch_phase<5>(p, layer, grid_blocks, stream);
    launch_phase<6>(p, layer, grid_blocks, stream);
    launch_phase<7>(p, layer, grid_blocks, stream);
    launch_phase<8>(p, layer, grid_blocks, stream);
    launch_phase<9>(p, layer, grid_blocks, stream);
    launch_phase<10>(p, layer, grid_blocks, stream);
    launch_phase<11>(p, layer, grid_blocks, stream);
  }
#endif
}
```

```cpp
#include <hip/hip_runtime.h>
#include <hip/hip_cooperative_groups.h>
#include <stdint.h>
#include <stdio.h>
namespace cg = cooperative_groups;

#ifndef ONE_LAUNCH
#define ONE_LAUNCH 1
#endif

typedef unsigned short bf16;
typedef short bf16x8 __attribute__((ext_vector_type(8)));
typedef unsigned u32x4 __attribute__((ext_vector_type(4)));
typedef short s16x4 __attribute__((ext_vector_type(4)));
typedef float f32x16 __attribute__((ext_vector_type(16)));
typedef __bf16 bfv2 __attribute__((ext_vector_type(2)));
typedef float fv2 __attribute__((ext_vector_type(2)));
typedef float v2f __attribute__((ext_vector_type(2)));
typedef float f32x4 __attribute__((ext_vector_type(4)));
typedef unsigned u32x2 __attribute__((ext_vector_type(2)));

#define DI __device__ __forceinline__
#define MFMA(a, b, c) __builtin_amdgcn_mfma_f32_32x32x16_bf16((a), (b), (c), 0, 0, 0)

DI int otid() { int t = (int)__builtin_amdgcn_workitem_id_x(); asm volatile("" : "+v"(t)); return t; }
DI float bf2f(bf16 b) { return __uint_as_float(((unsigned)b) << 16); }
DI unsigned pack2(float a, float b) { fv2 v = {a, b}; return __builtin_bit_cast(unsigned, __builtin_convertvector(v, bfv2)); }
DI bf16 f2bf(float a) { return (bf16)(pack2(a, 0.f) & 0xffffu); }
DI float fexp(float x) { return __builtin_amdgcn_exp2f(x * 1.4426950408889634f); }
DI float silu_f(float x) { return x * __builtin_amdgcn_rcpf(1.f + fexp(-x)); }

constexpr int NB = 4, SEQ = 8192, CTXL = 256, NLAT = NB * SEQ, NCTX = NB * CTXL, MROWS = NLAT + NCTX;
constexpr int KEYS = SEQ + CTXL;
constexpr float EPS = 1e-6f;
constexpr float LOG2E = 1.4426950408889634f;
constexpr int NORD = 132;
constexpr int SPEC_LD = 8200;

constexpr size_t OFF_WIN = 0;
constexpr size_t OFF_WOUT = OFF_WIN + (size_t)2 * 2560 * 1024 * 2;
constexpr size_t OFF_W1 = OFF_WOUT + (size_t)2 * 1024 * 1024 * 2;
constexpr size_t OFF_W2 = OFF_W1 + (size_t)2 * 4096 * 1024 * 2;
constexpr size_t OFF_SPEC = OFF_W2 + (size_t)2 * 4096 * 1024 * 2;
constexpr size_t OFF_KC = OFF_SPEC + (size_t)2 * 2 * 256 * SPEC_LD * 8;
constexpr size_t OFF_PART = OFF_KC + (size_t)1024 * 256 * 4;
constexpr size_t OFF_ROPE = OFF_PART + (size_t)3 * 256 * 1024 * 4;
constexpr size_t OFF_TW8 = OFF_ROPE + (size_t)8192 * 32 * 8;
constexpr size_t OFF_TW16 = OFF_TW8 + 4096 * 8;
constexpr size_t OFF_MOD = OFF_TW16 + 8192 * 8;
constexpr size_t OFF_DT = OFF_MOD + (size_t)2 * 5 * 6144 * 4;
constexpr size_t OFF_DEC = OFF_DT + (size_t)MROWS * 8 * 4;
constexpr size_t OFF_BAR = OFF_DEC + 32 * NORD * 4 + 256;
constexpr size_t OFF_CTXS = OFF_BAR + 16384;
constexpr size_t OFF_ARENA = ((OFF_CTXS + (size_t)1024 * 1024 * 4 + 4095) / 4096) * 4096;
constexpr size_t SZ_H = (size_t)MROWS * 1024 * 2;
constexpr size_t A_HBUF = OFF_ARENA;
constexpr size_t A_YOUT = A_HBUF + SZ_H;
constexpr size_t A_PROJ = A_YOUT + SZ_H;
constexpr size_t A_PROJA = A_PROJ;
constexpr size_t A_HYRAW = A_PROJA + (size_t)MROWS * 768 * 2;
constexpr size_t A_HYRAWC = A_HYRAW + (size_t)4 * 768 * 8192 * 2;
constexpr size_t A_QB = A_HYRAWC + (size_t)4 * 768 * 256 * 2;
constexpr size_t A_KB = A_QB + (size_t)2 * 4 * 4 * KEYS * 64 * 2;
constexpr size_t A_VT = A_KB + (size_t)2 * 4 * 2 * KEYS * 64 * 2;
constexpr size_t A_PROJ_END = A_VT + (size_t)2 * 4 * 2 * KEYS * 64 * 2;
constexpr size_t A_YMIX = A_PROJ_END;
constexpr size_t WS_END = A_YMIX + SZ_H;
constexpr size_t A_HID = A_PROJ;
constexpr size_t A_KRAW = A_PROJ;
constexpr size_t A_STATES = A_HBUF;
constexpr size_t A_YSSD = A_YOUT;
constexpr size_t A_HYOUT = A_YSSD + (size_t)MROWS * 256 * 4;
constexpr size_t A_ESCR1 = A_HYOUT + (size_t)4 * 256 * 8192 * 2;
constexpr size_t A_ESCR0 = WS_END;
constexpr size_t WS_TOTAL = A_ESCR0 + (size_t)256 * 8192 * 8;
static_assert(A_ESCR1 + (size_t)256 * 8192 * 8 <= A_PROJ, "escr1 alias");
static_assert((size_t)17408 * 4096 * 2 <= A_PROJ_END - A_PROJ, "hidden alias");
static_assert((size_t)2 * 1024 * 8192 * 4 <= A_PROJ_END - A_PROJ, "kraw alias");
static_assert((size_t)32 * NORD * 4096 * 4 <= SZ_H, "states alias");
static_assert(A_HYOUT + (size_t)4 * 256 * 8192 * 2 <= A_PROJ, "hyout alias");
static_assert(WS_TOTAL <= (size_t)536870912, "workspace");

struct Params {
  const float* in[34];
  float* out;
  char* ws;
  int ph0, ph1;
  int coop, pad;
};

constexpr int SMEM_BYTES = 73728;

DI float wave_sum(float v) {
#pragma unroll
  for (int o = 32; o >= 1; o >>= 1) v += __shfl_xor(v, o);
  return v;
}
DI float block_sum(float v, float* red) {
  v = wave_sum(v);
  if ((otid() & 63) == 0) red[otid() >> 6] = v;
  __syncthreads();
  float r = red[0] + red[1] + red[2] + red[3];
  __syncthreads();
  return r;
}


#define XB_TMO      128
#define XB_XCNT(j)  (256  + 64 * (j))
#define XB_XSUB(j)  (1280 + 64 * (j))
#define XB_XGEN(j)  (2304 + 64 * (j))
#define XB_TOP      3328
#define XB_TOPGEN   3392
#define XCD_BAR_WORDS 3456
#define XB_SPIN_CAP (1u << 22)
#define LAS __attribute__((address_space(3)))
DI unsigned xb_ld(unsigned* p) { return __hip_atomic_load(p, __ATOMIC_RELAXED, __HIP_MEMORY_SCOPE_AGENT); }
DI unsigned xb_add(unsigned* p, unsigned v) { return __hip_atomic_fetch_add(p, v, __ATOMIC_RELAXED, __HIP_MEMORY_SCOPE_AGENT); }
DI unsigned xb_xcc_id() { return (unsigned)__builtin_amdgcn_s_getreg((3 << 11) | 20) & 0xFu; }
#define XB_SPIN(cond, bar) do { unsigned _sp = 0; while (cond) { __builtin_amdgcn_s_sleep(1); \
    if ((++_sp & 255u) == 0u) { if (xb_ld(&(bar)[XB_TMO])) break; if (_sp > XB_SPIN_CAP) { atomicAdd(&(bar)[XB_TMO], 1u); break; } } } } while (0)
struct XcdBarrier { unsigned* bar; unsigned x; volatile LAS unsigned* st; };
DI XcdBarrier xcd_barrier_post(unsigned* bar, volatile LAS unsigned* st) {
  XcdBarrier b; b.bar = bar; b.x = xb_xcc_id(); b.st = st;
  if (threadIdx.x == 0) (void)xb_add(&bar[XB_XCNT(b.x)], 1u);
  return b;
}
DI void xcd_barrier_complete(unsigned* bar, unsigned x, unsigned& nloc, unsigned& nx) {
  const unsigned G = gridDim.x * gridDim.y * gridDim.z;
  unsigned sum, cnt, mine, sp = 0u;
  for (;;) {
    sum = 0u; cnt = 0u; mine = 0u;
#pragma unroll
    for (unsigned j = 0; j < 16; ++j) { const unsigned c = xb_ld(&bar[XB_XCNT(j)]); sum += c; cnt += (c > 0u) ? 1u : 0u; mine = (j == x) ? c : mine; }
    if (sum == G) break;
    __builtin_amdgcn_s_sleep(1);
    if ((++sp & 255u) == 0u) { if (xb_ld(&bar[XB_TMO])) break; if (sp > XB_SPIN_CAP) { atomicAdd(&bar[XB_TMO], 1u); break; } }
  }
  nloc = mine > 0u ? mine : 1u; nx = cnt > 0u ? cnt : 1u;
}
DI void xcd_barrier(const XcdBarrier& b) {
  asm volatile("s_waitcnt vmcnt(0)" ::: "memory");
  __syncthreads();
  if (threadIdx.x == 0) {
    unsigned* bar = b.bar;
    __builtin_amdgcn_s_waitcnt(0);
    unsigned nloc = b.st[0], nx = b.st[1];
    if (nloc == 0u) { xcd_barrier_complete(bar, b.x, nloc, nx); b.st[0] = nloc; b.st[1] = nx; }
    const unsigned old = xb_add(&bar[XB_XSUB(b.x)], 1u);
    const unsigned gen = old / nloc;
    if (old + 1u == (gen + 1u) * nloc) {
      __builtin_amdgcn_fence(__ATOMIC_RELEASE, "agent");
      asm volatile("s_waitcnt vmcnt(0)" ::: "memory");
      const unsigned og = xb_add(&bar[XB_TOP], 1u);
      const unsigned tg = og / nx;
      if (og + 1u == (tg + 1u) * nx) xb_add(&bar[XB_TOPGEN], 1u);
      else XB_SPIN(xb_ld(&bar[XB_TOPGEN]) == tg, bar);
      __builtin_amdgcn_fence(__ATOMIC_ACQUIRE, "agent");
      xb_add(&bar[XB_XGEN(b.x)], 1u);
      asm volatile("s_waitcnt vmcnt(0)" ::: "memory");
    } else {
      XB_SPIN(xb_ld(&bar[XB_XGEN(b.x)]) == gen, bar);
      __builtin_amdgcn_fence(__ATOMIC_ACQUIRE, "agent");
      asm volatile("s_waitcnt vmcnt(0)" ::: "memory");
    }
  }
  __syncthreads();
}

DI float2 cmul(float2 a, float2 w) { return make_float2(a.x * w.x - a.y * w.y, a.x * w.y + a.y * w.x); }
DI float2 cmulc(float2 a, float2 w) { return make_float2(a.x * w.x + a.y * w.y, a.y * w.x - a.x * w.y); }
template <int S>
DI void fft_pass_fwd(float2* X, const float2* __restrict__ tw) {
  constexpr int Q = 1 << (S - 2);
  const int tid = otid();
#pragma unroll 2
  for (int gi = 0; gi < 4; ++gi) {
    const int g = tid + 256 * gi;
    const int pos = g & (Q - 1), blk = g >> (S - 2);
    const int base = (blk << (S + 1)) + pos;
    float2 x[8];
#pragma unroll
    for (int m = 0; m < 8; ++m) x[m] = X[base + m * Q];
    const float2 wa = tw[pos << (12 - S)];
    const float2 wb = make_float2(wa.x * wa.x - wa.y * wa.y, 2.f * wa.x * wa.y);
    const float2 wc = make_float2(wb.x * wb.x - wb.y * wb.y, 2.f * wb.x * wb.y);
    const float R2 = 0.70710678118654752f;
    const float2 ws[4] = {wa, make_float2(R2 * (wa.x + wa.y), R2 * (wa.y - wa.x)), make_float2(wa.y, -wa.x),
                          make_float2(R2 * (wa.y - wa.x), -R2 * (wa.x + wa.y))};
#pragma unroll
    for (int m = 0; m < 4; ++m) {
      const float2 w = ws[m];
      const float2 a = x[m], b = x[m + 4];
      x[m] = make_float2(a.x + b.x, a.y + b.y);
      x[m + 4] = cmul(make_float2(a.x - b.x, a.y - b.y), w);
    }
    {
      const float2 w0 = wb, w1 = make_float2(wb.y, -wb.x);
#pragma unroll
      for (int b2 = 0; b2 < 8; b2 += 4)
#pragma unroll
        for (int m = 0; m < 2; ++m) {
          const float2 a = x[b2 + m], b = x[b2 + m + 2];
          x[b2 + m] = make_float2(a.x + b.x, a.y + b.y);
          x[b2 + m + 2] = cmul(make_float2(a.x - b.x, a.y - b.y), m ? w1 : w0);
        }
    }
    {
      const float2 w = wc;
#pragma unroll
      for (int m = 0; m < 8; m += 2) {
        const float2 a = x[m], b = x[m + 1];
        x[m] = make_float2(a.x + b.x, a.y + b.y);
        x[m + 1] = cmul(make_float2(a.x - b.x, a.y - b.y), w);
      }
    }
#pragma unroll
    for (int m = 0; m < 8; ++m) X[base + m * Q] = x[m];
  }
}
template <int S>
DI void fft_pass_inv(float2* X, const float2* __restrict__ tw) {
  constexpr int Q = 1 << (S - 2);
  const int tid = otid();
#pragma unroll 2
  for (int gi = 0; gi < 4; ++gi) {
    const int g = tid + 256 * gi;
    const int pos = g & (Q - 1), blk = g >> (S - 2);
    const int base = (blk << (S + 1)) + pos;
    float2 x[8];
#pragma unroll
    for (int m = 0; m < 8; ++m) x[m] = X[base + m * Q];
    const float2 wa = tw[pos << (12 - S)];
    const float2 wb = make_float2(wa.x * wa.x - wa.y * wa.y, 2.f * wa.x * wa.y);
    const float2 wc = make_float2(wb.x * wb.x - wb.y * wb.y, 2.f * wb.x * wb.y);
    const float R2 = 0.70710678118654752f;
    const float2 ws[4] = {wa, make_float2(R2 * (wa.x + wa.y), R2 * (wa.y - wa.x)), make_float2(wa.y, -wa.x),
                          make_float2(R2 * (wa.y - wa.x), -R2 * (wa.x + wa.y))};
    {
      const float2 w = wc;
#pragma unroll
      for (int m = 0; m < 8; m += 2) {
        const float2 a = x[m], b = cmulc(x[m + 1], w);
        x[m] = make_float2(a.x + b.x, a.y + b.y);
        x[m + 1] = make_float2(a.x - b.x, a.y - b.y);
      }
    }
    {
      const float2 w0 = wb, w1 = make_float2(wb.y, -wb.x);
#pragma unroll
      for (int b2 = 0; b2 < 8; b2 += 4)
#pragma unroll
        for (int m = 0; m < 2; ++m) {
          const float2 a = x[b2 + m], b = cmulc(x[b2 + m + 2], m ? w1 : w0);
          x[b2 + m] = make_float2(a.x + b.x, a.y + b.y);
          x[b2 + m + 2] = make_float2(a.x - b.x, a.y - b.y);
        }
    }
#pragma unroll
    for (int m = 0; m < 4; ++m) {
      const float2 w = ws[m];
      const float2 a = x[m], b = cmulc(x[m + 4], w);
      x[m] = make_float2(a.x + b.x, a.y + b.y);
      x[m + 4] = make_float2(a.x - b.x, a.y - b.y);
    }
#pragma unroll
    for (int m = 0; m < 8; ++m) X[base + m * Q] = x[m];
  }
}
DI void fft_stage0(float2* X) {
  const int tid = otid();
#pragma unroll 4
  for (int tt = 0; tt < 16; ++tt) {
    const int t = tid + 256 * tt;
    float4 v = *(const float4*)(X + 2 * t);
    *(float4*)(X + 2 * t) = make_float4(v.x + v.z, v.y + v.w, v.x - v.z, v.y - v.w);
  }
}
DI void fft_fwd(float2* X, const float2* __restrict__ tw) {
  __syncthreads();
  fft_pass_fwd<12>(X, tw);
  __syncthreads();
  fft_pass_fwd<9>(X, tw);
  __syncthreads();
  fft_pass_fwd<6>(X, tw);
  __syncthreads();
  fft_pass_fwd<3>(X, tw);
  __syncthreads();
  fft_stage0(X);
  __syncthreads();
}
DI void fft_inv(float2* X, const float2* __restrict__ tw) {
  __syncthreads();
  fft_stage0(X);
  __syncthreads();
  fft_pass_inv<3>(X, tw);
  __syncthreads();
  fft_pass_inv<6>(X, tw);
  __syncthreads();
  fft_pass_inv<9>(X, tw);
  __syncthreads();
  fft_pass_inv<12>(X, tw);
  __syncthreads();
}
DI int brev13(int j) { return (int)(__brev((unsigned)j) >> 19); }

DI void conv_tr_tile(const float* __restrict__ src, int src_ld, int k0, int n0, int shift,
                     bf16* __restrict__ dst, int dst_ld, float* lds) {
  const int tid = otid(), tx = tid & 63, ty = tid >> 6;
  int n = n0 + tx;
  int col = n + ((n >= 768) ? shift : 0);
#pragma unroll
  for (int i = 0; i < 16; ++i) { int kk = ty + 4 * i; lds[kk * 65 + tx] = src[(size_t)(k0 + kk) * src_ld + col]; }
  __syncthreads();
#pragma unroll
  for (int i = 0; i < 16; ++i) { int nn = ty + 4 * i; dst[(size_t)(n0 + nn) * dst_ld + k0 + tx] = f2bf(lds[tx * 65 + nn]); }
  __syncthreads();
}

DI void mod_item(const Params& p, int it, float* lds) {
  const int tid = otid();
  const int layer = it / 96, col0 = (it % 96) * 64;
  float* sv = lds;
  for (int e = tid; e < 5120; e += 256) {
    int r = e >> 10, k = e & 1023;
    float c = (r < 4) ? p.in[1][r * 1024 + k] : p.in[3][k];
    sv[e] = silu_f(c);
  }
  __syncthreads();
  const int cx = tid & 63, kg = tid >> 6;
  float acc[5] = {0.f, 0.f, 0.f, 0.f, 0.f};
  const float* w = p.in[4] + (size_t)layer * 1024 * 6144 + col0 + cx;
#pragma unroll 32
  for (int k = kg; k < 1024; k += 4) {
    float wv = w[(size_t)k * 6144];
#pragma unroll
    for (int r = 0; r < 5; ++r) acc[r] += sv[r * 1024 + k] * wv;
  }
  float* red = lds + 5120;
#pragma unroll
  for (int r = 0; r < 5; ++r) red[(kg * 5 + r) * 64 + cx] = acc[r];
  __syncthreads();
  if (tid < 64) {
    float* mod = (float*)(p.ws + OFF_MOD);
#pragma unroll
    for (int r = 0; r < 5; ++r) {
      float s = red[(0 * 5 + r) * 64 + tid] + red[(1 * 5 + r) * 64 + tid] + red[(2 * 5 + r) * 64 + tid] + red[(3 * 5 + r) * 64 + tid];
      mod[(size_t)(layer * 5 + r) * 6144 + col0 + tid] = s + p.in[5][layer * 6144 + col0 + tid];
    }
  }
  __syncthreads();
}

DI void filt_f1(const Params& p, int fid, int tile, float* lds) {
  const int tid = otid();
  const int layer = (fid == 1) ? 1 : 0;
  const int n = (fid < 2) ? 8192 : 256;
  const int pos0 = tile * 32;
  float* zf = lds;
  float* h1 = lds + 1056;
  float* h2 = h1 + 2048;
  const float* w1 = p.in[20] + layer * 33 * 64;
  const float* b1 = p.in[21] + layer * 64;
  const float* f1 = p.in[22] + layer * 64;
  const float* w2 = p.in[23] + layer * 4096;
  const float* b2 = p.in[24] + layer * 64;
  const float* f2 = p.in[25] + layer * 64;
  const float* w3 = p.in[26] + (size_t)layer * 64 * 1024;
  const float* b3 = p.in[27] + layer * 1024;
  for (int e = tid; e < 1056; e += 256) {
    int pp = e / 33, f = e % 33;
    float pos = (float)(pos0 + pp);
    float val;
    if (f == 0) val = pos / (float)(n - 1);
    else {
      int i = (f - 1) & 15;
      float fb = 1e-4f + (float)i * ((15.f - 1e-4f) / 15.f);
      float ang = ((6.2831855f * pos) * fb) / (float)n;
      val = (f <= 16) ? cosf(ang) : -sinf(ang);
    }
    zf[e] = val;
  }
  __syncthreads();
  {
    const int u = tid & 63;
    for (int q = 0; q < 8; ++q) {
      int pp = (tid >> 6) + 4 * q;
      float acc = b1[u];
      for (int f = 0; f < 33; ++f) acc += zf[pp * 33 + f] * w1[f * 64 + u];
      h1[pp * 64 + u] = sinf(f1[u] * acc);
    }
  }
  __syncthreads();
  {
    const int u = tid & 63;
    for (int q = 0; q < 8; ++q) {
      int pp = (tid >> 6) + 4 * q;
      float acc = b2[u];
      for (int k = 0; k < 64; ++k) acc += h1[pp * 64 + k] * w2[k * 64 + u];
      h2[pp * 64 + u] = sinf(f2[u] * acc);
    }
  }
  __syncthreads();
  const float dmin = -3.0701134573253945f, dmax = -15.350567286626973f;
  float* kraw = (float*)(p.ws + A_KRAW);
  float* kc = (float*)(p.ws + OFF_KC);
  float* part = (float*)(p.ws + OFF_PART);
  for (int q = 0; q < 4; ++q) {
    const int oc = tid + 256 * q, ch = oc & 255;
    float wc[64];
#pragma unroll
    for (int u = 0; u < 64; ++u) wc[u] = w3[u * 1024 + oc];
    const float bb = b3[oc];
    const float delta = fabsf(dmin + (dmax - dmin) * ((float)ch / 255.f));
    float ss = 0.f;
    float* obuf = lds + 5184;
    for (int pp = 0; pp < 32; ++pp) {
      float acc = bb;
#pragma unroll
      for (int u = 0; u < 64; ++u) acc += h2[pp * 64 + u] * wc[u];
      float t = (float)(pos0 + pp) / (float)(n - 1);
      float val = acc * expf(-t * delta);
      obuf[tid * 33 + pp] = val;
      ss += val * val;
    }
    part[((size_t)fid * 256 + tile) * 1024 + oc] = ss;
    __syncthreads();
#pragma unroll 4
    for (int r = 0; r < 32; ++r) {
      const int idx = tid + 256 * r, ol = idx >> 5, pp = idx & 31;
      const int oc2 = ol + 256 * q;
      float* dst = (fid < 2) ? (kraw + ((size_t)fid * 1024 + oc2) * 8192 + pos0) : (kc + (size_t)oc2 * 256 + pos0);
      dst[pp] = obuf[ol * 33 + pp];
    }
    __syncthreads();
  }
}

DI void filt_f2(const Params& p, int it, char* smem) {
  const int tid = otid();
  const int layer = it >> 9, order = (it >> 8) & 1, ch = it & 255;
  float2* X = (float2*)smem;
  float* red = (float*)(smem + 65536);
  const float* part = (const float*)(p.ws + OFF_PART);
  const int ocf = order * 512 + ch, ocb = ocf + 256;
  float v = part[((size_t)layer * 256 + tid) * 1024 + ocf] + part[((size_t)layer * 256 + tid) * 1024 + ocb];
  float tot = block_sum(v, red);
  const float scale = rsqrtf(tot + EPS);
  const float* kf = (const float*)(p.ws + A_KRAW) + ((size_t)layer * 1024 + ocf) * 8192;
  const float* kb = (const float*)(p.ws + A_KRAW) + ((size_t)layer * 1024 + ocb) * 8192;
  const float2* tw8 = (const float2*)(p.ws + OFF_TW8);
  const float2* tw16 = (const float2*)(p.ws + OFF_TW16);
  float2* H = (float2*)(p.ws + OFF_SPEC) + ((size_t)(layer * 2 + order) * 256 + ch) * SPEC_LD;
#pragma unroll 8
  for (int i = 0; i < 32; ++i) {
    int n = tid + 256 * i;
    float e = kf[n] + ((n >= 1) ? kb[8192 - n] : 0.f);
    X[n] = make_float2(e * scale, 0.f);
  }
  fft_fwd(X, tw8);
#pragma unroll 8
  for (int i = 0; i < 32; ++i) {
    int j = tid + 256 * i, k = brev13(j);
    if (k <= 4096) H[2 * k] = X[j];
  }
  __syncthreads();
#pragma unroll 8
  for (int i = 0; i < 32; ++i) {
    int n = tid + 256 * i;
    float o = (kf[n] - ((n >= 1) ? kb[8192 - n] : 0.f)) * scale;
    float2 w = tw16[n];
    X[n] = make_float2(o * w.x, o * w.y);
  }
  fft_fwd(X, tw8);
#pragma unroll 8
  for (int i = 0; i < 32; ++i) {
    int j = tid + 256 * i, k = brev13(j);
    if (k <= 4095) H[2 * k + 1] = X[j];
  }
  __syncthreads();
}

struct RowIn { f32x4 x0, x1, x2, x3; u32x2 y0, y1, y2, y3; };
DI RowIn row_load(int lane, const float* __restrict__ xsrc, const bf16* __restrict__ yrow, bool has_y) {
  RowIn r;
  r.x0 = *(const f32x4*)(xsrc + lane * 4); r.x1 = *(const f32x4*)(xsrc + lane * 4 + 256);
  r.x2 = *(const f32x4*)(xsrc + lane * 4 + 512); r.x3 = *(const f32x4*)(xsrc + lane * 4 + 768);
  if (has_y) {
    r.y0 = *(const u32x2*)(yrow + lane * 4); r.y1 = *(const u32x2*)(yrow + lane * 4 + 256);
    r.y2 = *(const u32x2*)(yrow + lane * 4 + 512); r.y3 = *(const u32x2*)(yrow + lane * 4 + 768);
  } else { r.y0 = u32x2{0u, 0u}; r.y1 = r.y0; r.y2 = r.y0; r.y3 = r.y0; }
  return r;
}
DI void rowpass(int lane, const RowIn& in, float* __restrict__ xdst,
                const float* __restrict__ wpost, const float* __restrict__ gate, bool has_y,
                const float* __restrict__ wpre, const float* __restrict__ scv, const float* __restrict__ shv, bool do_norm,
                bf16* __restrict__ hrow, const float* __restrict__ wdt, float* __restrict__ dtrow) {
  float xv[16] = {in.x0.x, in.x0.y, in.x0.z, in.x0.w, in.x1.x, in.x1.y, in.x1.z, in.x1.w,
                  in.x2.x, in.x2.y, in.x2.z, in.x2.w, in.x3.x, in.x3.y, in.x3.z, in.x3.w};
  if (has_y) {
    float yv[16];
    float ss = 0.f;
    {
      const unsigned yy[8] = {in.y0.x, in.y0.y, in.y1.x, in.y1.y, in.y2.x, in.y2.y, in.y3.x, in.y3.y};
#pragma unroll
      for (int q = 0; q < 8; ++q) { yv[2 * q] = __uint_as_float(yy[q] << 16); yv[2 * q + 1] = __uint_as_float(yy[q] & 0xffff0000u); }
    }
#pragma unroll
    for (int e = 0; e < 16; ++e) ss += yv[e] * yv[e];
    ss = wave_sum(ss);
    const float rstd = rsqrtf(ss * (1.f / 1024.f) + EPS);
#pragma unroll
    for (int q = 0; q < 4; ++q) {
      float4 g = *(const float4*)(gate + lane * 4 + 256 * q);
      float4 w = *(const float4*)(wpost + lane * 4 + 256 * q);
      xv[4 * q] += g.x * (yv[4 * q] * rstd * w.x);
      xv[4 * q + 1] += g.y * (yv[4 * q + 1] * rstd * w.y);
      xv[4 * q + 2] += g.z * (yv[4 * q + 2] * rstd * w.z);
      xv[4 * q + 3] += g.w * (yv[4 * q + 3] * rstd * w.w);
      *(float4*)(xdst + lane * 4 + 256 * q) = make_float4(xv[4 * q], xv[4 * q + 1], xv[4 * q + 2], xv[4 * q + 3]);
    }
  }
  if (do_norm) {
    float ss = 0.f;
#pragma unroll
    for (int e = 0; e < 16; ++e) ss += xv[e] * xv[e];
    ss = wave_sum(ss);
    const float rstd = rsqrtf(ss * (1.f / 1024.f) + EPS);
    float hv[16];
#pragma unroll
    for (int q = 0; q < 4; ++q) {
      float4 w = *(const float4*)(wpre + lane * 4 + 256 * q);
      float4 sc = *(const float4*)(scv + lane * 4 + 256 * q);
      float4 sh = *(const float4*)(shv + lane * 4 + 256 * q);
      hv[4 * q] = xv[4 * q] * rstd * w.x * (1.f + sc.x) + sh.x;
      hv[4 * q + 1] = xv[4 * q + 1] * rstd * w.y * (1.f + sc.y) + sh.y;
      hv[4 * q + 2] = xv[4 * q + 2] * rstd * w.z * (1.f + sc.z) + sh.z;
      hv[4 * q + 3] = xv[4 * q + 3] * rstd * w.w * (1.f + sc.w) + sh.w;
      uint2 o;
      o.x = pack2(hv[4 * q], hv[4 * q + 1]);
      o.y = pack2(hv[4 * q + 2], hv[4 * q + 3]);
      *(uint2*)(hrow + lane * 4 + 256 * q) = o;
    }
    if (wdt) {
      float d[8] = {0.f, 0.f, 0.f, 0.f, 0.f, 0.f, 0.f, 0.f};
#pragma unroll
      for (int q = 0; q < 4; ++q) {
#pragma unroll
        for (int dd = 0; dd < 8; ++dd) {
          float4 w = *(const float4*)(wdt + dd * 1028 + lane * 4 + 256 * q);
          d[dd] += hv[4 * q] * w.x + hv[4 * q + 1] * w.y + hv[4 * q + 2] * w.z + hv[4 * q + 3] * w.w;
        }
      }
#pragma unroll
      for (int k = 0; k < 8; ++k) d[k] = wave_sum(d[k]);
      if (lane == 0) {
        *(float4*)dtrow = make_float4(d[0], d[1], d[2], d[3]);
        *(float4*)(dtrow + 4) = make_float4(d[4], d[5], d[6], d[7]);
      }
    }
  }
}

DI void rowpass_phase(const Params& p, int layer, int mode, char* smem) {
  const int lane = otid() & 63, wave = otid() >> 6;
  const int nrows = (mode == 0 || layer == 0) ? MROWS : NLAT;
  const float* modb = (const float*)(p.ws + OFF_MOD);
  float* wl = (float*)smem;
  if (mode == 0 || (mode == 2 && layer + 1 < 2)) {
    const int nl = (mode == 0) ? layer : (layer + 1);
    const float* wsrc = p.in[10] + (size_t)nl * 1024 * 2568 + 768;
    for (int e = otid(); e < 8192; e += 256) wl[(e & 7) * 1028 + (e >> 3)] = wsrc[(size_t)(e >> 3) * 2568 + (e & 7)];
    __syncthreads();
  }
  const bool first = (layer == 0 && mode <= 1);
  const bool has_y = (mode != 0);
  const bf16* ybase = (const bf16*)(p.ws + A_YOUT);
  auto xsrc_of = [&](int row) -> const float* {
    if (row < NLAT) return first ? (p.in[0] + (size_t)row * 1024) : (p.out + (size_t)row * 1024);
    return first ? (p.in[2] + (size_t)(row - NLAT) * 1024) : ((const float*)(p.ws + OFF_CTXS) + (size_t)(row - NLAT) * 1024);
  };
  int r4 = blockIdx.x;
  if (r4 * 4 >= nrows) return;
  RowIn cur = row_load(lane, xsrc_of(r4 * 4 + wave), ybase + (size_t)(r4 * 4 + wave) * 1024, has_y);
  for (; r4 * 4 < nrows; r4 += gridDim.x) {
    const int row = r4 * 4 + wave;
    const int rn = row + 4 * (int)gridDim.x;
    RowIn nxt = cur;
    if (rn < nrows) nxt = row_load(lane, xsrc_of(rn), ybase + (size_t)rn * 1024, has_y);
    const int mb = (row < NLAT) ? (row >> 13) : 4;
    float* xdst = (row < NLAT) ? (p.out + (size_t)row * 1024) : ((float*)(p.ws + OFF_CTXS) + (size_t)(row - NLAT) * 1024);
    const float* mv = modb + (size_t)(layer * 5 + mb) * 6144;
    bf16* hrow = (bf16*)(p.ws + A_HBUF) + (size_t)row * 1024;
    float* dtrow = (float*)(p.ws + OFF_DT) + (size_t)row * 8;
    if (mode == 0) {
      rowpass(lane, cur, xdst, nullptr, nullptr, false, p.in[6] + layer * 1024, mv + 1024, mv, true, hrow, wl, dtrow);
    } else if (mode == 1) {
      rowpass(lane, cur, xdst, p.in[7] + layer * 1024, mv + 2048, true, p.in[8] + layer * 1024, mv + 4 * 1024, mv + 3 * 1024,
              true, hrow, nullptr, dtrow);
    } else {
      const bool nxtl = (layer + 1 < 2);
      const float* mvn = modb + (size_t)((layer + 1) * 5 + mb) * 6144;
      rowpass(lane, cur, xdst, p.in[9] + layer * 1024, mv + 5 * 1024, true, p.in[6] + (layer + 1) * 1024, mvn + 1024, mvn, nxtl,
              hrow, nxtl ? wl : nullptr, dtrow);
    }
    cur = nxt;
  }
}

DI void gload16(u32x4& dst, const bf16* sbase, unsigned voff) {
  asm volatile("global_load_dwordx4 %0, %1, %2" : "=&v"(dst) : "v"(voff), "s"(sbase) : "memory");
}
DI const bf16* uniform_ptr(const bf16* p) {
  unsigned long long v = (unsigned long long)p;
  unsigned lo = __builtin_amdgcn_readfirstlane((unsigned)v), hi = __builtin_amdgcn_readfirstlane((unsigned)(v >> 32));
  return (const bf16*)(((unsigned long long)hi << 32) | lo);
}
#define GEMM_GROUP(ks)                                                                         \
    {                                                                                          \
      bf16x8 a0 = *(const bf16x8*)(st + aoff + (ks) * 32);                                     \
      bf16x8 a1 = *(const bf16x8*)(st + aoff + 32 * 144 + (ks) * 32);                          \
      bf16x8 b0 = *(const bf16x8*)(st + boff + (ks) * 32);                                     \
      bf16x8 b1 = *(const bf16x8*)(st + boff + 32 * 144 + (ks) * 32);                          \
      acc00 = MFMA(a0, b0, acc00);                                                             \
      acc01 = MFMA(a0, b1, acc01);                                                             \
      acc10 = MFMA(a1, b0, acc10);                                                             \
      acc11 = MFMA(a1, b1, acc11);                                                             \
    }
#define GEMM_ITER(KT_, LA, LB, SA, SB)                                                        \
  {                                                                                            \
    const int kt_ = (KT_);                                                                     \
    const char* st = smem + (kt_ & 1) * 36864;                                                 \
    char* sn = smem + ((kt_ + 1) & 1) * 36864;                                                 \
    GEMM_GROUP(0)                                                                              \
    if (kt_ + 2 < KT) {                                                                        \
      gload16(LA[0], As + (kt_ + 2) * 64, voa);               gload16(LB[0], Bs + (kt_ + 2) * 64, vob);  \
      gload16(LA[1], As + (kt_ + 2) * 64, voa + sa32);        gload16(LB[1], Bs + (kt_ + 2) * 64, vob + sb32); \
    }                                                                                          \
    __builtin_amdgcn_sched_barrier(0);                                                         \
    GEMM_GROUP(1)                                                                              \
    if (kt_ + 2 < KT) {                                                                        \
      gload16(LA[2], As + (kt_ + 2) * 64, voa + 2 * sa32);    gload16(LB[2], Bs + (kt_ + 2) * 64, vob + 2 * sb32); \
      gload16(LA[3], As + (kt_ + 2) * 64, voa + 3 * sa32);    gload16(LB[3], Bs + (kt_ + 2) * 64, vob + 3 * sb32); \
    }                                                                                          \
    __builtin_amdgcn_sched_barrier(0);                                                         \
    if (kt_ + 2 < KT) asm volatile("s_waitcnt vmcnt(8)" ::: "memory");                         \
    else asm volatile("s_waitcnt vmcnt(0)" ::: "memory");                                      \
    GEMM_GROUP(2)                                                                              \
    if (kt_ + 1 < KT) {                                                                        \
      *(u32x4*)(sn + soff) = SA[0];                  *(u32x4*)(sn + 18432 + soff) = SB[0];     \
      *(u32x4*)(sn + soff + 32 * 144) = SA[1];       *(u32x4*)(sn + 18432 + soff + 32 * 144) = SB[1]; \
    }                                                                                          \
    __builtin_amdgcn_sched_barrier(0);                                                         \
    GEMM_GROUP(3)                                                                              \
    if (kt_ + 1 < KT) {                                                                        \
      *(u32x4*)(sn + soff + 64 * 144) = SA[2];       *(u32x4*)(sn + 18432 + soff + 64 * 144) = SB[2]; \
      *(u32x4*)(sn + soff + 96 * 144) = SA[3];       *(u32x4*)(sn + 18432 + soff + 96 * 144) = SB[3]; \
    }                                                                                          \
    __builtin_amdgcn_sched_barrier(0);                                                         \
    __syncthreads();                                                                           \
  }

DI void gemm_tile(const bf16* __restrict__ A, int lda, const bf16* __restrict__ Bt, int ldb, int K, char* smem) {
  const int tid = otid(), lane = tid & 63, wave = tid >> 6, r = lane & 31, h = lane >> 5, wm = wave >> 1, wn = wave & 1;
  const int lrow = tid >> 3, lkc = tid & 7;
  const bf16* ag = A + (size_t)lrow * lda + lkc * 8;
  const bf16* bg = Bt + (size_t)lrow * ldb + lkc * 8;
  const size_t lda32 = (size_t)32 * lda, ldb32 = (size_t)32 * ldb;
  const int soff = lrow * 144 + lkc * 16;
  const int aoff = (wm * 64 + r) * 144 + h * 16;
  const int boff = 18432 + (wn * 64 + r) * 144 + h * 16;
  const int KT = K >> 6;
  u32x4 ra0[4], rb0[4], ra1[4], rb1[4];
#pragma unroll
  for (int i = 0; i < 4; ++i) {
    ra0[i] = *(const u32x4*)(ag + i * lda32);
    rb0[i] = *(const u32x4*)(bg + i * ldb32);
  }
#pragma unroll
  for (int i = 0; i < 4; ++i) {
    *(u32x4*)(smem + soff + i * 32 * 144) = ra0[i];
    *(u32x4*)(smem + 18432 + soff + i * 32 * 144) = rb0[i];
  }
  const bf16* As = uniform_ptr(A);
  const bf16* Bs = uniform_ptr(Bt);
  const unsigned voa = (unsigned)(lrow * lda + lkc * 8) * 2u, vob = (unsigned)(lrow * ldb + lkc * 8) * 2u;
  const unsigned sa32 = (unsigned)lda * 64u, sb32 = (unsigned)ldb * 64u;
#pragma unroll
  for (int i = 0; i < 4; ++i) {
    gload16(ra1[i], As + 64, voa + i * sa32);
    gload16(rb1[i], Bs + 64, vob + i * sb32);
  }
  __syncthreads();
  f32x16 acc00, acc01, acc10, acc11;
#pragma unroll
  for (int e = 0; e < 16; ++e) { acc00[e] = 0.f; acc01[e] = 0.f; acc10[e] = 0.f; acc11[e] = 0.f; }
#pragma unroll 1
  for (int kt = 0; kt < KT; kt += 2) {
    GEMM_ITER(kt, ra0, rb0, ra1, rb1)
    GEMM_ITER(kt + 1, ra1, rb1, ra0, rb0)
  }
  float* Cs = (float*)smem;
#pragma unroll
  for (int e = 0; e < 16; ++e) {
    const int rr = (e & 3) + 8 * (e >> 2) + 4 * h;
    Cs[(wm * 64 + rr) * 132 + wn * 64 + r] = acc00[e];
    Cs[(wm * 64 + rr) * 132 + wn * 64 + 32 + r] = acc01[e];
    Cs[(wm * 64 + 32 + rr) * 132 + wn * 64 + r] = acc10[e];
    Cs[(wm * 64 + 32 + rr) * 132 + wn * 64 + 32 + r] = acc11[e];
  }
  __syncthreads();
}

DI void epi_store_bf16(const float* Cs, bf16* __restrict__ dst, int ld, bool sqrelu) {
  const int tid = otid();
#pragma unroll
  for (int i = 0; i < 8; ++i) {
    int c = tid + 256 * i;
    int row = c >> 4, cc = (c & 15) * 8;
    float4 v0 = *(const float4*)(Cs + row * 132 + cc);
    float4 v1 = *(const float4*)(Cs + row * 132 + cc + 4);
    if (sqrelu) {
      v0.x = fmaxf(v0.x, 0.f); v0.x *= v0.x; v0.y = fmaxf(v0.y, 0.f); v0.y *= v0.y;
      v0.z = fmaxf(v0.z, 0.f); v0.z *= v0.z; v0.w = fmaxf(v0.w, 0.f); v0.w *= v0.w;
      v1.x = fmaxf(v1.x, 0.f); v1.x *= v1.x; v1.y = fmaxf(v1.y, 0.f); v1.y *= v1.y;
      v1.z = fmaxf(v1.z, 0.f); v1.z *= v1.z; v1.w = fmaxf(v1.w, 0.f); v1.w *= v1.w;
    }
    uint4 o;
    o.x = pack2(v0.x, v0.y); o.y = pack2(v0.z, v0.w); o.z = pack2(v1.x, v1.y); o.w = pack2(v1.z, v1.w);
    *(uint4*)(dst + (size_t)row * ld + cc) = o;
  }
}
DI void epi_store_tr(const float* Cs, bf16* __restrict__ dst, size_t ldc) {
  const int tid = otid(), pcl = tid & 3, colb = tid >> 2;
#pragma unroll
  for (int i = 0; i < 8; ++i) {
    const int col = colb + 64 * (i & 1);
    const int pc = pcl + 4 * (i >> 1);
    float v[8];
#pragma unroll
    for (int e = 0; e < 8; ++e) v[e] = Cs[(pc * 8 + e) * 132 + col];
    uint4 o;
    o.x = pack2(v[0], v[1]); o.y = pack2(v[2], v[3]); o.z = pack2(v[4], v[5]); o.w = pack2(v[6], v[7]);
    *(uint4*)(dst + (size_t)col * ldc + pc * 8) = o;
  }
}

DI void gemm1_epilogue(const Params& p, int layer, int m0, int nt, const float* Cs) {
  const int tid = otid();
  const bool is_ctx = (m0 >= NLAT);
  const int b = is_ctx ? ((m0 - NLAT) >> 8) : (m0 >> 13);
  const int pos0 = is_ctx ? ((m0 - NLAT) & 255) : (m0 & 8191);
  if (nt < 6) {
    epi_store_bf16(Cs, (bf16*)(p.ws + A_PROJA) + (size_t)m0 * 768 + nt * 128, 768, false);
  } else if (nt < 12) {
    const int ch0 = (nt - 6) * 128;
    if (!is_ctx) epi_store_tr(Cs, (bf16*)(p.ws + A_HYRAW) + ((size_t)(b * 768 + ch0)) * 8192 + pos0, 8192);
    else epi_store_tr(Cs, (bf16*)(p.ws + A_HYRAWC) + ((size_t)(b * 768 + ch0)) * 256 + pos0, 256);
  } else {
    const int g = (nt - 12) >> 2, tt = (nt - 12) & 3;
    const int kpos0 = is_ctx ? (SEQ + pos0) : pos0;
    if (tt == 3) {
      bf16* dst = (bf16*)(p.ws + A_VT) + ((size_t)((g * 4 + b) * 2) * 64) * KEYS + kpos0;
      epi_store_tr(Cs, dst, KEYS);
    } else {
      const int row = tid & 127, hh = tid >> 7;
      float v[64];
#pragma unroll
      for (int d4 = 0; d4 < 16; ++d4) {
        float4 t = *(const float4*)(Cs + row * 132 + hh * 64 + d4 * 4);
        v[d4 * 4] = t.x; v[d4 * 4 + 1] = t.y; v[d4 * 4 + 2] = t.z; v[d4 * 4 + 3] = t.w;
      }
      const bool isq = (tt < 2);
      if (g == 1) {
        const float* wn = (isq ? p.in[30] : p.in[31]) + layer * 64;
        float ss = 0.f;
#pragma unroll
        for (int d = 0; d < 64; ++d) ss += v[d] * v[d];
        const float rstd = rsqrtf(ss * (1.f / 64.f) + EPS);
#pragma unroll
        for (int d = 0; d < 64; ++d) v[d] = v[d] * rstd * wn[d];
      }
      if (!is_ctx) {
        constexpr float kInvRev[16] = {
            1.591549431e-01f, 8.949940161e-02f, 5.032921210e-02f, 2.830219583e-02f, 1.591549431e-02f, 8.949940161e-03f, 5.032921210e-03f, 2.830219583e-03f, 1.591549431e-03f, 8.949940161e-04f, 5.032921210e-04f, 2.830219583e-04f, 1.591549431e-04f, 8.949940161e-05f, 5.032921210e-05f, 2.830219583e-05f};
        const float frow = (float)((pos0 + row) >> 6), fcol = (float)((pos0 + row) & 63);
#pragma unroll
        for (int i = 0; i < 32; ++i) {
          const float rev = ((i < 16) ? frow : fcol) * kInvRev[i & 15];
          const float cs_x = __builtin_amdgcn_cosf(rev), cs_y = __builtin_amdgcn_sinf(rev);
          float a = v[i], bb = v[i + 32];
          v[i] = a * cs_x - bb * cs_y;
          v[i + 32] = a * cs_y + bb * cs_x;
        }
      }
      bf16* dst;
      if (isq) {
        const int head = tt * 2 + hh;
#pragma unroll
        for (int d = 0; d < 64; ++d) v[d] *= (0.125f * LOG2E);
        dst = (bf16*)(p.ws + A_QB) + ((size_t)((g * 4 + b) * 4 + head) * KEYS + kpos0 + row) * 64;
      } else {
        dst = (bf16*)(p.ws + A_KB) + ((size_t)((g * 4 + b) * 2 + hh) * KEYS + kpos0 + row) * 64;
      }
#pragma unroll
      for (int c = 0; c < 8; ++c) {
        uint4 o;
        o.x = pack2(v[c * 8], v[c * 8 + 1]); o.y = pack2(v[c * 8 + 2], v[c * 8 + 3]);
        o.z = pack2(v[c * 8 + 4], v[c * 8 + 5]); o.w = pack2(v[c * 8 + 6], v[c * 8 + 7]);
        *(uint4*)(dst + c * 8) = o;
      }
    }
  }
}

DI void gemm_epilogue(const Params& p, int layer, int which, int mt, int mt_lo, int nt, const float* Cs) {
  if (which == 1) gemm1_epilogue(p, layer, mt * 128, nt, Cs);
  else if (which == 2) epi_store_bf16(Cs, (bf16*)(p.ws + A_YOUT) + (size_t)(mt * 128) * 1024 + nt * 128, 1024, false);
  else if (which == 3) epi_store_bf16(Cs, (bf16*)(p.ws + A_HID) + (size_t)((mt - mt_lo) * 128) * 4096 + nt * 128, 4096, true);
  else epi_store_bf16(Cs, (bf16*)(p.ws + A_YOUT) + (size_t)(mt * 128) * 1024 + nt * 128, 1024, false);
}

DI void glds16(const bf16* sbase, unsigned voff, unsigned lds_dst) {
  unsigned keep;
  asm volatile("s_mov_b32 %0, m0\n\ts_mov_b32 m0, %3\n\ts_nop 0\n\tglobal_load_lds_dwordx4 %1, %2\n\ts_mov_b32 m0, %0"
               : "=&s"(keep) : "v"(voff), "s"(sbase), "s"(lds_dst) : "memory");
}
#define G2_GROUP(AO, BO)                                                                       \
    {                                                                                          \
      bf16x8 a0 = *(const bf16x8*)(st + (AO));                                                 \
      bf16x8 a1 = *(const bf16x8*)(st + (AO) + 2048);                                          \
      bf16x8 b0 = *(const bf16x8*)(st + (BO));                                                 \
      bf16x8 b1 = *(const bf16x8*)(st + (BO) + 2048);                                          \
      bf16x8 b2 = *(const bf16x8*)(st + (BO) + 4096);                                          \
      bf16x8 b3 = *(const bf16x8*)(st + (BO) + 6144);                                          \
      c00 = MFMA(a0, b0, c00); c01 = MFMA(a0, b1, c01); c02 = MFMA(a0, b2, c02); c03 = MFMA(a0, b3, c03); \
      c10 = MFMA(a1, b0, c10); c11 = MFMA(a1, b1, c11); c12 = MFMA(a1, b2, c12); c13 = MFMA(a1, b3, c13); \
    }
#define G2_DMA(KT_, STG)                                                                       \
  {                                                                                            \
    const unsigned lb_ = ldsbase + (STG) * 24576u;                                             \
    glds16(As + (KT_) * 32, voa0, lb_ + wq * 2048u);                                           \
    glds16(As + (KT_) * 32, voa0 + ra16, lb_ + wq * 2048u + 1024u);                            \
    glds16(Bs + (KT_) * 32, vob0, lb_ + 8192u + wq * 4096u);                                   \
    glds16(Bs + (KT_) * 32, vob0 + rb16, lb_ + 8192u + wq * 4096u + 1024u);                    \
    glds16(Bs + (KT_) * 32, vob0 + 2 * rb16, lb_ + 8192u + wq * 4096u + 2048u);                \
    glds16(Bs + (KT_) * 32, vob0 + 3 * rb16, lb_ + 8192u + wq * 4096u + 3072u);                \
  }

DI void gemm_tile2(const Params& p, int layer, int which, int mt, int mt_lo, int nt2, const bf16* __restrict__ A, int lda,
                   const bf16* __restrict__ Bt, int ldb, int K, char* smem) {
  const int tid = otid(), lane = tid & 63, wave = tid >> 6, r = lane & 31, h = lane >> 5, wm = wave >> 1, wn = wave & 1;
  const unsigned wq = (unsigned)__builtin_amdgcn_readfirstlane(wave);
  const unsigned ldsbase = (unsigned)(size_t)(LAS char*)smem;
  const bf16* As = uniform_ptr(A);
  const bf16* Bs = uniform_ptr(Bt);
  const int lr = lane >> 2, cp = lane & 3, gc = cp ^ ((lr >> 2) & 3);
  const unsigned voa0 = (unsigned)((wave * 32 + lr) * lda + gc * 8) * 2u;
  const unsigned vob0 = (unsigned)((wave * 64 + lr) * ldb + gc * 8) * 2u;
  const unsigned ra16 = (unsigned)lda * 32u, rb16 = (unsigned)ldb * 32u;
  const int sw = (r >> 2) & 3;
  const int cx0 = ((h ^ sw) * 16), cx1 = (((2 + h) ^ sw) * 16);
  const int arow = (wm * 64 + r) * 64, brow = 8192 + (wn * 128 + r) * 64;
  const int KT = K >> 5;
  G2_DMA(0, 0u)
  G2_DMA(1, 1u)
  asm volatile("s_waitcnt vmcnt(6)" ::: "memory");
  __syncthreads();
  f32x16 c00, c01, c02, c03, c10, c11, c12, c13;
#pragma unroll
  for (int e = 0; e < 16; ++e) { c00[e] = 0.f; c01[e] = 0.f; c02[e] = 0.f; c03[e] = 0.f; c10[e] = 0.f; c11[e] = 0.f; c12[e] = 0.f; c13[e] = 0.f; }
  unsigned cur = 0u, nx2 = 2u;
#pragma unroll 1
  for (int kt = 0; kt < KT; ++kt) {
    if (kt + 2 < KT) G2_DMA(kt + 2, nx2)
    __builtin_amdgcn_sched_barrier(0);
    const char* st = smem + cur * 24576u;
    G2_GROUP(arow + cx0, brow + cx0)
    G2_GROUP(arow + cx1, brow + cx1)
    __builtin_amdgcn_sched_barrier(0);
    if (kt + 2 < KT) asm volatile("s_waitcnt vmcnt(6)" ::: "memory");
    else asm volatile("s_waitcnt vmcnt(0)" ::: "memory");
    __syncthreads();
    cur = (cur == 2u) ? 0u : cur + 1u;
    nx2 = (nx2 == 2u) ? 0u : nx2 + 1u;
  }
  float* Cs = (float*)smem;
#pragma unroll 1
  for (int nh = 0; nh < 2; ++nh) {
    if (wn == nh) {
#pragma unroll
      for (int e = 0; e < 16; ++e) {
        const int rr = (e & 3) + 8 * (e >> 2) + 4 * h;
        float* c0 = Cs + (wm * 64 + rr) * 132 + r;
        float* c1 = Cs + (wm * 64 + 32 + rr) * 132 + r;
        c0[0] = c00[e]; c0[32] = c01[e]; c0[64] = c02[e]; c0[96] = c03[e];
        c1[0] = c10[e]; c1[32] = c11[e]; c1[64] = c12[e]; c1[96] = c13[e];
      }
    }
    __syncthreads();
    gemm_epilogue(p, layer, which, mt, mt_lo, nt2 * 2 + nh, Cs);
    __syncthreads();
  }
}

DI void gemm_phase(const Params& p, int layer, int which, int half, char* smem) {
  const int mt_all = ((which == 1 || layer == 0) ? MROWS : NLAT) / 128;
  const int mt_lo = (which >= 3 && half) ? 128 : 0;
  const int mt_hi = (which >= 3 && !half) ? 128 : mt_all;
  const int mt_big_hi = (which == 1) ? mt_lo : ((mt_hi < 256) ? mt_hi : 256);
  int NT, K, lda, ldb;
  const bf16 *A, *Bt;
  if (which == 1) { NT = 20; K = 1024; A = (const bf16*)(p.ws + A_HBUF); lda = 1024; Bt = (const bf16*)(p.ws + OFF_WIN) + (size_t)layer * 2560 * 1024; ldb = 1024; }
  else if (which == 2) { NT = 8; K = 1024; A = (const bf16*)(p.ws + A_YMIX); lda = 1024; Bt = (const bf16*)(p.ws + OFF_WOUT) + (size_t)layer * 1024 * 1024; ldb = 1024; }
  else if (which == 3) { NT = 32; K = 1024; A = (const bf16*)(p.ws + A_HBUF); lda = 1024; Bt = (const bf16*)(p.ws + OFF_W1) + (size_t)layer * 4096 * 1024; ldb = 1024; }
  else { NT = 8; K = 4096; A = (const bf16*)(p.ws + A_HID) - (size_t)mt_lo * 128 * 4096; lda = 4096; Bt = (const bf16*)(p.ws + OFF_W2) + (size_t)layer * 1024 * 4096; ldb = 4096; }
  const int NT2 = NT >> 1;
  const int nbig = (mt_big_hi - mt_lo) * NT2;
  if (which != 1)
  for (int t = blockIdx.x; t < nbig; t += gridDim.x) {
    const int mt = mt_lo + t / NT2, nt2 = t % NT2;
    gemm_tile2(p, layer, which, mt, mt_lo, nt2, A + (size_t)mt * 128 * lda, lda, Bt + (size_t)nt2 * 256 * ldb, ldb, K, smem);
  }
  const int nsmall = (mt_hi - mt_big_hi) * NT;
  for (int t = blockIdx.x; t < nsmall; t += gridDim.x) {
    const int mt = mt_big_hi + t / NT, nt = t % NT;
    gemm_tile(A + (size_t)mt * 128 * lda, lda, Bt + (size_t)nt * 128 * ldb, ldb, K, smem);
    gemm_epilogue(p, layer, which, mt, mt_lo, nt, (const float*)smem);
    __syncthreads();
  }
}

DI void attn_item(const bf16* __restrict__ Q, const bf16* __restrict__ Kb, const bf16* __restrict__ VT, int q0, int lo, int hi,
                  int nctx_tiles, bool window, bool has_sink, float sink_l2, bf16* __restrict__ out, char* smem) {
  const int tid = otid(), lane = tid & 63, wave = tid >> 6, r = lane & 31, h = lane >> 5;
  bf16x8 qf[4];
  {
    const bf16* qp = Q + (size_t)(q0 + wave * 32 + r) * 64 + h * 8;
#pragma unroll
    for (int ks = 0; ks < 4; ++ks) qf[ks] = *(const bf16x8*)(qp + ks * 16);
  }
  const int ntl = (hi - lo) >> 6;
  const int nt = ntl + nctx_tiles;
  f32x16 o0, o1;
#pragma unroll
  for (int e = 0; e < 16; ++e) { o0[e] = 0.f; o1[e] = 0.f; }
  float m = has_sink ? sink_l2 : -1e30f;
  float l = (has_sink && h == 0) ? 1.f : 0.f;
  const int qpos = q0 + wave * 32 + r;
  const int c0 = tid, c1 = tid + 256;
  const int lr0 = c0 >> 3, lk0 = c0 & 7, lr1 = c1 >> 3, lk1 = c1 & 7;
  uint4 rk0, rk1, rv0, rv1;
  {
    int key0 = (0 < ntl) ? lo : SEQ;
    rk0 = *(const uint4*)(Kb + (size_t)(key0 + lr0) * 64 + lk0 * 8);
    rk1 = *(const uint4*)(Kb + (size_t)(key0 + lr1) * 64 + lk1 * 8);
    rv0 = *(const uint4*)(VT + (size_t)lr0 * KEYS + key0 + lk0 * 8);
    rv1 = *(const uint4*)(VT + (size_t)lr1 * KEYS + key0 + lk1 * 8);
  }
  *(uint4*)(smem + lr0 * 144 + lk0 * 16) = rk0;
  *(uint4*)(smem + lr1 * 144 + lk1 * 16) = rk1;
  *(uint4*)(smem + 9216 + lr0 * 144 + lk0 * 16) = rv0;
  *(uint4*)(smem + 9216 + lr1 * 144 + lk1 * 16) = rv1;
  __syncthreads();
  for (int ti = 0; ti < nt; ++ti) {
    const int key0 = (ti < ntl) ? (lo + ti * 64) : (SEQ + (ti - ntl) * 64);
    if (ti + 1 < nt) {
      const int kn = (ti + 1 < ntl) ? (lo + (ti + 1) * 64) : (SEQ + (ti + 1 - ntl) * 64);
      rk0 = *(const uint4*)(Kb + (size_t)(kn + lr0) * 64 + lk0 * 8);
      rk1 = *(const uint4*)(Kb + (size_t)(kn + lr1) * 64 + lk1 * 8);
      rv0 = *(const uint4*)(VT + (size_t)lr0 * KEYS + kn + lk0 * 8);
      rv1 = *(const uint4*)(VT + (size_t)lr1 * KEYS + kn + lk1 * 8);
    }
    __builtin_amdgcn_sched_barrier(0);
    const char* Ks = smem + (ti & 1) * 18432;
    const char* Vs = Ks + 9216;
    f32x16 s0, s1;
#pragma unroll
    for (int e = 0; e < 16; ++e) { s0[e] = 0.f; s1[e] = 0.f; }
#pragma unroll
    for (int ks = 0; ks < 4; ++ks) {
      bf16x8 a0 = *(const bf16x8*)(Ks + r * 144 + ks * 32 + h * 16);
      bf16x8 a1 = *(const bf16x8*)(Ks + (32 + r) * 144 + ks * 32 + h * 16);
      s0 = MFMA(a0, qf[ks], s0);
      s1 = MFMA(a1, qf[ks], s1);
    }
    if (window && key0 < SEQ) {
#pragma unroll
      for (int e = 0; e < 16; ++e) {
        int kp = key0 + (e & 3) + 8 * (e >> 2) + 4 * h;
        int d0 = qpos - kp; d0 = d0 < 0 ? -d0 : d0;
        int d1 = qpos - (kp + 32); d1 = d1 < 0 ? -d1 : d1;
        if (d0 > 128) s0[e] = -1e30f;
        if (d1 > 128) s1[e] = -1e30f;
      }
    }
    float mx = s0[0];
#pragma unroll
    for (int e = 1; e < 16; ++e) mx = fmaxf(mx, s0[e]);
#pragma unroll
    for (int e = 0; e < 16; ++e) mx = fmaxf(mx, s1[e]);
    mx = fmaxf(mx, __shfl_xor(mx, 32));
    const float mnew = fmaxf(m, mx);
    const float alpha = __builtin_amdgcn_exp2f(m - mnew);
    m = mnew;
    float ls = 0.f;
#pragma unroll
    for (int e = 0; e < 16; ++e) {
      s0[e] = __builtin_amdgcn_exp2f(s0[e] - mnew);
      s1[e] = __builtin_amdgcn_exp2f(s1[e] - mnew);
      ls += s0[e] + s1[e];
    }
    l = l * alpha + ls;
#pragma unroll
    for (int e = 0; e < 16; ++e) { o0[e] *= alpha; o1[e] *= alpha; }
#pragma unroll
    for (int kb = 0; kb < 2; ++kb) {
#pragma unroll
      for (int s2 = 0; s2 < 2; ++s2) {
        unsigned pk[4];
#pragma unroll
        for (int j = 0; j < 4; ++j) {
          float x0 = kb ? s1[8 * s2 + 2 * j] : s0[8 * s2 + 2 * j];
          float x1 = kb ? s1[8 * s2 + 2 * j + 1] : s0[8 * s2 + 2 * j + 1];
          pk[j] = pack2(x0, x1);
        }
        uint4 pku = make_uint4(pk[0], pk[1], pk[2], pk[3]);
        bf16x8 pf = __builtin_bit_cast(bf16x8, pku);
        const char* vb = Vs + r * 144 + (kb * 32 + 16 * s2 + 4 * h) * 2;
        s16x4 lo0 = *(const s16x4*)(vb);
        s16x4 hi0 = *(const s16x4*)(vb + 16);
        s16x4 lo1 = *(const s16x4*)(vb + 32 * 144);
        s16x4 hi1 = *(const s16x4*)(vb + 32 * 144 + 16);
        bf16x8 v0 = __builtin_shufflevector(lo0, hi0, 0, 1, 2, 3, 4, 5, 6, 7);
        bf16x8 v1 = __builtin_shufflevector(lo1, hi1, 0, 1, 2, 3, 4, 5, 6, 7);
        o0 = MFMA(v0, pf, o0);
        o1 = MFMA(v1, pf, o1);
      }
    }
    if (ti + 1 < nt) {
      char* sn = smem + ((ti + 1) & 1) * 18432;
      *(uint4*)(sn + lr0 * 144 + lk0 * 16) = rk0;
      *(uint4*)(sn + lr1 * 144 + lk1 * 16) = rk1;
      *(uint4*)(sn + 9216 + lr0 * 144 + lk0 * 16) = rv0;
      *(uint4*)(sn + 9216 + lr1 * 144 + lk1 * 16) = rv1;
    }
    __syncthreads();
  }
  const float lt = l + __shfl_xor(l, 32);
  const float inv = 1.f / lt;
  bf16* Os = (bf16*)(smem + 36864);
  {
    const int q = wave * 32 + r;
#pragma unroll
    for (int e = 0; e < 16; e += 2) {
      int d = (e & 3) + 8 * (e >> 2) + 4 * h;
      *(unsigned*)(Os + q * 72 + d) = pack2(o0[e] * inv, o0[e + 1] * inv);
      *(unsigned*)(Os + q * 72 + 32 + d) = pack2(o1[e] * inv, o1[e + 1] * inv);
    }
  }
  __syncthreads();
#pragma unroll
  for (int i = 0; i < 4; ++i) {
    int c = tid + 256 * i;
    int row = c >> 3, ch = c & 7;
    *(uint4*)(out + (size_t)row * 1024 + ch * 8) = *(const uint4*)(Os + row * 72 + ch * 8);
  }
  __syncthreads();
}

DI float conv3_at(const bf16* __restrict__ raw, int n, int len, float w0, float w1, float w2, float bb) {
  const int nm = (n >= 1) ? (n - 1) : 0, np = (n + 1 < len) ? (n + 1) : (len - 1);
  const float vm = bf2f(raw[nm]), v0 = bf2f(raw[n]), vp = bf2f(raw[np]);
  return bb + w1 * v0 + ((n >= 1) ? w0 * vm : 0.f) + ((n + 1 < len) ? w2 * vp : 0.f);
}

DI void hyena_fft_item(const Params& p, int layer, int it, char* smem) {
  const int tid = otid();
  const int ch = it & 255, bp = it >> 8, b0 = 2 * bp, b1 = b0 + 1;
  float2* X = (float2*)smem;
  const bf16* hyraw = (const bf16*)(p.ws + A_HYRAW);
  const float* cw = p.in[18] + layer * 3 * 768;
  const float* cb = p.in[19] + layer * 768;
  const float* hb = p.in[28] + layer * 2 * 256;
  const float2* tw8 = (const float2*)(p.ws + OFF_TW8);
  const float2* tw16 = (const float2*)(p.ws + OFF_TW16);
  bf16* ho0 = (bf16*)(p.ws + A_HYOUT) + ((size_t)(b0 * 256 + ch)) * 8192;
  bf16* ho1 = (bf16*)(p.ws + A_HYOUT) + ((size_t)(b1 * 256 + ch)) * 8192;
  float2* escr = (blockIdx.x < 256) ? ((float2*)(p.ws + A_ESCR0) + (size_t)blockIdx.x * 8192)
                                    : ((float2*)(p.ws + A_ESCR1) + (size_t)(blockIdx.x - 256) * 8192);
  const float vw0 = cw[ch], vw1 = cw[768 + ch], vw2 = cw[1536 + ch], vbb = cb[ch];
  const bf16* r0 = hyraw + ((size_t)(b0 * 768 + ch)) * 8192;
  const bf16* r1 = hyraw + ((size_t)(b1 * 768 + ch)) * 8192;
#pragma unroll 1
  for (int o = 0; o < 2; ++o) {
    const float2* Hl = (const float2*)(p.ws + OFF_SPEC) + ((size_t)(layer * 2 + o) * 256 + ch) * SPEC_LD;
#pragma unroll 8
    for (int i = 0; i < 32; ++i) {
      int n = tid + 256 * i;
      float za, zb;
      if (o == 0) {
        const bf16 qa = f2bf(conv3_at(r0, n, 8192, vw0, vw1, vw2, vbb)), qb = f2bf(conv3_at(r1, n, 8192, vw0, vw1, vw2, vbb));
        ho0[n] = qa; ho1[n] = qb;
        za = bf2f(qa); zb = bf2f(qb);
      } else { za = bf2f(ho0[n]); zb = bf2f(ho1[n]); }
      X[n] = make_float2(za, zb);
    }
    fft_fwd(X, tw8);
#pragma unroll 8
    for (int i = 0; i < 32; ++i) {
      int j = tid + 256 * i, mI = 2 * brev13(j);
      float2 hv = (mI <= 8192) ? Hl[mI] : Hl[16384 - mI];
      if (mI > 8192) hv.y = -hv.y;
      float2 x = X[j];
      X[j] = make_float2(x.x * hv.x - x.y * hv.y, x.x * hv.y + x.y * hv.x);
    }
    fft_inv(X, tw8);
#pragma unroll 8
    for (int i = 0; i < 32; ++i) escr[tid + 256 * i] = X[tid + 256 * i];
#pragma unroll 8
    for (int i = 0; i < 32; ++i) {
      int n = tid + 256 * i;
      const float za = bf2f(ho0[n]), zb = bf2f(ho1[n]);
      float2 w = tw16[n];
      X[n] = make_float2(za * w.x - zb * w.y, za * w.y + zb * w.x);
    }
    fft_fwd(X, tw8);
#pragma unroll 8
    for (int i = 0; i < 32; ++i) {
      int j = tid + 256 * i, mI = 2 * brev13(j) + 1;
      float2 hv = (mI <= 8192) ? Hl[mI] : Hl[16384 - mI];
      if (mI > 8192) hv.y = -hv.y;
      float2 x = X[j];
      X[j] = make_float2(x.x * hv.x - x.y * hv.y, x.x * hv.y + x.y * hv.x);
    }
    fft_inv(X, tw8);
    {
      const int gc = (o + 1) * 256 + ch;
      const float w0 = cw[gc], w1 = cw[768 + gc], w2 = cw[1536 + gc], bb = cb[gc];
      const bf16* g0p = hyraw + ((size_t)(b0 * 768 + gc)) * 8192;
      const bf16* g1p = hyraw + ((size_t)(b1 * 768 + gc)) * 8192;
      const float bias = hb[o * 256 + ch];
#pragma unroll 8
      for (int i = 0; i < 32; ++i) {
        int n = tid + 256 * i;
        const float za = bf2f(ho0[n]), zb = bf2f(ho1[n]);
        float2 x = X[n];
        float2 w = tw16[n];
        float2 ev = escr[n];
        float cr = (ev.x + x.x * w.x + x.y * w.y) * (1.f / 16384.f);
        float ci = (ev.y + x.y * w.x - x.x * w.y) * (1.f / 16384.f);
        float g0 = conv3_at(g0p, n, 8192, w0, w1, w2, bb);
        float g1 = conv3_at(g1p, n, 8192, w0, w1, w2, bb);
        ho0[n] = f2bf(g0 * (cr + za * bias));
        ho1[n] = f2bf(g1 * (ci + zb * bias));
      }
    }
    __syncthreads();
  }
}

DI void hyena_ctx_item(const Params& p, int layer, int ch, float* lds) {
  const int tid = otid();
  float* kf = lds;
  float* kb = lds + 512;
  float* z = lds + 1024;
  const float* part = (const float*)(p.ws + OFF_PART);
  const float* kc = (const float*)(p.ws + OFF_KC);
  const bf16* raw = (const bf16*)(p.ws + A_HYRAWC);
  const float* cw = p.in[18] + layer * 3 * 768;
  const float* cb = p.in[19] + layer * 768;
  const float* hb = p.in[28] + layer * 2 * 256;
  for (int o = 0; o < 2; ++o) {
    float s = 0.f;
    for (int t = 0; t < 8; ++t) s += part[((size_t)2 * 256 + t) * 1024 + o * 512 + ch] + part[((size_t)2 * 256 + t) * 1024 + o * 512 + 256 + ch];
    float sc = rsqrtf(s + EPS);
    kf[o * 256 + tid] = kc[(size_t)(o * 512 + ch) * 256 + tid] * sc;
    kb[o * 256 + tid] = kc[(size_t)(o * 512 + 256 + ch) * 256 + tid] * sc;
  }
  {
    const float w0 = cw[ch], w1 = cw[768 + ch], w2 = cw[1536 + ch], bb = cb[ch];
    for (int b = 0; b < 4; ++b) z[b * 256 + tid] = conv3_at(raw + ((size_t)(b * 768 + ch)) * 256, tid, 256, w0, w1, w2, bb);
  }
  __syncthreads();
  for (int o = 0; o < 2; ++o) {
    const int gc = (o + 1) * 256 + ch;
    const float w0 = cw[gc], w1 = cw[768 + gc], w2 = cw[1536 + gc], bb = cb[gc];
    const float bias = hb[o * 256 + ch];
    float zn[4];
    for (int b = 0; b < 4; ++b) {
      float y = 0.f;
      for (int j = 0; j <= tid; ++j) y += kf[o * 256 + tid - j] * z[b * 256 + j];
      for (int j = tid + 1; j < 256; ++j) y += kb[o * 256 + j - tid] * z[b * 256 + j];
      float g = conv3_at(raw + ((size_t)(b * 768 + gc)) * 256, tid, 256, w0, w1, w2, bb);
      zn[b] = g * (y + z[b * 256 + tid] * bias);
    }
    __syncthreads();
    for (int b = 0; b < 4; ++b) z[b * 256 + tid] = zn[b];
    __syncthreads();
  }
  bf16* ymix = (bf16*)(p.ws + A_YMIX);
  for (int b = 0; b < 4; ++b) ymix[((size_t)(NLAT + b * 256 + tid)) * 1024 + 256 + ch] = f2bf(z[b * 256 + tid]);
  __syncthreads();
}

DI void hyena_tr_item(const Params& p, int it, char* smem) {
  const int tid = otid();
  const int b = it >> 9, ct = (it >> 7) & 3, ntile = it & 127;
  bf16* t = (bf16*)smem;
  const bf16* src = (const bf16*)(p.ws + A_HYOUT) + ((size_t)(b * 256 + ct * 64)) * 8192 + ntile * 64;
  {
    const int nx = tid & 63, cy = tid >> 6;
#pragma unroll
    for (int i = 0; i < 16; ++i) { int c = cy + 4 * i; t[c * 66 + nx] = src[(size_t)c * 8192 + nx]; }
  }
  __syncthreads();
  {
    const int cx = tid & 63, ny = tid >> 6;
    bf16* dst = (bf16*)(p.ws + A_YMIX) + ((size_t)(b * 8192 + ntile * 64)) * 1024 + 256 + ct * 64;
#pragma unroll
    for (int i = 0; i < 16; ++i) { int n = ny + 4 * i; dst[(size_t)n * 1024 + cx] = t[cx * 66 + n]; }
  }
  __syncthreads();
}

constexpr int TLD = 68;
constexpr int TSZ = 64 * TLD;

DI void ssd_stage_raw(bf16* dstraw, const bf16* __restrict__ projA, int rowbase, int seqlen, int s0, int cofs) {
  const int tid = otid();
#pragma unroll
  for (int q = 0; q < 3; ++q) {
    const int c = tid + 256 * q;
    if (c < 544) {
      const int rr = c >> 3, ck = c & 7;
      const int t = s0 - 2 + rr;
      u32x4 v = {0u, 0u, 0u, 0u};
      if (t >= 0 && t < seqlen) v = *(const u32x4*)(projA + (size_t)(rowbase + t) * 768 + 256 + cofs + ck * 8);
      *(u32x4*)(dstraw + rr * 64 + ck * 8) = v;
    }
  }
}
DI void ssd_conv_tile(float* dst, bool transposed, const bf16* raw, int cofs, const float* __restrict__ cw, const float* __restrict__ cb) {
  const int tid = otid(), c = tid & 63, i0 = (tid >> 6) * 16;
  const float w0 = cw[cofs + c], w1 = cw[512 + cofs + c], w2 = cw[1024 + cofs + c], w3 = cw[1536 + cofs + c], w4 = cw[2048 + cofs + c];
  const float bb = cb[cofs + c];
  float x0 = bf2f(raw[(i0 + 0) * 64 + c]), x1 = bf2f(raw[(i0 + 1) * 64 + c]);
  float x2 = bf2f(raw[(i0 + 2) * 64 + c]), x3 = bf2f(raw[(i0 + 3) * 64 + c]);
#pragma unroll
  for (int q = 0; q < 16; ++q) {
    const int i = i0 + q;
    const float x4 = bf2f(raw[(i + 4) * 64 + c]);
    const float acc = bb + w0 * x0 + w1 * x1 + w2 * x2 + w3 * x3 + w4 * x4;
    const float v = silu_f(acc);
    if (transposed) dst[c * TLD + i] = v; else dst[i * TLD + c] = v;
    x0 = x1; x1 = x2; x2 = x3; x3 = x4;
  }
}
DI void ssd_dt2(float* misc, const float* __restrict__ dtraw, int rowbase, int s0, int head, const float* __restrict__ alog, const float* __restrict__ dtbias) {
  const int tid = otid();
  if (tid < 128) {
    const int dir = tid >> 6, l = tid & 63;
    const int j = dir ? (63 - l) : l;
    const float a_h = -expf(alog[dir * 4 + head]);
    float x = dtraw[(size_t)(rowbase + s0 + j) * 8 + dir * 4 + head] + dtbias[dir * 4 + head];
    float dt = (x > 20.f) ? x : log1pf(expf(x));
    float v = dt * a_h;
#pragma unroll
    for (int off = 1; off < 64; off <<= 1) {
      float u = __shfl_up(v, off);
      if (l >= off) v += u;
    }
    misc[dir * 64 + j] = dt;
    misc[128 + dir * 64 + j] = v;
  }
}

struct SsdItem2 { int b, head, c, rowbase, seqlen, s0, of, ob, seqf, seqb; bool ctx; };
DI SsdItem2 ssd_decode2(int it) {
  SsdItem2 s;
  const int bh = it / NORD, o = it % NORD;
  s.b = bh >> 2; s.head = bh & 3;
  s.ctx = (o < 4);
  if (s.ctx) { s.c = o; s.rowbase = NLAT + s.b * 256; s.seqlen = 256; s.of = o; s.ob = 3 - o; }
  else { s.c = o - 4; s.rowbase = s.b * 8192; s.seqlen = 8192; s.of = o; s.ob = 4 + 127 - s.c; }
  s.s0 = s.c * 64;
  s.seqf = (s.b * 2 + 0) * 4 + s.head;
  s.seqb = (s.b * 2 + 1) * 4 + s.head;
  return s;
}

DI void ssd_s1_item(const Params& p, int layer, int it, float* lds) {
  const int tid = otid();
  const SsdItem2 s = ssd_decode2(it);
  float* Xs = lds;
  float* Bs = lds + TSZ;
  bf16* raw = (bf16*)(lds + 2 * TSZ);
  float* misc = lds + 4 * TSZ;
  const bf16* projA = (const bf16*)(p.ws + A_PROJA);
  const float* cw = p.in[12] + layer * 5 * 512;
  const float* cb = p.in[13] + layer * 512;
  ssd_stage_raw(raw, projA, s.rowbase, s.seqlen, s.s0, s.head * 64);
  ssd_stage_raw(raw + 68 * 64, projA, s.rowbase, s.seqlen, s.s0, 256 + (s.head >> 1) * 64);
  ssd_dt2(misc, (const float*)(p.ws + OFF_DT), s.rowbase, s.s0, s.head, p.in[14] + layer * 8, p.in[15] + layer * 8);
  __syncthreads();
  ssd_conv_tile(Xs, false, raw, s.head * 64, cw, cb);
  ssd_conv_tile(Bs, false, raw + 68 * 64, 256 + (s.head >> 1) * 64, cw, cb);
  if (tid < 64) {
    misc[256 + tid] = fexp(misc[128 + 63] - misc[128 + tid]) * misc[tid];
    misc[320 + tid] = fexp(misc[192 + 0] - misc[192 + tid]) * misc[64 + tid];
  }
  __syncthreads();
  const int tp = tid >> 4, tn = tid & 15;
  v2f af2[4][2], ab2[4][2];
#pragma unroll
  for (int a = 0; a < 4; ++a)
#pragma unroll
    for (int c = 0; c < 2; ++c) { af2[a][c] = v2f{0.f, 0.f}; ab2[a][c] = v2f{0.f, 0.f}; }
#pragma unroll 2
  for (int j = 0; j < 64; ++j) {
    const float wf = misc[256 + j], wb = misc[320 + j];
    float4 xv = *(const float4*)(Xs + j * TLD + tp * 4);
    float4 bv = *(const float4*)(Bs + j * TLD + tn * 4);
    const v2f b01 = {bv.x, bv.y}, b23 = {bv.z, bv.w};
    float xa[4] = {xv.x, xv.y, xv.z, xv.w};
#pragma unroll
    for (int a = 0; a < 4; ++a) {
      const float xf = xa[a] * wf, xb = xa[a] * wb;
      const v2f xf2 = {xf, xf}, xb2 = {xb, xb};
      af2[a][0] += xf2 * b01; af2[a][1] += xf2 * b23;
      ab2[a][0] += xb2 * b01; ab2[a][1] += xb2 * b23;
    }
  }
  float accf[4][4], accb[4][4];
#pragma unroll
  for (int a = 0; a < 4; ++a) {
    accf[a][0] = af2[a][0].x; accf[a][1] = af2[a][0].y; accf[a][2] = af2[a][1].x; accf[a][3] = af2[a][1].y;
    accb[a][0] = ab2[a][0].x; accb[a][1] = ab2[a][0].y; accb[a][2] = ab2[a][1].x; accb[a][3] = ab2[a][1].y;
  }
  float* stf = (float*)(p.ws + A_STATES) + ((size_t)s.seqf * NORD + s.of) * 4096;
  float* stb = (float*)(p.ws + A_STATES) + ((size_t)s.seqb * NORD + s.ob) * 4096;
#pragma unroll
  for (int c = 0; c < 4; ++c) {
    *(float4*)(stf + (tn * 4 + c) * 64 + tp * 4) = make_float4(accf[0][c], accf[1][c], accf[2][c], accf[3][c]);
    *(float4*)(stb + (tn * 4 + c) * 64 + tp * 4) = make_float4(accb[0][c], accb[1][c], accb[2][c], accb[3][c]);
  }
  if (tid == 0) {
    ((float*)(p.ws + OFF_DEC))[s.seqf * NORD + s.of] = expf(misc[128 + 63]);
    ((float*)(p.ws + OFF_DEC))[s.seqb * NORD + s.ob] = expf(misc[192 + 0]);
  }
  __syncthreads();
}

DI void ssd_scan_item(const Params& p, int it) {
  const int g = it * 256 + otid();
  const int seq = g >> 12, e = g & 4095;
  float* st = (float*)(p.ws + A_STATES) + (size_t)seq * NORD * 4096 + e;
  const float* dec = (const float*)(p.ws + OFF_DEC) + seq * NORD;
  float hcur = 0.f;
#pragma unroll 12
  for (int o = 0; o < NORD; ++o) {
    float sv = st[(size_t)o * 4096];
    st[(size_t)o * 4096] = hcur;
    hcur = dec[o] * hcur + sv;
  }
}

DI void ssd_s3_item(const Params& p, int layer, int it, float* lds) {
  const int tid = otid();
  const SsdItem2 s = ssd_decode2(it);
  if (layer == 1 && s.ctx) return;
  float* T0 = lds;
  float* T1 = lds + TSZ;
  float* T2 = lds + 2 * TSZ;
  float* T3 = lds + 3 * TSZ;
  float* misc = lds + 4 * TSZ;
  bf16* raw = (bf16*)T2;
  const bf16* projA = (const bf16*)(p.ws + A_PROJA);
  const float* cw = p.in[12] + layer * 5 * 512;
  const float* cb = p.in[13] + layer * 512;
  ssd_stage_raw(raw, projA, s.rowbase, s.seqlen, s.s0, 384 + (s.head >> 1) * 64);
  ssd_stage_raw(raw + 68 * 64, projA, s.rowbase, s.seqlen, s.s0, 256 + (s.head >> 1) * 64);
  ssd_dt2(misc, (const float*)(p.ws + OFF_DT), s.rowbase, s.s0, s.head, p.in[14] + layer * 8, p.in[15] + layer * 8);
  __syncthreads();
  ssd_conv_tile(T0, true, raw, 384 + (s.head >> 1) * 64, cw, cb);
  ssd_conv_tile(T1, true, raw + 68 * 64, 256 + (s.head >> 1) * 64, cw, cb);
  __syncthreads();
  ssd_stage_raw(raw, projA, s.rowbase, s.seqlen, s.s0, s.head * 64);
  __syncthreads();
  ssd_conv_tile(T3, false, raw, s.head * 64, cw, cb);
  __syncthreads();
  const float* dtf = misc; const float* dtb = misc + 64; const float* af = misc + 128; const float* ab = misc + 192;
  const int ti = tid >> 4, tj = tid & 15;
  {
    float acc[4][4];
#pragma unroll
    for (int a = 0; a < 4; ++a)
#pragma unroll
      for (int c = 0; c < 4; ++c) acc[a][c] = 0.f;
    v2f g2[4][2];
#pragma unroll
    for (int a = 0; a < 4; ++a) { g2[a][0] = v2f{0.f, 0.f}; g2[a][1] = v2f{0.f, 0.f}; }
#pragma unroll 4
    for (int n = 0; n < 64; ++n) {
      float4 bv = *(const float4*)(T1 + n * TLD + tj * 4);
      const v2f b01 = {bv.x, bv.y}, b23 = {bv.z, bv.w};
      const float4 c4 = *(const float4*)(T0 + n * TLD + ti * 4);
      const float cva[4] = {c4.x, c4.y, c4.z, c4.w};
#pragma unroll
      for (int a = 0; a < 4; ++a) {
        const v2f c2 = {cva[a], cva[a]};
        g2[a][0] += c2 * b01; g2[a][1] += c2 * b23;
      }
    }
#pragma unroll
    for (int a = 0; a < 4; ++a) { acc[a][0] = g2[a][0].x; acc[a][1] = g2[a][0].y; acc[a][2] = g2[a][1].x; acc[a][3] = g2[a][1].y; }
#pragma unroll
    for (int c = 0; c < 4; ++c) {
      const int j = tj * 4 + c;
      float o4[4];
#pragma unroll
      for (int a = 0; a < 4; ++a) {
        const int i = ti * 4 + a;
        float m = 0.f;
        if (j <= i) m += fexp(af[i] - af[j]) * dtf[j];
        if (j >= i) m += fexp(ab[i] - ab[j]) * dtb[j];
        o4[a] = acc[a][c] * m;
      }
      *(float4*)(T2 + j * TLD + ti * 4) = make_float4(o4[0], o4[1], o4[2], o4[3]);
    }
  }
  __syncthreads();
  {
    const float* st = (const float*)(p.ws + A_STATES) + ((size_t)s.seqf * NORD + s.of) * 4096;
#pragma unroll
    for (int q = 0; q < 4; ++q) {
      int e4 = tid + 256 * q;
      int n = e4 >> 4, p4 = (e4 & 15) * 4;
      *(float4*)(T1 + n * TLD + p4) = *(const float4*)(st + n * 64 + p4);
    }
  }
  __syncthreads();
  const int tp = tj;
  float acc1[4][4], acc2[4][4];
#pragma unroll
  for (int a = 0; a < 4; ++a)
#pragma unroll
    for (int c = 0; c < 4; ++c) { acc1[a][c] = 0.f; acc2[a][c] = 0.f; }
  {
    v2f p1[4][2], p2[4][2];
#pragma unroll
    for (int a = 0; a < 4; ++a) { p1[a][0] = v2f{0.f, 0.f}; p1[a][1] = v2f{0.f, 0.f}; p2[a][0] = v2f{0.f, 0.f}; p2[a][1] = v2f{0.f, 0.f}; }
#pragma unroll 2
    for (int j = 0; j < 64; ++j) {
      float4 xv = *(const float4*)(T3 + j * TLD + tp * 4);
      float4 hv = *(const float4*)(T1 + j * TLD + tp * 4);
      const v2f x01 = {xv.x, xv.y}, x23 = {xv.z, xv.w}, h01 = {hv.x, hv.y}, h23 = {hv.z, hv.w};
      const float4 s4 = *(const float4*)(T2 + j * TLD + ti * 4), c4 = *(const float4*)(T0 + j * TLD + ti * 4);
      const float sva[4] = {s4.x, s4.y, s4.z, s4.w}, cva[4] = {c4.x, c4.y, c4.z, c4.w};
#pragma unroll
      for (int a = 0; a < 4; ++a) {
        const v2f s2 = {sva[a], sva[a]}, c2 = {cva[a], cva[a]};
        p1[a][0] += s2 * x01; p1[a][1] += s2 * x23;
        p2[a][0] += c2 * h01; p2[a][1] += c2 * h23;
      }
    }
#pragma unroll
    for (int a = 0; a < 4; ++a) {
      acc1[a][0] = p1[a][0].x; acc1[a][1] = p1[a][0].y; acc1[a][2] = p1[a][1].x; acc1[a][3] = p1[a][1].y;
      acc2[a][0] = p2[a][0].x; acc2[a][1] = p2[a][0].y; acc2[a][2] = p2[a][1].x; acc2[a][3] = p2[a][1].y;
    }
  }
#pragma unroll
  for (int a = 0; a < 4; ++a) {
    const float ei = fexp(af[ti * 4 + a]);
#pragma unroll
    for (int c = 0; c < 4; ++c) acc1[a][c] += ei * acc2[a][c];
  }
  __syncthreads();
  {
    const float* st = (const float*)(p.ws + A_STATES) + ((size_t)s.seqb * NORD + s.ob) * 4096;
#pragma unroll
    for (int q = 0; q < 4; ++q) {
      int e4 = tid + 256 * q;
      int n = e4 >> 4, p4 = (e4 & 15) * 4;
      *(float4*)(T1 + n * TLD + p4) = *(const float4*)(st + n * 64 + p4);
    }
  }
  __syncthreads();
#pragma unroll
  for (int a = 0; a < 4; ++a)
#pragma unroll
    for (int c = 0; c < 4; ++c) acc2[a][c] = 0.f;
  {
    v2f p2[4][2];
#pragma unroll
    for (int a = 0; a < 4; ++a) { p2[a][0] = v2f{0.f, 0.f}; p2[a][1] = v2f{0.f, 0.f}; }
#pragma unroll 4
    for (int n = 0; n < 64; ++n) {
      float4 hv = *(const float4*)(T1 + n * TLD + tp * 4);
      const v2f h01 = {hv.x, hv.y}, h23 = {hv.z, hv.w};
      const float4 c4 = *(const float4*)(T0 + n * TLD + ti * 4);
      const float cva[4] = {c4.x, c4.y, c4.z, c4.w};
#pragma unroll
      for (int a = 0; a < 4; ++a) {
        const v2f c2 = {cva[a], cva[a]};
        p2[a][0] += c2 * h01; p2[a][1] += c2 * h23;
      }
    }
#pragma unroll
    for (int a = 0; a < 4; ++a) { acc2[a][0] = p2[a][0].x; acc2[a][1] = p2[a][0].y; acc2[a][2] = p2[a][1].x; acc2[a][3] = p2[a][1].y; }
  }
  const float dsk = p.in[16][layer * 4 + s.head];
  float* yssd = (float*)(p.ws + A_YSSD);
#pragma unroll
  for (int a = 0; a < 4; ++a) {
    const int i = ti * 4 + a;
    const float eb = fexp(ab[i]);
    float4 xv = *(const float4*)(T3 + i * TLD + tp * 4);
    float4 o;
    o.x = acc1[a][0] + eb * acc2[a][0] + dsk * xv.x;
    o.y = acc1[a][1] + eb * acc2[a][1] + dsk * xv.y;
    o.z = acc1[a][2] + eb * acc2[a][2] + dsk * xv.z;
    o.w = acc1[a][3] + eb * acc2[a][3] + dsk * xv.w;
    *(float4*)(yssd + (size_t)(s.rowbase + s.s0 + i) * 256 + s.head * 64 + tp * 4) = o;
  }
  __syncthreads();
}

DI void ssd_gate_row(int lane, int row, f32x4 yv, u32x2 zv, const float* __restrict__ ng, bf16* __restrict__ ymix) {
  const int c0 = lane * 4;
  const float z[4] = {__uint_as_float(zv.x << 16), __uint_as_float(zv.x & 0xffff0000u), __uint_as_float(zv.y << 16), __uint_as_float(zv.y & 0xffff0000u)};
  const float y[4] = {yv.x, yv.y, yv.z, yv.w};
  float g[4];
  float ss = 0.f;
#pragma unroll
  for (int e = 0; e < 4; ++e) {
    g[e] = y[e] * silu_f(z[e]);
    ss += g[e] * g[e];
  }
  ss = wave_sum(ss);
  const float rstd = rsqrtf(ss * (1.f / 256.f) + EPS);
  float4 gw = *(const float4*)(ng + c0);
  uint2 o;
  o.x = pack2(g[0] * rstd * gw.x, g[1] * rstd * gw.y);
  o.y = pack2(g[2] * rstd * gw.z, g[3] * rstd * gw.w);
  *(uint2*)(ymix + (size_t)row * 1024 + c0) = o;
}
DI void ssd_gate_phase(const Params& p, int layer) {
  const int lane = otid() & 63, wave = otid() >> 6;
  const int nrows = (layer == 0) ? MROWS : NLAT;
  const bf16* projA = (const bf16*)(p.ws + A_PROJA);
  const float* yssd = (const float*)(p.ws + A_YSSD);
  const float* ng = p.in[17] + layer * 256;
  bf16* ymix = (bf16*)(p.ws + A_YMIX);
  const int c0 = lane * 4;
  for (int r4 = blockIdx.x; r4 * 4 < nrows; r4 += 2 * gridDim.x) {
    const int rowA = r4 * 4 + wave, rowB = rowA + 4 * (int)gridDim.x;
    const bool hasB = ((r4 + (int)gridDim.x) * 4 < nrows);
    const f32x4 yA = *(const f32x4*)(yssd + (size_t)rowA * 256 + c0);
    const u32x2 zA = *(const u32x2*)(projA + (size_t)rowA * 768 + c0);
    f32x4 yB = yA; u32x2 zB = zA;
    if (hasB) {
      yB = *(const f32x4*)(yssd + (size_t)rowB * 256 + c0);
      zB = *(const u32x2*)(projA + (size_t)rowB * 768 + c0);
    }
    ssd_gate_row(lane, rowA, yA, zA, ng, ymix);
    if (hasB) ssd_gate_row(lane, rowB, yB, zB, ng, ymix);
  }
}

DI void phase_pro0(const Params& p, char* smem) {
  float* lds = (float*)smem;
  const int tid = otid();
  constexpr int N_W = 5888, N_MOD = 192, N_F1 = 520, N_ROPE = 1024, N_TW = 48;
  const int rb = gridDim.x - 1 - blockIdx.x;
  for (int it = blockIdx.x; it < 512; it += gridDim.x) filt_f1(p, it >> 8, it & 255, lds);
  for (int it = rb; it < N_MOD; it += gridDim.x) mod_item(p, it, lds);
  for (int it = rb - N_MOD; it < N_F1 - 512; it += gridDim.x) if (it >= 0) filt_f1(p, 2, it, lds);
  {
    struct WT { const float* src; bf16* dst; int sld, dld, k0, n0, shift; };
    auto decode = [&](int it) -> WT {
      WT w; int kt, nt; w.shift = 0;
      if (it < 1280) {
        int layer = it / 640, r = it % 640; kt = r / 40; nt = r % 40; w.shift = 8;
        w.src = p.in[10] + (size_t)layer * 1024 * 2568; w.sld = 2568; w.dst = (bf16*)(p.ws + OFF_WIN) + (size_t)layer * 2560 * 1024; w.dld = 1024;
      } else if (it < 1792) {
        int r = it - 1280, layer = r / 256; r %= 256; kt = r / 16; nt = r % 16;
        w.src = p.in[11] + (size_t)layer * 1024 * 1024; w.sld = 1024; w.dst = (bf16*)(p.ws + OFF_WOUT) + (size_t)layer * 1024 * 1024; w.dld = 1024;
      } else if (it < 3840) {
        int r = it - 1792, layer = r / 1024; r %= 1024; kt = r / 64; nt = r % 64;
        w.src = p.in[32] + (size_t)layer * 1024 * 4096; w.sld = 4096; w.dst = (bf16*)(p.ws + OFF_W1) + (size_t)layer * 4096 * 1024; w.dld = 1024;
      } else {
        int r = it - 3840, layer = r / 1024; r %= 1024; kt = r / 16; nt = r % 16;
        w.src = p.in[33] + (size_t)layer * 4096 * 1024; w.sld = 1024; w.dst = (bf16*)(p.ws + OFF_W2) + (size_t)layer * 1024 * 4096; w.dld = 4096;
      }
      w.k0 = kt * 64; w.n0 = nt * 64;
      return w;
    };
    const int tx = tid & 63, ty = tid >> 6;
    const int kx2 = tid & 31, ny = tid >> 5;
    for (int it = blockIdx.x; it < N_W; it += 2 * gridDim.x) {
      const int itb = it + gridDim.x;
      const bool hasb = (itb < N_W);
      const WT wa = decode(it);
      const WT wb = decode(hasb ? itb : it);
      float va[16], vb[16];
      {
        const int na = wa.n0 + tx, ca = na + ((na >= 768) ? wa.shift : 0);
        const int nb = wb.n0 + tx, cb_ = nb + ((nb >= 768) ? wb.shift : 0);
#pragma unroll
        for (int i = 0; i < 16; ++i) va[i] = wa.src[(size_t)(wa.k0 + ty + 4 * i) * wa.sld + ca];
        if (hasb) {
#pragma unroll
          for (int i = 0; i < 16; ++i) vb[i] = wb.src[(size_t)(wb.k0 + ty + 4 * i) * wb.sld + cb_];
        }
      }
#pragma unroll
      for (int i = 0; i < 16; ++i) lds[(ty + 4 * i) * 65 + tx] = va[i];
      if (hasb) {
#pragma unroll
        for (int i = 0; i < 16; ++i) lds[4160 + (ty + 4 * i) * 65 + tx] = vb[i];
      }
      __syncthreads();
#pragma unroll
      for (int i = 0; i < 8; ++i) {
        const int nn = ny + 8 * i;
        *(unsigned*)(wa.dst + (size_t)(wa.n0 + nn) * wa.dld + wa.k0 + 2 * kx2) = pack2(lds[(2 * kx2) * 65 + nn], lds[(2 * kx2 + 1) * 65 + nn]);
      }
      if (hasb) {
#pragma unroll
        for (int i = 0; i < 8; ++i) {
          const int nn = ny + 8 * i;
          *(unsigned*)(wb.dst + (size_t)(wb.n0 + nn) * wb.dld + wb.k0 + 2 * kx2) = pack2(lds[4160 + (2 * kx2) * 65 + nn], lds[4160 + (2 * kx2 + 1) * 65 + nn]);
        }
      }
      __syncthreads();
    }
  }
  for (int it = blockIdx.x; it < N_ROPE; it += gridDim.x) {
    int idx = it * 256 + tid;
    int pos = idx >> 5, i = idx & 31, fi = i & 15;
    float inv = powf(10000.f, -(float)fi / 16.f);
    int coord = (i < 16) ? (pos >> 6) : (pos & 63);
    float ang = (float)coord * inv;
    ((float2*)(p.ws + OFF_ROPE))[idx] = make_float2(cosf(ang), sinf(ang));
  }
  for (int it = blockIdx.x; it < N_TW; it += gridDim.x) {
    int idx = it * 256 + tid;
    if (idx < 4096) ((float2*)(p.ws + OFF_TW8))[idx] = make_float2(cospif((float)idx / 4096.f), -sinpif((float)idx / 4096.f));
    else { int j = idx - 4096; ((float2*)(p.ws + OFF_TW16))[j] = make_float2(cospif((float)j / 8192.f), -sinpif((float)j / 8192.f)); }
  }
}

DI void phase_pro1(const Params& p, char* smem) {
  for (int it = blockIdx.x; it < 1024; it += gridDim.x) filt_f2(p, it, smem);
  rowpass_phase(p, 0, 0, smem);
}

DI void attn_dispatch(const Params& p, int layer, int akind, int ar_, char* smem) {
  const bf16* QB = (const bf16*)(p.ws + A_QB);
  const bf16* KB = (const bf16*)(p.ws + A_KB);
  const bf16* VT = (const bf16*)(p.ws + A_VT);
  bf16* ymix = (bf16*)(p.ws + A_YMIX);
  int g, b, head, q0, lo, hi, orow, ocol;
  bool window = false, has_sink = false;
  if (akind == 0) {
    g = 1; b = ar_ >> 8; head = (ar_ >> 6) & 3; q0 = (ar_ & 63) * 128; lo = 0; hi = SEQ; orow = b * 8192 + q0; ocol = 768;
  } else if (akind == 1) {
    g = 0; b = ar_ >> 8; head = (ar_ >> 6) & 3; q0 = (ar_ & 63) * 128;
    lo = (q0 - 128 < 0) ? 0 : (q0 - 128); hi = (q0 + 256 > SEQ) ? SEQ : (q0 + 256);
    window = true; has_sink = true; orow = b * 8192 + q0; ocol = 512;
  } else {
    g = ar_ >> 5; b = (ar_ >> 3) & 3; head = (ar_ >> 1) & 3; const int qt = ar_ & 1;
    q0 = SEQ + qt * 128; lo = 0; hi = 0; has_sink = (g == 0); orow = NLAT + b * 256 + qt * 128; ocol = (g == 0) ? 512 : 768;
  }
  attn_item(QB + ((size_t)((g * 4 + b) * 4 + head)) * KEYS * 64, KB + ((size_t)((g * 4 + b) * 2 + (head >> 1))) * KEYS * 64,
            VT + ((size_t)((g * 4 + b) * 2 + (head >> 1))) * 64 * KEYS, q0, lo, hi, 4, window, has_sink,
            p.in[29][layer * 4 + head] * LOG2E, ymix + (size_t)orow * 1024 + ocol + head * 64, smem);
}

DI void phase_mix1(const Params& p, int layer, char* smem) {
  const int tid = otid();
  const int N_DENSE = 1024, N_FFT = 512, N_WIN = 1024, N_S1 = 16 * NORD;
  const int N_CH = (layer == 0) ? 256 : 0, N_CA = (layer == 0) ? 64 : 0;
  const int n_att = N_DENSE + N_WIN + N_CA;
  for (int it = blockIdx.x; it < n_att; it += gridDim.x) {
    int akind, ar_;
    if (it < N_DENSE) { akind = 0; ar_ = it; }
    else if (it < N_DENSE + N_WIN) { akind = 1; ar_ = it - N_DENSE; }
    else { akind = 2; ar_ = it - N_DENSE - N_WIN; }
    attn_dispatch(p, layer, akind, ar_, smem);
  }
  for (int it = blockIdx.x; it < N_FFT; it += gridDim.x) hyena_fft_item(p, layer, it, smem);
  for (int it = blockIdx.x; it < N_S1; it += gridDim.x) ssd_s1_item(p, layer, it, (float*)smem);
  for (int it = blockIdx.x; it < N_CH; it += gridDim.x) hyena_ctx_item(p, layer, it, (float*)smem);
}

DI void phase_mix2(const Params& p, int layer, char* smem) {
  const int total = 512 + 2048;
  for (int it = blockIdx.x; it < total; it += gridDim.x) {
    if (it < 512) ssd_scan_item(p, it);
    else hyena_tr_item(p, it - 512, smem);
  }
}

DI void phase_mix3(const Params& p, int layer, char* smem) {
  for (int it = blockIdx.x; it < 16 * NORD; it += gridDim.x) ssd_s3_item(p, layer, it, (float*)smem);
}

template <int K>
DI void run_phase_k(const Params& p, int layer, char* smem) {
  if (K == -2) phase_pro0(p, smem);
  else if (K == -1) phase_pro1(p, smem);
  else if (K == 0) gemm_phase(p, layer, 1, 0, smem);
  else if (K == 1) phase_mix1(p, layer, smem);
  else if (K == 2) phase_mix2(p, layer, smem);
  else if (K == 3) phase_mix3(p, layer, smem);
  else if (K == 4) ssd_gate_phase(p, layer);
  else if (K == 5) gemm_phase(p, layer, 2, 0, smem);
  else if (K == 6) rowpass_phase(p, layer, 1, smem);
  else if (K == 7) gemm_phase(p, layer, 3, 0, smem);
  else if (K == 8) gemm_phase(p, layer, 4, 0, smem);
  else if (K == 9) gemm_phase(p, layer, 3, 1, smem);
  else if (K == 10) gemm_phase(p, layer, 4, 1, smem);
  else rowpass_phase(p, layer, 2, smem);
}
#ifndef PHASE_MASK
#define PHASE_MASK 0xffff
#endif
#define PM(k) ((PHASE_MASK >> (k)) & 1)
DI void run_phase(const Params& p, int ph, char* smem) {
  if (ph == 0) { if (PM(12)) run_phase_k<-2>(p, 0, smem); return; }
  if (ph == 1) { if (PM(13)) run_phase_k<-1>(p, 0, smem); return; }
  const int layer = (ph - 2) / 12, k = (ph - 2) % 12;
  switch (k) {
    case 0: if (PM(0)) run_phase_k<0>(p, layer, smem); break;
    case 1: if (PM(1)) run_phase_k<1>(p, layer, smem); break;
    case 2: if (PM(2)) run_phase_k<2>(p, layer, smem); break;
    case 3: if (PM(3)) run_phase_k<3>(p, layer, smem); break;
    case 4: if (PM(4)) run_phase_k<4>(p, layer, smem); break;
    case 5: if (PM(5)) run_phase_k<5>(p, layer, smem); break;
    case 6: if (PM(6)) run_phase_k<6>(p, layer, smem); break;
    case 7: if (PM(7)) run_phase_k<7>(p, layer, smem); break;
    case 8: if (PM(8)) run_phase_k<8>(p, layer, smem); break;
    case 9: if (PM(9)) run_phase_k<9>(p, layer, smem); break;
    case 10: if (PM(10)) run_phase_k<10>(p, layer, smem); break;
    default: if (PM(11)) run_phase_k<11>(p, layer, smem); break;
  }
}

constexpr int N_PHASES = 2 + 2 * 12;

#if 1
__global__ void __launch_bounds__(256, 2) fwd_megakernel(Params p) {
  __shared__ __attribute__((aligned(16))) char smem[SMEM_BYTES];
  __shared__ uint4 xb_words;
  if (threadIdx.x == 0) xb_words = make_uint4(0u, 0u, 0u, 0u);
  __syncthreads();
  XcdBarrier xb = xcd_barrier_post((unsigned*)(p.ws + OFF_BAR), (volatile LAS unsigned*)&xb_words);
  for (int ph = p.ph0; ph < p.ph1; ++ph) {
    run_phase(p, ph, smem);
    if (ph + 1 < p.ph1) {
      if (p.coop == 2) cg::this_grid().sync();
      else xcd_barrier(xb);
    }
  }
}
#endif
#if 1
template <int K>
__global__ void __launch_bounds__(256, 2) phase_kernel(Params p) {
  __shared__ __attribute__((aligned(16))) char smem[SMEM_BYTES];
  run_phase_k<K>(p, p.ph0, smem);
}
template <int K>
static void launch_phase(Params p, int layer, int grid, hipStream_t stream) {
  p.ph0 = layer; p.ph1 = layer + 1;
  hipLaunchKernelGGL(phase_kernel<K>, dim3(grid), dim3(256), 0, stream, p);
}
#endif

extern "C" void kernel_launch(void* const* d_in, const int* in_sizes, int n_in, void* d_out, int out_size, void* d_ws,
                              size_t ws_size, hipStream_t stream) {
  static int grid_blocks = 0, grid_fallback = 0;
  if (!grid_blocks) {
    int dev = 0, cus = 0, per_cu = 0;
    (void)hipGetDevice(&dev);
    (void)hipDeviceGetAttribute(&cus, hipDeviceAttributeMultiprocessorCount, dev);
#if ONE_LAUNCH
    (void)hipOccupancyMaxActiveBlocksPerMultiprocessor(&per_cu, fwd_megakernel, 256, 0);
#else
    per_cu = 2;
#endif
    if (per_cu < 1) per_cu = 1;
    if (per_cu > 2) per_cu = 2;
    grid_fallback = cus * per_cu;
    grid_blocks = cus * 2;
  }
  Params p{};
  for (int i = 0; i < 34; ++i) p.in[i] = (const float*)d_in[i];
  p.out = (float*)d_out;
  p.ws = (char*)d_ws;
  p.pad = 0;
  if (ws_size < WS_TOTAL) { fprintf(stderr, "workspace too small: %zu < %zu\n", ws_size, (size_t)WS_TOTAL); return; }
#if ONE_LAUNCH == 2
#ifndef SEP_MASK
#define SEP_MASK 0x7A1
#endif
  for (int ph = 0; ph < N_PHASES; ++ph) {
    p.coop = 0;
    const int k = (ph < 2) ? (12 + ph) : ((ph - 2) % 12), layer = (ph < 2) ? 0 : (ph - 2) / 12;
    if ((SEP_MASK >> k) & 1) {
      switch (k) {
        case 0: launch_phase<0>(p, layer, 512, stream); break;
        case 1: launch_phase<1>(p, layer, 512, stream); break;
        case 2: launch_phase<2>(p, layer, 512, stream); break;
        case 3: launch_phase<3>(p, layer, 512, stream); break;
        case 4: launch_phase<4>(p, layer, 512, stream); break;
        case 5: launch_phase<5>(p, layer, 512, stream); break;
        case 6: launch_phase<6>(p, layer, 512, stream); break;
        case 7: launch_phase<7>(p, layer, 512, stream); break;
        case 8: launch_phase<8>(p, layer, 512, stream); break;
        case 9: launch_phase<9>(p, layer, 512, stream); break;
        case 10: launch_phase<10>(p, layer, 512, stream); break;
        case 11: launch_phase<11>(p, layer, 512, stream); break;
        case 12: launch_phase<-2>(p, 0, 512, stream); break;
        default: launch_phase<-1>(p, 0, 512, stream); break;
      }
    } else {
      p.ph0 = ph; p.ph1 = ph + 1;
      hipLaunchKernelGGL(fwd_megakernel, dim3(512), dim3(256), 0, stream, p);
    }
  }
#elif ONE_LAUNCH
  p.ph0 = 0; p.ph1 = N_PHASES; p.coop = 1;
  void* args[] = {&p};
  (void)hipMemsetAsync(p.ws + OFF_BAR, 0, XCD_BAR_WORDS * 4, stream);
  hipError_t e = hipLaunchCooperativeKernel((void*)fwd_megakernel, dim3(grid_blocks), dim3(256), args, 0, stream);
  if (e != hipSuccess && grid_blocks != grid_fallback) {
    (void)hipGetLastError();
    grid_blocks = grid_fallback;
    e = hipLaunchCooperativeKernel((void*)fwd_megakernel, dim3(grid_blocks), dim3(256), args, 0, stream);
  }
  if (e != hipSuccess) fprintf(stderr, "cooperative launch failed: %s (grid %d)\n", hipGetErrorString(e), grid_blocks);
#else
  p.coop = 0;
  launch_phase<-2>(p, 0, grid_blocks, stream);
  launch_phase<-1>(p, 0, grid_blocks, stream);
  for (int layer = 0; layer < 2; ++layer) {
    launch_phase<0>(p, layer, grid_blocks, stream);
    launch_phase<1>(p, layer, grid_blocks, stream);
    launch_phase<2>(p, layer, grid_blocks, stream);
    launch_phase<3>(p, layer, grid_blocks, stream);
    launch_phase<4>(p, layer, grid_blocks, stream);
    launch_phase<5>(p, layer, grid_blocks, stream);
    launch_phase<6>(p, layer, grid_blocks, stream);
    launch_phase<7>(p, layer, grid_blocks, stream);
    launch_phase<8>(p, layer, grid_blocks, stream);
    launch_phase<9>(p, layer, grid_blocks, stream);
    launch_phase<10>(p, layer, grid_blocks, stream);
    launch_phase<11>(p, layer, grid_blocks, stream);
  }
#endif
}
```

```cpp
#include <hip/hip_runtime.h>
#include <hip/hip_cooperative_groups.h>
#include <stdint.h>
#include <stdio.h>
namespace cg = cooperative_groups;

#ifndef ONE_LAUNCH
#define ONE_LAUNCH 1
#endif

typedef unsigned short bf16;
typedef short bf16x8 __attribute__((ext_vector_type(8)));
typedef unsigned u32x4 __attribute__((ext_vector_type(4)));
typedef short s16x4 __attribute__((ext_vector_type(4)));
typedef float f32x16 __attribute__((ext_vector_type(16)));
typedef __bf16 bfv2 __attribute__((ext_vector_type(2)));
typedef float fv2 __attribute__((ext_vector_type(2)));
typedef float v2f __attribute__((ext_vector_type(2)));
typedef float f32x4 __attribute__((ext_vector_type(4)));
typedef unsigned u32x2 __attribute__((ext_vector_type(2)));

#define DI __device__ __forceinline__
#define MFMA(a, b, c) __builtin_amdgcn_mfma_f32_32x32x16_bf16((a), (b), (c), 0, 0, 0)

DI int otid() { int t = (int)__builtin_amdgcn_workitem_id_x(); asm volatile("" : "+v"(t)); return t; }
DI float bf2f(bf16 b) { return __uint_as_float(((unsigned)b) << 16); }
DI unsigned pack2(float a, float b) { fv2 v = {a, b}; return __builtin_bit_cast(unsigned, __builtin_convertvector(v, bfv2)); }
DI bf16 f2bf(float a) { return (bf16)(pack2(a, 0.f) & 0xffffu); }
DI float fexp(float x) { return __builtin_amdgcn_exp2f(x * 1.4426950408889634f); }
DI float silu_f(float x) { return x * __builtin_amdgcn_rcpf(1.f + fexp(-x)); }

constexpr int NB = 4, SEQ = 8192, CTXL = 256, NLAT = NB * SEQ, NCTX = NB * CTXL, MROWS = NLAT + NCTX;
constexpr int KEYS = SEQ + CTXL;
constexpr float EPS = 1e-6f;
constexpr float LOG2E = 1.4426950408889634f;
constexpr int NORD = 132;
constexpr int SPEC_LD = 8200;

constexpr size_t OFF_WIN = 0;
constexpr size_t OFF_WOUT = OFF_WIN + (size_t)2 * 2560 * 1024 * 2;
constexpr size_t OFF_W1 = OFF_WOUT + (size_t)2 * 1024 * 1024 * 2;
constexpr size_t OFF_W2 = OFF_W1 + (size_t)2 * 4096 * 1024 * 2;
constexpr size_t OFF_SPEC = OFF_W2 + (size_t)2 * 4096 * 1024 * 2;
constexpr size_t OFF_KC = OFF_SPEC + (size_t)2 * 2 * 256 * SPEC_LD * 8;
constexpr size_t OFF_PART = OFF_KC + (size_t)1024 * 256 * 4;
constexpr size_t OFF_ROPE = OFF_PART + (size_t)3 * 256 * 1024 * 4;
constexpr size_t OFF_TW8 = OFF_ROPE + (size_t)8192 * 32 * 8;
constexpr size_t OFF_TW16 = OFF_TW8 + 4096 * 8;
constexpr size_t OFF_MOD = OFF_TW16 + 8192 * 8;
constexpr size_t OFF_DT = OFF_MOD + (size_t)2 * 5 * 6144 * 4;
constexpr size_t OFF_DEC = OFF_DT + (size_t)MROWS * 8 * 4;
constexpr size_t OFF_BAR = OFF_DEC + 32 * NORD * 4 + 256;
constexpr size_t OFF_CTXS = OFF_BAR + 16384;
constexpr size_t OFF_ARENA = ((OFF_CTXS + (size_t)1024 * 1024 * 4 + 4095) / 4096) * 4096;
constexpr size_t SZ_H = (size_t)MROWS * 1024 * 2;
constexpr size_t A_HBUF = OFF_ARENA;
constexpr size_t A_YOUT = A_HBUF + SZ_H;
constexpr size_t A_PROJ = A_YOUT + SZ_H;
constexpr size_t A_PROJA = A_PROJ;
constexpr size_t A_HYRAW = A_PROJA + (size_t)MROWS * 768 * 2;
constexpr size_t A_HYRAWC = A_HYRAW + (size_t)4 * 768 * 8192 * 2;
constexpr size_t A_QB = A_HYRAWC + (size_t)4 * 768 * 256 * 2;
constexpr size_t A_KB = A_QB + (size_t)2 * 4 * 4 * KEYS * 64 * 2;
constexpr size_t A_VT = A_KB + (size_t)2 * 4 * 2 * KEYS * 64 * 2;
constexpr size_t A_PROJ_END = A_VT + (size_t)2 * 4 * 2 * KEYS * 64 * 2;
constexpr size_t A_YMIX = A_PROJ_END;
constexpr size_t WS_END = A_YMIX + SZ_H;
constexpr size_t A_HID = A_PROJ;
constexpr size_t A_KRAW = A_PROJ;
constexpr size_t A_STATES = A_HBUF;
constexpr size_t A_YSSD = A_YOUT;
constexpr size_t A_HYOUT = A_YSSD + (size_t)MROWS * 256 * 4;
constexpr size_t A_ESCR1 = A_HYOUT + (size_t)4 * 256 * 8192 * 2;
constexpr size_t A_ESCR0 = WS_END;
constexpr size_t WS_TOTAL = A_ESCR0 + (size_t)256 * 8192 * 8;
static_assert(A_ESCR1 + (size_t)256 * 8192 * 8 <= A_PROJ, "escr1 alias");
static_assert((size_t)17408 * 4096 * 2 <= A_PROJ_END - A_PROJ, "hidden alias");
static_assert((size_t)2 * 1024 * 8192 * 4 <= A_PROJ_END - A_PROJ, "kraw alias");
static_assert((size_t)32 * NORD * 4096 * 4 <= SZ_H, "states alias");
static_assert(A_HYOUT + (size_t)4 * 256 * 8192 * 2 <= A_PROJ, "hyout alias");
static_assert(WS_TOTAL <= (size_t)536870912, "workspace");

struct Params {
  const float* in[34];
  float* out;
  char* ws;
  int ph0, ph1;
  int coop, pad;
};

constexpr int SMEM_BYTES = 73728;

DI float wave_sum(float v) {
#pragma unroll
  for (int o = 32; o >= 1; o >>= 1) v += __shfl_xor(v, o);
  return v;
}
DI float block_sum(float v, float* red) {
  v = wave_sum(v);
  if ((otid() & 63) == 0) red[otid() >> 6] = v;
  __syncthreads();
  float r = red[0] + red[1] + red[2] + red[3];
  __syncthreads();
  return r;
}


#define XB_TMO      128
#define XB_XCNT(j)  (256  + 64 * (j))
#define XB_XSUB(j)  (1280 + 64 * (j))
#define XB_XGEN(j)  (2304 + 64 * (j))
#define XB_TOP      3328
#define XB_TOPGEN   3392
#define XCD_BAR_WORDS 3456
#define XB_SPIN_CAP (1u << 22)
#define LAS __attribute__((address_space(3)))
DI unsigned xb_ld(unsigned* p) { return __hip_atomic_load(p, __ATOMIC_RELAXED, __HIP_MEMORY_SCOPE_AGENT); }
DI unsigned xb_add(unsigned* p, unsigned v) { return __hip_atomic_fetch_add(p, v, __ATOMIC_RELAXED, __HIP_MEMORY_SCOPE_AGENT); }
DI unsigned xb_xcc_id() { return (unsigned)__builtin_amdgcn_s_getreg((3 << 11) | 20) & 0xFu; }
#define XB_SPIN(cond, bar) do { unsigned _sp = 0; while (cond) { __builtin_amdgcn_s_sleep(1); \
    if ((++_sp & 255u) == 0u) { if (xb_ld(&(bar)[XB_TMO])) break; if (_sp > XB_SPIN_CAP) { atomicAdd(&(bar)[XB_TMO], 1u); break; } } } } while (0)
struct XcdBarrier { unsigned* bar; unsigned x; volatile LAS unsigned* st; };
DI XcdBarrier xcd_barrier_post(unsigned* bar, volatile LAS unsigned* st) {
  XcdBarrier b; b.bar = bar; b.x = xb_xcc_id(); b.st = st;
  if (threadIdx.x == 0) (void)xb_add(&bar[XB_XCNT(b.x)], 1u);
  return b;
}
DI void xcd_barrier_complete(unsigned* bar, unsigned x, unsigned& nloc, unsigned& nx) {
  const unsigned G = gridDim.x * gridDim.y * gridDim.z;
  unsigned sum, cnt, mine, sp = 0u;
  for (;;) {
    sum = 0u; cnt = 0u; mine = 0u;
#pragma unroll
    for (unsigned j = 0; j < 16; ++j) { const unsigned c = xb_ld(&bar[XB_XCNT(j)]); sum += c; cnt += (c > 0u) ? 1u : 0u; mine = (j == x) ? c : mine; }
    if (sum == G) break;
    __builtin_amdgcn_s_sleep(1);
    if ((++sp & 255u) == 0u) { if (xb_ld(&bar[XB_TMO])) break; if (sp > XB_SPIN_CAP) { atomicAdd(&bar[XB_TMO], 1u); break; } }
  }
  nloc = mine > 0u ? mine : 1u; nx = cnt > 0u ? cnt : 1u;
}
DI void xcd_barrier(const XcdBarrier& b) {
  asm volatile("s_waitcnt vmcnt(0)" ::: "memory");
  __syncthreads();
  if (threadIdx.x == 0) {
    unsigned* bar = b.bar;
    __builtin_amdgcn_s_waitcnt(0);
    unsigned nloc = b.st[0], nx = b.st[1];
    if (nloc == 0u) { xcd_barrier_complete(bar, b.x, nloc, nx); b.st[0] = nloc; b.st[1] = nx; }
    const unsigned old = xb_add(&bar[XB_XSUB(b.x)], 1u);
    const unsigned gen = old / nloc;
    if (old + 1u == (gen + 1u) * nloc) {
      __builtin_amdgcn_fence(__ATOMIC_RELEASE, "agent");
      asm volatile("s_waitcnt vmcnt(0)" ::: "memory");
      const unsigned og = xb_add(&bar[XB_TOP], 1u);
      const unsigned tg = og / nx;
      if (og + 1u == (tg + 1u) * nx) xb_add(&bar[XB_TOPGEN], 1u);
      else XB_SPIN(xb_ld(&bar[XB_TOPGEN]) == tg, bar);
      __builtin_amdgcn_fence(__ATOMIC_ACQUIRE, "agent");
      xb_add(&bar[XB_XGEN(b.x)], 1u);
      asm volatile("s_waitcnt vmcnt(0)" ::: "memory");
    } else {
      XB_SPIN(xb_ld(&bar[XB_XGEN(b.x)]) == gen, bar);
      __builtin_amdgcn_fence(__ATOMIC_ACQUIRE, "agent");
      asm volatile("s_waitcnt vmcnt(0)" ::: "memory");
    }
  }
  __syncthreads();
}

DI float2 cmul(float2 a, float2 w) { return make_float2(a.x * w.x - a.y * w.y, a.x * w.y + a.y * w.x); }
DI float2 cmulc(float2 a, float2 w) { return make_float2(a.x * w.x + a.y * w.y, a.y * w.x - a.x * w.y); }
template <int S>
DI void fft_pass_fwd(float2* X, const float2* __restrict__ tw) {
  constexpr int Q = 1 << (S - 2);
  const int tid = otid();
#pragma unroll 2
  for (int gi = 0; gi < 4; ++gi) {
    const int g = tid + 256 * gi;
    const int pos = g & (Q - 1), blk = g >> (S - 2);
    const int base = (blk << (S + 1)) + pos;
    float2 x[8];
#pragma unroll
    for (int m = 0; m < 8; ++m) x[m] = X[base + m * Q];
    const float2 wa = tw[pos << (12 - S)];
    const float2 wb = make_float2(wa.x * wa.x - wa.y * wa.y, 2.f * wa.x * wa.y);
    const float2 wc = make_float2(wb.x * wb.x - wb.y * wb.y, 2.f * wb.x * wb.y);
    const float R2 = 0.70710678118654752f;
    const float2 ws[4] = {wa, make_float2(R2 * (wa.x + wa.y), R2 * (wa.y - wa.x)), make_float2(wa.y, -wa.x),
                          make_float2(R2 * (wa.y - wa.x), -R2 * (wa.x + wa.y))};
#pragma unroll
    for (int m = 0; m < 4; ++m) {
      const float2 w = ws[m];
      const float2 a = x[m], b = x[m + 4];
      x[m] = make_float2(a.x + b.x, a.y + b.y);
      x[m + 4] = cmul(make_float2(a.x - b.x, a.y - b.y), w);
    }
    {
      const float2 w0 = wb, w1 = make_float2(wb.y, -wb.x);
#pragma unroll
      for (int b2 = 0; b2 < 8; b2 += 4)
#pragma unroll
        for (int m = 0; m < 2; ++m) {
          const float2 a = x[b2 + m], b = x[b2 + m + 2];
          x[b2 + m] = make_float2(a.x + b.x, a.y + b.y);
          x[b2 + m + 2] = cmul(make_float2(a.x - b.x, a.y - b.y), m ? w1 : w0);
        }
    }
    {
      const float2 w = wc;
#pragma unroll
      for (int m = 0; m < 8; m += 2) {
        const float2 a = x[m], b = x[m + 1];
        x[m] = make_float2(a.x + b.x, a.y + b.y);
        x[m + 1] = cmul(make_float2(a.x - b.x, a.y - b.y), w);
      }
    }
#pragma unroll
    for (int m = 0; m < 8; ++m) X[base + m * Q] = x[m];
  }
}
template <int S>
DI void fft_pass_inv(float2* X, const float2* __restrict__ tw) {
  constexpr int Q = 1 << (S - 2);
  const int tid = otid();
#pragma unroll 2
  for (int gi = 0; gi < 4; ++gi) {
    const int g = tid + 256 * gi;
    const int pos = g & (Q - 1), blk = g >> (S - 2);
    const int base = (blk << (S + 1)) + pos;
    float2 x[8];
#pragma unroll
    for (int m = 0; m < 8; ++m) x[m] = X[base + m * Q];
    const float2 wa = tw[pos << (12 - S)];
    const float2 wb = make_float2(wa.x * wa.x - wa.y * wa.y, 2.f * wa.x * wa.y);
    const float2 wc = make_float2(wb.x * wb.x - wb.y * wb.y, 2.f * wb.x * wb.y);
    const float R2 = 0.70710678118654752f;
    const float2 ws[4] = {wa, make_float2(R2 * (wa.x + wa.y), R2 * (wa.y - wa.x)), make_float2(wa.y, -wa.x),
                          make_float2(R2 * (wa.y - wa.x), -R2 * (wa.x + wa.y))};
    {
      const float2 w = wc;
#pragma unroll
      for (int m = 0; m < 8; m += 2) {
        const float2 a = x[m], b = cmulc(x[m + 1], w);
        x[m] = make_float2(a.x + b.x, a.y + b.y);
        x[m + 1] = make_float2(a.x - b.x, a.y - b.y);
      }
    }
    {
      const float2 w0 = wb, w1 = make_float2(wb.y, -wb.x);
#pragma unroll
      for (int b2 = 0; b2 < 8; b2 += 4)
#pragma unroll
        for (int m = 0; m < 2; ++m) {
          const float2 a = x[b2 + m], b = cmulc(x[b2 + m + 2], m ? w1 : w0);
          x[b2 + m] = make_float2(a.x + b.x, a.y + b.y);
          x[b2 + m + 2] = make_float2(a.x - b.x, a.y - b.y);
        }
    }
#pragma unroll
    for (int m = 0; m < 4; ++m) {
      const float2 w = ws[m];
      const float2 a = x[m], b = cmulc(x[m + 4], w);
      x[m] = make_float2(a.x + b.x, a.y + b.y);
      x[m + 4] = make_float2(a.x - b.x, a.y - b.y);
    }
#pragma unroll
    for (int m = 0; m < 8; ++m) X[base + m * Q] = x[m];
  }
}
DI void fft_stage0(float2* X) {
  const int tid = otid();
#pragma unroll 4
  for (int tt = 0; tt < 16; ++tt) {
    const int t = tid + 256 * tt;
    float4 v = *(const float4*)(X + 2 * t);
    *(float4*)(X + 2 * t) = make_float4(v.x + v.z, v.y + v.w, v.x - v.z, v.y - v.w);
  }
}
DI void fft_fwd(float2* X, const float2* __restrict__ tw) {
  __syncthreads();
  fft_pass_fwd<12>(X, tw);
  __syncthreads();
  fft_pass_fwd<9>(X, tw);
  __syncthreads();
  fft_pass_fwd<6>(X, tw);
  __syncthreads();
  fft_pass_fwd<3>(X, tw);
  __syncthreads();
  fft_stage0(X);
  __syncthreads();
}
DI void fft_inv(float2* X, const float2* __restrict__ tw) {
  __syncthreads();
  fft_stage0(X);
  __syncthreads();
  fft_pass_inv<3>(X, tw);
  __syncthreads();
  fft_pass_inv<6>(X, tw);
  __syncthreads();
  fft_pass_inv<9>(X, tw);
  __syncthreads();
  fft_pass_inv<12>(X, tw);
  __syncthreads();
}
DI int brev13(int j) { return (int)(__brev((unsigned)j) >> 19); }

DI void conv_tr_tile(const float* __restrict__ src, int src_ld, int k0, int n0, int shift,
                     bf16* __restrict__ dst, int dst_ld, float* lds) {
  const int tid = otid(), tx = tid & 63, ty = tid >> 6;
  int n = n0 + tx;
  int col = n + ((n >= 768) ? shift : 0);
#pragma unroll
  for (int i = 0; i < 16; ++i) { int kk = ty + 4 * i; lds[kk * 65 + tx] = src[(size_t)(k0 + kk) * src_ld + col]; }
  __syncthreads();
#pragma unroll
  for (int i = 0; i < 16; ++i) { int nn = ty + 4 * i; dst[(size_t)(n0 + nn) * dst_ld + k0 + tx] = f2bf(lds[tx * 65 + nn]); }
  __syncthreads();
}

DI void mod_item(const Params& p, int it, float* lds) {
  const int tid = otid();
  const int layer = it / 96, col0 = (it % 96) * 64;
  float* sv = lds;
  for (int e = tid; e < 5120; e += 256) {
    int r = e >> 10, k = e & 1023;
    float c = (r < 4) ? p.in[1][r * 1024 + k] : p.in[3][k];
    sv[e] = silu_f(c);
  }
  __syncthreads();
  const int cx = tid & 63, kg = tid >> 6;
  float acc[5] = {0.f, 0.f, 0.f, 0.f, 0.f};
  const float* w = p.in[4] + (size_t)layer * 1024 * 6144 + col0 + cx;
#pragma unroll 32
  for (int k = kg; k < 1024; k += 4) {
    float wv = w[(size_t)k * 6144];
#pragma unroll
    for (int r = 0; r < 5; ++r) acc[r] += sv[r * 1024 + k] * wv;
  }
  float* red = lds + 5120;
#pragma unroll
  for (int r = 0; r < 5; ++r) red[(kg * 5 + r) * 64 + cx] = acc[r];
  __syncthreads();
  if (tid < 64) {
    float* mod = (float*)(p.ws + OFF_MOD);
#pragma unroll
    for (int r = 0; r < 5; ++r) {
      float s = red[(0 * 5 + r) * 64 + tid] + red[(1 * 5 + r) * 64 + tid] + red[(2 * 5 + r) * 64 + tid] + red[(3 * 5 + r) * 64 + tid];
      mod[(size_t)(layer * 5 + r) * 6144 + col0 + tid] = s + p.in[5][layer * 6144 + col0 + tid];
    }
  }
  __syncthreads();
}

DI void filt_f1(const Params& p, int fid, int tile, float* lds) {
  const int tid = otid();
  const int layer = (fid == 1) ? 1 : 0;
  const int n = (fid < 2) ? 8192 : 256;
  const int pos0 = tile * 32;
  float* zf = lds;
  float* h1 = lds + 1056;
  float* h2 = h1 + 2048;
  const float* w1 = p.in[20] + layer * 33 * 64;
  const float* b1 = p.in[21] + layer * 64;
  const float* f1 = p.in[22] + layer * 64;
  const float* w2 = p.in[23] + layer * 4096;
  const float* b2 = p.in[24] + layer * 64;
  const float* f2 = p.in[25] + layer * 64;
  const float* w3 = p.in[26] + (size_t)layer * 64 * 1024;
  const float* b3 = p.in[27] + layer * 1024;
  for (int e = tid; e < 1056; e += 256) {
    int pp = e / 33, f = e % 33;
    float pos = (float)(pos0 + pp);
    float val;
    if (f == 0) val = pos / (float)(n - 1);
    else {
      int i = (f - 1) & 15;
      float fb = 1e-4f + (float)i * ((15.f - 1e-4f) / 15.f);
      float ang = ((6.2831855f * pos) * fb) / (float)n;
      val = (f <= 16) ? cosf(ang) : -sinf(ang);
    }
    zf[e] = val;
  }
  __syncthreads();
  {
    const int u = tid & 63;
    for (int q = 0; q < 8; ++q) {
      int pp = (tid >> 6) + 4 * q;
      float acc = b1[u];
      for (int f = 0; f < 33; ++f) acc += zf[pp * 33 + f] * w1[f * 64 + u];
      h1[pp * 64 + u] = __builtin_amdgcn_sinf(f1[u] * acc * 0.15915494309189535f);
    }
  }
  __syncthreads();
  {
    const int u = tid & 63;
    for (int q = 0; q < 8; ++q) {
      int pp = (tid >> 6) + 4 * q;
      float acc = b2[u];
      for (int k = 0; k < 64; ++k) acc += h1[pp * 64 + k] * w2[k * 64 + u];
      h2[pp * 64 + u] = __builtin_amdgcn_sinf(f2[u] * acc * 0.15915494309189535f);
    }
  }
  __syncthreads();
  const float dmin = -3.0701134573253945f, dmax = -15.350567286626973f;
  float* kraw = (float*)(p.ws + A_KRAW);
  float* kc = (float*)(p.ws + OFF_KC);
  float* part = (float*)(p.ws + OFF_PART);
  for (int q = 0; q < 4; ++q) {
    const int oc = tid + 256 * q, ch = oc & 255;
    float wc[64];
#pragma unroll
    for (int u = 0; u < 64; ++u) wc[u] = w3[u * 1024 + oc];
    const float bb = b3[oc];
    const float delta = fabsf(dmin + (dmax - dmin) * ((float)ch / 255.f));
    float ss = 0.f;
    float* obuf = lds + 5184;
    for (int pp = 0; pp < 32; ++pp) {
      float acc = bb;
#pragma unroll
      for (int u = 0; u < 64; ++u) acc += h2[pp * 64 + u] * wc[u];
      float t = (float)(pos0 + pp) / (float)(n - 1);
      float val = acc * expf(-t * delta);
      obuf[tid * 33 + pp] = val;
      ss += val * val;
    }
    part[((size_t)fid * 256 + tile) * 1024 + oc] = ss;
    __syncthreads();
#pragma unroll 4
    for (int r = 0; r < 32; ++r) {
      const int idx = tid + 256 * r, ol = idx >> 5, pp = idx & 31;
      const int oc2 = ol + 256 * q;
      float* dst = (fid < 2) ? (kraw + ((size_t)fid * 1024 + oc2) * 8192 + pos0) : (kc + (size_t)oc2 * 256 + pos0);
      dst[pp] = obuf[ol * 33 + pp];
    }
    __syncthreads();
  }
}

DI void filt_f2(const Params& p, int it, char* smem) {
  const int tid = otid();
  const int layer = it >> 9, order = (it >> 8) & 1, ch = it & 255;
  float2* X = (float2*)smem;
  float* red = (float*)(smem + 65536);
  const float* part = (const float*)(p.ws + OFF_PART);
  const int ocf = order * 512 + ch, ocb = ocf + 256;
  float v = part[((size_t)layer * 256 + tid) * 1024 + ocf] + part[((size_t)layer * 256 + tid) * 1024 + ocb];
  float tot = block_sum(v, red);
  const float scale = rsqrtf(tot + EPS);
  const float* kf = (const float*)(p.ws + A_KRAW) + ((size_t)layer * 1024 + ocf) * 8192;
  const float* kb = (const float*)(p.ws + A_KRAW) + ((size_t)layer * 1024 + ocb) * 8192;
  const float2* tw8 = (const float2*)(p.ws + OFF_TW8);
  const float2* tw16 = (const float2*)(p.ws + OFF_TW16);
  float2* H = (float2*)(p.ws + OFF_SPEC) + ((size_t)(layer * 2 + order) * 256 + ch) * SPEC_LD;
#pragma unroll 8
  for (int i = 0; i < 32; ++i) {
    int n = tid + 256 * i;
    float e = kf[n] + ((n >= 1) ? kb[8192 - n] : 0.f);
    X[n] = make_float2(e * scale, 0.f);
  }
  fft_fwd(X, tw8);
#pragma unroll 8
  for (int i = 0; i < 32; ++i) {
    int j = tid + 256 * i, k = brev13(j);
    if (k <= 4096) H[2 * k] = X[j];
  }
  __syncthreads();
#pragma unroll 8
  for (int i = 0; i < 32; ++i) {
    int n = tid + 256 * i;
    float o = (kf[n] - ((n >= 1) ? kb[8192 - n] : 0.f)) * scale;
    float2 w = tw16[n];
    X[n] = make_float2(o * w.x, o * w.y);
  }
  fft_fwd(X, tw8);
#pragma unroll 8
  for (int i = 0; i < 32; ++i) {
    int j = tid + 256 * i, k = brev13(j);
    if (k <= 4095) H[2 * k + 1] = X[j];
  }
  __syncthreads();
}

struct RowIn { f32x4 x0, x1, x2, x3; u32x2 y0, y1, y2, y3; };
DI RowIn row_load(int lane, const float* __restrict__ xsrc, const bf16* __restrict__ yrow, bool has_y) {
  RowIn r;
  r.x0 = *(const f32x4*)(xsrc + lane * 4); r.x1 = *(const f32x4*)(xsrc + lane * 4 + 256);
  r.x2 = *(const f32x4*)(xsrc + lane * 4 + 512); r.x3 = *(const f32x4*)(xsrc + lane * 4 + 768);
  if (has_y) {
    r.y0 = *(const u32x2*)(yrow + lane * 4); r.y1 = *(const u32x2*)(yrow + lane * 4 + 256);
    r.y2 = *(const u32x2*)(yrow + lane * 4 + 512); r.y3 = *(const u32x2*)(yrow + lane * 4 + 768);
  } else { r.y0 = u32x2{0u, 0u}; r.y1 = r.y0; r.y2 = r.y0; r.y3 = r.y0; }
  return r;
}
DI void rowpass(int lane, const RowIn& in, float* __restrict__ xdst,
                const float* __restrict__ wpost, const float* __restrict__ gate, bool has_y,
                const float* __restrict__ wpre, const float* __restrict__ scv, const float* __restrict__ shv, bool do_norm,
                bf16* __restrict__ hrow, const float* __restrict__ wdt, float* __restrict__ dtrow) {
  float xv[16] = {in.x0.x, in.x0.y, in.x0.z, in.x0.w, in.x1.x, in.x1.y, in.x1.z, in.x1.w,
                  in.x2.x, in.x2.y, in.x2.z, in.x2.w, in.x3.x, in.x3.y, in.x3.z, in.x3.w};
  if (has_y) {
    float yv[16];
    float ss = 0.f;
    {
      const unsigned yy[8] = {in.y0.x, in.y0.y, in.y1.x, in.y1.y, in.y2.x, in.y2.y, in.y3.x, in.y3.y};
#pragma unroll
      for (int q = 0; q < 8; ++q) { yv[2 * q] = __uint_as_float(yy[q] << 16); yv[2 * q + 1] = __uint_as_float(yy[q] & 0xffff0000u); }
    }
#pragma unroll
    for (int e = 0; e < 16; ++e) ss += yv[e] * yv[e];
    ss = wave_sum(ss);
    const float rstd = rsqrtf(ss * (1.f / 1024.f) + EPS);
#pragma unroll
    for (int q = 0; q < 4; ++q) {
      float4 g = *(const float4*)(gate + lane * 4 + 256 * q);
      float4 w = *(const float4*)(wpost + lane * 4 + 256 * q);
      xv[4 * q] += g.x * (yv[4 * q] * rstd * w.x);
      xv[4 * q + 1] += g.y * (yv[4 * q + 1] * rstd * w.y);
      xv[4 * q + 2] += g.z * (yv[4 * q + 2] * rstd * w.z);
      xv[4 * q + 3] += g.w * (yv[4 * q + 3] * rstd * w.w);
      *(float4*)(xdst + lane * 4 + 256 * q) = make_float4(xv[4 * q], xv[4 * q + 1], xv[4 * q + 2], xv[4 * q + 3]);
    }
  }
  if (do_norm) {
    float ss = 0.f;
#pragma unroll
    for (int e = 0; e < 16; ++e) ss += xv[e] * xv[e];
    ss = wave_sum(ss);
    const float rstd = rsqrtf(ss * (1.f / 1024.f) + EPS);
    float hv[16];
#pragma unroll
    for (int q = 0; q < 4; ++q) {
      float4 w = *(const float4*)(wpre + lane * 4 + 256 * q);
      float4 sc = *(const float4*)(scv + lane * 4 + 256 * q);
      float4 sh = *(const float4*)(shv + lane * 4 + 256 * q);
      hv[4 * q] = xv[4 * q] * rstd * w.x * (1.f + sc.x) + sh.x;
      hv[4 * q + 1] = xv[4 * q + 1] * rstd * w.y * (1.f + sc.y) + sh.y;
      hv[4 * q + 2] = xv[4 * q + 2] * rstd * w.z * (1.f + sc.z) + sh.z;
      hv[4 * q + 3] = xv[4 * q + 3] * rstd * w.w * (1.f + sc.w) + sh.w;
      uint2 o;
      o.x = pack2(hv[4 * q], hv[4 * q + 1]);
      o.y = pack2(hv[4 * q + 2], hv[4 * q + 3]);
      *(uint2*)(hrow + lane * 4 + 256 * q) = o;
    }
    if (wdt) {
      float d[8] = {0.f, 0.f, 0.f, 0.f, 0.f, 0.f, 0.f, 0.f};
#pragma unroll
      for (int q = 0; q < 4; ++q) {
#pragma unroll
        for (int dd = 0; dd < 8; ++dd) {
          float4 w = *(const float4*)(wdt + dd * 1028 + lane * 4 + 256 * q);
          d[dd] += hv[4 * q] * w.x + hv[4 * q + 1] * w.y + hv[4 * q + 2] * w.z + hv[4 * q + 3] * w.w;
        }
      }
#pragma unroll
      for (int k = 0; k < 8; ++k) d[k] = wave_sum(d[k]);
      if (lane == 0) {
        *(float4*)dtrow = make_float4(d[0], d[1], d[2], d[3]);
        *(float4*)(dtrow + 4) = make_float4(d[4], d[5], d[6], d[7]);
      }
    }
  }
}

DI void rowpass_phase(const Params& p, int layer, int mode, char* smem) {
  const int lane = otid() & 63, wave = otid() >> 6;
  const int nrows = (mode == 0 || layer == 0) ? MROWS : NLAT;
  const float* modb = (const float*)(p.ws + OFF_MOD);
  float* wl = (float*)smem;
  if (mode == 0 || (mode == 2 && layer + 1 < 2)) {
    const int nl = (mode == 0) ? layer : (layer + 1);
    const float* wsrc = p.in[10] + (size_t)nl * 1024 * 2568 + 768;
    for (int e = otid(); e < 8192; e += 256) wl[(e & 7) * 1028 + (e >> 3)] = wsrc[(size_t)(e >> 3) * 2568 + (e & 7)];
    __syncthreads();
  }
  const bool first = (layer == 0 && mode <= 1);
  const bool has_y = (mode != 0);
  const bf16* ybase = (const bf16*)(p.ws + A_YOUT);
  auto xsrc_of = [&](int row) -> const float* {
    if (row < NLAT) return first ? (p.in[0] + (size_t)row * 1024) : (p.out + (size_t)row * 1024);
    return first ? (p.in[2] + (size_t)(row - NLAT) * 1024) : ((const float*)(p.ws + OFF_CTXS) + (size_t)(row - NLAT) * 1024);
  };
  int r4 = blockIdx.x;
  if (r4 * 4 >= nrows) return;
  RowIn cur = row_load(lane, xsrc_of(r4 * 4 + wave), ybase + (size_t)(r4 * 4 + wave) * 1024, has_y);
  for (; r4 * 4 < nrows; r4 += gridDim.x) {
    const int row = r4 * 4 + wave;
    const int rn = row + 4 * (int)gridDim.x;
    RowIn nxt = cur;
    if (rn < nrows) nxt = row_load(lane, xsrc_of(rn), ybase + (size_t)rn * 1024, has_y);
    const int mb = (row < NLAT) ? (row >> 13) : 4;
    float* xdst = (row < NLAT) ? (p.out + (size_t)row * 1024) : ((float*)(p.ws + OFF_CTXS) + (size_t)(row - NLAT) * 1024);
    const float* mv = modb + (size_t)(layer * 5 + mb) * 6144;
    bf16* hrow = (bf16*)(p.ws + A_HBUF) + (size_t)row * 1024;
    float* dtrow = (float*)(p.ws + OFF_DT) + (size_t)row * 8;
    if (mode == 0) {
      rowpass(lane, cur, xdst, nullptr, nullptr, false, p.in[6] + layer * 1024, mv + 1024, mv, true, hrow, wl, dtrow);
    } else if (mode == 1) {
      rowpass(lane, cur, xdst, p.in[7] + layer * 1024, mv + 2048, true, p.in[8] + layer * 1024, mv + 4 * 1024, mv + 3 * 1024,
              true, hrow, nullptr, dtrow);
    } else {
      const bool nxtl = (layer + 1 < 2);
      const float* mvn = modb + (size_t)((layer + 1) * 5 + mb) * 6144;
      rowpass(lane, cur, xdst, p.in[9] + layer * 1024, mv + 5 * 1024, true, p.in[6] + (layer + 1) * 1024, mvn + 1024, mvn, nxtl,
              hrow, nxtl ? wl : nullptr, dtrow);
    }
    cur = nxt;
  }
}

DI void gload16(u32x4& dst, const bf16* sbase, unsigned voff) {
  asm volatile("global_load_dwordx4 %0, %1, %2" : "=&v"(dst) : "v"(voff), "s"(sbase) : "memory");
}
DI const bf16* uniform_ptr(const bf16* p) {
  unsigned long long v = (unsigned long long)p;
  unsigned lo = __builtin_amdgcn_readfirstlane((unsigned)v), hi = __builtin_amdgcn_readfirstlane((unsigned)(v >> 32));
  return (const bf16*)(((unsigned long long)hi << 32) | lo);
}
#define GEMM_GROUP(ks)                                                                         \
    {                                                                                          \
      bf16x8 a0 = *(const bf16x8*)(st + aoff + (ks) * 32);                                     \
      bf16x8 a1 = *(const bf16x8*)(st + aoff + 32 * 144 + (ks) * 32);                          \
      bf16x8 b0 = *(const bf16x8*)(st + boff + (ks) * 32);                                     \
      bf16x8 b1 = *(const bf16x8*)(st + boff + 32 * 144 + (ks) * 32);                          \
      acc00 = MFMA(a0, b0, acc00);                                                             \
      acc01 = MFMA(a0, b1, acc01);                                                             \
      acc10 = MFMA(a1, b0, acc10);                                                             \
      acc11 = MFMA(a1, b1, acc11);                                                             \
    }
#define GEMM_ITER(KT_, LA, LB, SA, SB)                                                        \
  {                                                                                            \
    const int kt_ = (KT_);                                                                     \
    const char* st = smem + (kt_ & 1) * 36864;                                                 \
    char* sn = smem + ((kt_ + 1) & 1) * 36864;                                                 \
    GEMM_GROUP(0)                                                                              \
    if (kt_ + 2 < KT) {                                                                        \
      gload16(LA[0], As + (kt_ + 2) * 64, voa);               gload16(LB[0], Bs + (kt_ + 2) * 64, vob);  \
      gload16(LA[1], As + (kt_ + 2) * 64, voa + sa32);        gload16(LB[1], Bs + (kt_ + 2) * 64, vob + sb32); \
    }                                                                                          \
    __builtin_amdgcn_sched_barrier(0);                                                         \
    GEMM_GROUP(1)                                                                              \
    if (kt_ + 2 < KT) {                                                                        \
      gload16(LA[2], As + (kt_ + 2) * 64, voa + 2 * sa32);    gload16(LB[2], Bs + (kt_ + 2) * 64, vob + 2 * sb32); \
      gload16(LA[3], As + (kt_ + 2) * 64, voa + 3 * sa32);    gload16(LB[3], Bs + (kt_ + 2) * 64, vob + 3 * sb32); \
    }                                                                                          \
    __builtin_amdgcn_sched_barrier(0);                                                         \
    if (kt_ + 2 < KT) asm volatile("s_waitcnt vmcnt(8)" ::: "memory");                         \
    else asm volatile("s_waitcnt vmcnt(0)" ::: "memory");                                      \
    GEMM_GROUP(2)                                                                              \
    if (kt_ + 1 < KT) {                                                                        \
      *(u32x4*)(sn + soff) = SA[0];                  *(u32x4*)(sn + 18432 + soff) = SB[0];     \
      *(u32x4*)(sn + soff + 32 * 144) = SA[1];       *(u32x4*)(sn + 18432 + soff + 32 * 144) = SB[1]; \
    }                                                                                          \
    __builtin_amdgcn_sched_barrier(0);                                                         \
    GEMM_GROUP(3)                                                                              \
    if (kt_ + 1 < KT) {                                                                        \
      *(u32x4*)(sn + soff + 64 * 144) = SA[2];       *(u32x4*)(sn + 18432 + soff + 64 * 144) = SB[2]; \
      *(u32x4*)(sn + soff + 96 * 144) = SA[3];       *(u32x4*)(sn + 18432 + soff + 96 * 144) = SB[3]; \
    }                                                                                          \
    __builtin_amdgcn_sched_barrier(0);                                                         \
    __syncthreads();                                                                           \
  }

DI void gemm_tile(const bf16* __restrict__ A, int lda, const bf16* __restrict__ Bt, int ldb, int K, char* smem) {
  const int tid = otid(), lane = tid & 63, wave = tid >> 6, r = lane & 31, h = lane >> 5, wm = wave >> 1, wn = wave & 1;
  const int lrow = tid >> 3, lkc = tid & 7;
  const bf16* ag = A + (size_t)lrow * lda + lkc * 8;
  const bf16* bg = Bt + (size_t)lrow * ldb + lkc * 8;
  const size_t lda32 = (size_t)32 * lda, ldb32 = (size_t)32 * ldb;
  const int soff = lrow * 144 + lkc * 16;
  const int aoff = (wm * 64 + r) * 144 + h * 16;
  const int boff = 18432 + (wn * 64 + r) * 144 + h * 16;
  const int KT = K >> 6;
  u32x4 ra0[4], rb0[4], ra1[4], rb1[4];
#pragma unroll
  for (int i = 0; i < 4; ++i) {
    ra0[i] = *(const u32x4*)(ag + i * lda32);
    rb0[i] = *(const u32x4*)(bg + i * ldb32);
  }
#pragma unroll
  for (int i = 0; i < 4; ++i) {
    *(u32x4*)(smem + soff + i * 32 * 144) = ra0[i];
    *(u32x4*)(smem + 18432 + soff + i * 32 * 144) = rb0[i];
  }
  const bf16* As = uniform_ptr(A);
  const bf16* Bs = uniform_ptr(Bt);
  const unsigned voa = (unsigned)(lrow * lda + lkc * 8) * 2u, vob = (unsigned)(lrow * ldb + lkc * 8) * 2u;
  const unsigned sa32 = (unsigned)lda * 64u, sb32 = (unsigned)ldb * 64u;
#pragma unroll
  for (int i = 0; i < 4; ++i) {
    gload16(ra1[i], As + 64, voa + i * sa32);
    gload16(rb1[i], Bs + 64, vob + i * sb32);
  }
  __syncthreads();
  f32x16 acc00, acc01, acc10, acc11;
#pragma unroll
  for (int e = 0; e < 16; ++e) { acc00[e] = 0.f; acc01[e] = 0.f; acc10[e] = 0.f; acc11[e] = 0.f; }
#pragma unroll 1
  for (int kt = 0; kt < KT; kt += 2) {
    GEMM_ITER(kt, ra0, rb0, ra1, rb1)
    GEMM_ITER(kt + 1, ra1, rb1, ra0, rb0)
  }
  float* Cs = (float*)smem;
#pragma unroll
  for (int e = 0; e < 16; ++e) {
    const int rr = (e & 3) + 8 * (e >> 2) + 4 * h;
    Cs[(wm * 64 + rr) * 132 + wn * 64 + r] = acc00[e];
    Cs[(wm * 64 + rr) * 132 + wn * 64 + 32 + r] = acc01[e];
    Cs[(wm * 64 + 32 + rr) * 132 + wn * 64 + r] = acc10[e];
    Cs[(wm * 64 + 32 + rr) * 132 + wn * 64 + 32 + r] = acc11[e];
  }
  __syncthreads();
}

DI void epi_store_bf16(const float* Cs, bf16* __restrict__ dst, int ld, bool sqrelu) {
  const int tid = otid();
#pragma unroll
  for (int i = 0; i < 8; ++i) {
    int c = tid + 256 * i;
    int row = c >> 4, cc = (c & 15) * 8;
    float4 v0 = *(const float4*)(Cs + row * 132 + cc);
    float4 v1 = *(const float4*)(Cs + row * 132 + cc + 4);
    if (sqrelu) {
      v0.x = fmaxf(v0.x, 0.f); v0.x *= v0.x; v0.y = fmaxf(v0.y, 0.f); v0.y *= v0.y;
      v0.z = fmaxf(v0.z, 0.f); v0.z *= v0.z; v0.w = fmaxf(v0.w, 0.f); v0.w *= v0.w;
      v1.x = fmaxf(v1.x, 0.f); v1.x *= v1.x; v1.y = fmaxf(v1.y, 0.f); v1.y *= v1.y;
      v1.z = fmaxf(v1.z, 0.f); v1.z *= v1.z; v1.w = fmaxf(v1.w, 0.f); v1.w *= v1.w;
    }
    uint4 o;
    o.x = pack2(v0.x, v0.y); o.y = pack2(v0.z, v0.w); o.z = pack2(v1.x, v1.y); o.w = pack2(v1.z, v1.w);
    *(uint4*)(dst + (size_t)row * ld + cc) = o;
  }
}
DI void epi_store_tr(const float* Cs, bf16* __restrict__ dst, size_t ldc) {
  const int tid = otid(), pcl = tid & 3, colb = tid >> 2;
#pragma unroll
  for (int i = 0; i < 8; ++i) {
    const int col = colb + 64 * (i & 1);
    const int pc = pcl + 4 * (i >> 1);
    float v[8];
#pragma unroll
    for (int e = 0; e < 8; ++e) v[e] = Cs[(pc * 8 + e) * 132 + col];
    uint4 o;
    o.x = pack2(v[0], v[1]); o.y = pack2(v[2], v[3]); o.z = pack2(v[4], v[5]); o.w = pack2(v[6], v[7]);
    *(uint4*)(dst + (size_t)col * ldc + pc * 8) = o;
  }
}

DI void gemm1_epilogue(const Params& p, int layer, int m0, int nt, const float* Cs) {
  const int tid = otid();
  const bool is_ctx = (m0 >= NLAT);
  const int b = is_ctx ? ((m0 - NLAT) >> 8) : (m0 >> 13);
  const int pos0 = is_ctx ? ((m0 - NLAT) & 255) : (m0 & 8191);
  if (nt < 6) {
    epi_store_bf16(Cs, (bf16*)(p.ws + A_PROJA) + (size_t)m0 * 768 + nt * 128, 768, false);
  } else if (nt < 12) {
    const int ch0 = (nt - 6) * 128;
    if (!is_ctx) epi_store_tr(Cs, (bf16*)(p.ws + A_HYRAW) + ((size_t)(b * 768 + ch0)) * 8192 + pos0, 8192);
    else epi_store_tr(Cs, (bf16*)(p.ws + A_HYRAWC) + ((size_t)(b * 768 + ch0)) * 256 + pos0, 256);
  } else {
    const int g = (nt - 12) >> 2, tt = (nt - 12) & 3;
    const int kpos0 = is_ctx ? (SEQ + pos0) : pos0;
    if (tt == 3) {
      bf16* dst = (bf16*)(p.ws + A_VT) + ((size_t)((g * 4 + b) * 2) * 64) * KEYS + kpos0;
      epi_store_tr(Cs, dst, KEYS);
    } else {
      const int row = tid & 127, hh = tid >> 7;
      float v[64];
#pragma unroll
      for (int d4 = 0; d4 < 16; ++d4) {
        float4 t = *(const float4*)(Cs + row * 132 + hh * 64 + d4 * 4);
        v[d4 * 4] = t.x; v[d4 * 4 + 1] = t.y; v[d4 * 4 + 2] = t.z; v[d4 * 4 + 3] = t.w;
      }
      const bool isq = (tt < 2);
      if (g == 1) {
        const float* wn = (isq ? p.in[30] : p.in[31]) + layer * 64;
        float ss = 0.f;
#pragma unroll
        for (int d = 0; d < 64; ++d) ss += v[d] * v[d];
        const float rstd = rsqrtf(ss * (1.f / 64.f) + EPS);
#pragma unroll
        for (int d = 0; d < 64; ++d) v[d] = v[d] * rstd * wn[d];
      }
      if (!is_ctx) {
        constexpr float kInvRev[16] = {
            1.591549431e-01f, 8.949940161e-02f, 5.032921210e-02f, 2.830219583e-02f, 1.591549431e-02f, 8.949940161e-03f, 5.032921210e-03f, 2.830219583e-03f, 1.591549431e-03f, 8.949940161e-04f, 5.032921210e-04f, 2.830219583e-04f, 1.591549431e-04f, 8.949940161e-05f, 5.032921210e-05f, 2.830219583e-05f};
        const float frow = (float)((pos0 + row) >> 6), fcol = (float)((pos0 + row) & 63);
#pragma unroll
        for (int i = 0; i < 32; ++i) {
          const float rev = ((i < 16) ? frow : fcol) * kInvRev[i & 15];
          const float cs_x = __builtin_amdgcn_cosf(rev), cs_y = __builtin_amdgcn_sinf(rev);
          float a = v[i], bb = v[i + 32];
          v[i] = a * cs_x - bb * cs_y;
          v[i + 32] = a * cs_y + bb * cs_x;
        }
      }
      bf16* dst;
      if (isq) {
        const int head = tt * 2 + hh;
#pragma unroll
        for (int d = 0; d < 64; ++d) v[d] *= (0.125f * LOG2E);
        dst = (bf16*)(p.ws + A_QB) + ((size_t)((g * 4 + b) * 4 + head) * KEYS + kpos0 + row) * 64;
      } else {
        dst = (bf16*)(p.ws + A_KB) + ((size_t)((g * 4 + b) * 2 + hh) * KEYS + kpos0 + row) * 64;
      }
#pragma unroll
      for (int c = 0; c < 8; ++c) {
        uint4 o;
        o.x = pack2(v[c * 8], v[c * 8 + 1]); o.y = pack2(v[c * 8 + 2], v[c * 8 + 3]);
        o.z = pack2(v[c * 8 + 4], v[c * 8 + 5]); o.w = pack2(v[c * 8 + 6], v[c * 8 + 7]);
        *(uint4*)(dst + c * 8) = o;
      }
    }
  }
}

DI void gemm_epilogue(const Params& p, int layer, int which, int mt, int mt_lo, int nt, const float* Cs) {
  if (which == 1) gemm1_epilogue(p, layer, mt * 128, nt, Cs);
  else if (which == 2) epi_store_bf16(Cs, (bf16*)(p.ws + A_YOUT) + (size_t)(mt * 128) * 1024 + nt * 128, 1024, false);
  else if (which == 3) epi_store_bf16(Cs, (bf16*)(p.ws + A_HID) + (size_t)((mt - mt_lo) * 128) * 4096 + nt * 128, 4096, true);
  else epi_store_bf16(Cs, (bf16*)(p.ws + A_YOUT) + (size_t)(mt * 128) * 1024 + nt * 128, 1024, false);
}

DI void glds16(const bf16* sbase, unsigned voff, unsigned lds_dst) {
  unsigned keep;
  asm volatile("s_mov_b32 %0, m0\n\ts_mov_b32 m0, %3\n\ts_nop 0\n\tglobal_load_lds_dwordx4 %1, %2\n\ts_mov_b32 m0, %0"
               : "=&s"(keep) : "v"(voff), "s"(sbase), "s"(lds_dst) : "memory");
}
#define G2_GROUP(AO, BO)                                                                       \
    {                                                                                          \
      bf16x8 a0 = *(const bf16x8*)(st + (AO));                                                 \
      bf16x8 a1 = *(const bf16x8*)(st + (AO) + 2048);                                          \
      bf16x8 b0 = *(const bf16x8*)(st + (BO));                                                 \
      bf16x8 b1 = *(const bf16x8*)(st + (BO) + 2048);                                          \
      bf16x8 b2 = *(const bf16x8*)(st + (BO) + 4096);                                          \
      bf16x8 b3 = *(const bf16x8*)(st + (BO) + 6144);                                          \
      c00 = MFMA(a0, b0, c00); c01 = MFMA(a0, b1, c01); c02 = MFMA(a0, b2, c02); c03 = MFMA(a0, b3, c03); \
      c10 = MFMA(a1, b0, c10); c11 = MFMA(a1, b1, c11); c12 = MFMA(a1, b2, c12); c13 = MFMA(a1, b3, c13); \
    }
#define G2_DMA(KT_, STG)                                                                       \
  {                                                                                            \
    const unsigned lb_ = ldsbase + (STG) * 24576u;                                             \
    glds16(As + (KT_) * 32, voa0, lb_ + wq * 2048u);                                           \
    glds16(As + (KT_) * 32, voa0 + ra16, lb_ + wq * 2048u + 1024u);                            \
    glds16(Bs + (KT_) * 32, vob0, lb_ + 8192u + wq * 4096u);                                   \
    glds16(Bs + (KT_) * 32, vob0 + rb16, lb_ + 8192u + wq * 4096u + 1024u);                    \
    glds16(Bs + (KT_) * 32, vob0 + 2 * rb16, lb_ + 8192u + wq * 4096u + 2048u);                \
    glds16(Bs + (KT_) * 32, vob0 + 3 * rb16, lb_ + 8192u + wq * 4096u + 3072u);                \
  }

DI void gemm_tile2(const Params& p, int layer, int which, int mt, int mt_lo, int nt2, const bf16* __restrict__ A, int lda,
                   const bf16* __restrict__ Bt, int ldb, int K, char* smem) {
  const int tid = otid(), lane = tid & 63, wave = tid >> 6, r = lane & 31, h = lane >> 5, wm = wave >> 1, wn = wave & 1;
  const unsigned wq = (unsigned)__builtin_amdgcn_readfirstlane(wave);
  const unsigned ldsbase = (unsigned)(size_t)(LAS char*)smem;
  const bf16* As = uniform_ptr(A);
  const bf16* Bs = uniform_ptr(Bt);
  const int lr = lane >> 2, cp = lane & 3, gc = cp ^ ((lr >> 2) & 3);
  const unsigned voa0 = (unsigned)((wave * 32 + lr) * lda + gc * 8) * 2u;
  const unsigned vob0 = (unsigned)((wave * 64 + lr) * ldb + gc * 8) * 2u;
  const unsigned ra16 = (unsigned)lda * 32u, rb16 = (unsigned)ldb * 32u;
  const int sw = (r >> 2) & 3;
  const int cx0 = ((h ^ sw) * 16), cx1 = (((2 + h) ^ sw) * 16);
  const int arow = (wm * 64 + r) * 64, brow = 8192 + (wn * 128 + r) * 64;
  const int KT = K >> 5;
  G2_DMA(0, 0u)
  G2_DMA(1, 1u)
  asm volatile("s_waitcnt vmcnt(6)" ::: "memory");
  __syncthreads();
  f32x16 c00, c01, c02, c03, c10, c11, c12, c13;
#pragma unroll
  for (int e = 0; e < 16; ++e) { c00[e] = 0.f; c01[e] = 0.f; c02[e] = 0.f; c03[e] = 0.f; c10[e] = 0.f; c11[e] = 0.f; c12[e] = 0.f; c13[e] = 0.f; }
  unsigned cur = 0u, nx2 = 2u;
#pragma unroll 1
  for (int kt = 0; kt < KT; ++kt) {
    if (kt + 2 < KT) G2_DMA(kt + 2, nx2)
    __builtin_amdgcn_sched_barrier(0);
    const char* st = smem + cur * 24576u;
    G2_GROUP(arow + cx0, brow + cx0)
    G2_GROUP(arow + cx1, brow + cx1)
    __builtin_amdgcn_sched_barrier(0);
    if (kt + 2 < KT) asm volatile("s_waitcnt vmcnt(6)" ::: "memory");
    else asm volatile("s_waitcnt vmcnt(0)" ::: "memory");
    __syncthreads();
    cur = (cur == 2u) ? 0u : cur + 1u;
    nx2 = (nx2 == 2u) ? 0u : nx2 + 1u;
  }
  float* Cs = (float*)smem;
#pragma unroll 1
  for (int nh = 0; nh < 2; ++nh) {
    if (wn == nh) {
#pragma unroll
      for (int e = 0; e < 16; ++e) {
        const int rr = (e & 3) + 8 * (e >> 2) + 4 * h;
        float* c0 = Cs + (wm * 64 + rr) * 132 + r;
        float* c1 = Cs + (wm * 64 + 32 + rr) * 132 + r;
        c0[0] = c00[e]; c0[32] = c01[e]; c0[64] = c02[e]; c0[96] = c03[e];
        c1[0] = c10[e]; c1[32] = c11[e]; c1[64] = c12[e]; c1[96] = c13[e];
      }
    }
    __syncthreads();
    gemm_epilogue(p, layer, which, mt, mt_lo, nt2 * 2 + nh, Cs);
    __syncthreads();
  }
}

DI void gemm_phase(const Params& p, int layer, int which, int half, char* smem) {
  const int mt_all = ((which == 1 || layer == 0) ? MROWS : NLAT) / 128;
  const int mt_lo = (which >= 3 && half) ? 128 : 0;
  const int mt_hi = (which >= 3 && !half) ? 128 : mt_all;
  const int mt_big_hi = (which == 1) ? mt_lo : ((mt_hi < 256) ? mt_hi : 256);
  int NT, K, lda, ldb;
  const bf16 *A, *Bt;
  if (which == 1) { NT = 20; K = 1024; A = (const bf16*)(p.ws + A_HBUF); lda = 1024; Bt = (const bf16*)(p.ws + OFF_WIN) + (size_t)layer * 2560 * 1024; ldb = 1024; }
  else if (which == 2) { NT = 8; K = 1024; A = (const bf16*)(p.ws + A_YMIX); lda = 1024; Bt = (const bf16*)(p.ws + OFF_WOUT) + (size_t)layer * 1024 * 1024; ldb = 1024; }
  else if (which == 3) { NT = 32; K = 1024; A = (const bf16*)(p.ws + A_HBUF); lda = 1024; Bt = (const bf16*)(p.ws + OFF_W1) + (size_t)layer * 4096 * 1024; ldb = 1024; }
  else { NT = 8; K = 4096; A = (const bf16*)(p.ws + A_HID) - (size_t)mt_lo * 128 * 4096; lda = 4096; Bt = (const bf16*)(p.ws + OFF_W2) + (size_t)layer * 1024 * 4096; ldb = 4096; }
  const int NT2 = NT >> 1;
  const int nbig = (mt_big_hi - mt_lo) * NT2;
  if (which != 1)
  for (int t = blockIdx.x; t < nbig; t += gridDim.x) {
    const int mt = mt_lo + t / NT2, nt2 = t % NT2;
    gemm_tile2(p, layer, which, mt, mt_lo, nt2, A + (size_t)mt * 128 * lda, lda, Bt + (size_t)nt2 * 256 * ldb, ldb, K, smem);
  }
  const int nsmall = (mt_hi - mt_big_hi) * NT;
  for (int t = blockIdx.x; t < nsmall; t += gridDim.x) {
    const int mt = mt_big_hi + t / NT, nt = t % NT;
    gemm_tile(A + (size_t)mt * 128 * lda, lda, Bt + (size_t)nt * 128 * ldb, ldb, K, smem);
    gemm_epilogue(p, layer, which, mt, mt_lo, nt, (const float*)smem);
    __syncthreads();
  }
}

DI void attn_item(const bf16* __restrict__ Q, const bf16* __restrict__ Kb, const bf16* __restrict__ VT, int q0, int lo, int hi,
                  int nctx_tiles, bool window, bool has_sink, float sink_l2, bf16* __restrict__ out, char* smem) {
  const int tid = otid(), lane = tid & 63, wave = tid >> 6, r = lane & 31, h = lane >> 5;
  bf16x8 qf[4];
  {
    const bf16* qp = Q + (size_t)(q0 + wave * 32 + r) * 64 + h * 8;
#pragma unroll
    for (int ks = 0; ks < 4; ++ks) qf[ks] = *(const bf16x8*)(qp + ks * 16);
  }
  const int ntl = (hi - lo) >> 6;
  const int nt = ntl + nctx_tiles;
  f32x16 o0, o1;
#pragma unroll
  for (int e = 0; e < 16; ++e) { o0[e] = 0.f; o1[e] = 0.f; }
  float m = has_sink ? sink_l2 : -1e30f;
  float l = (has_sink && h == 0) ? 1.f : 0.f;
  const int qpos = q0 + wave * 32 + r;
  const int c0 = tid, c1 = tid + 256;
  const int lr0 = c0 >> 3, lk0 = c0 & 7, lr1 = c1 >> 3, lk1 = c1 & 7;
  uint4 rk0, rk1, rv0, rv1;
  {
    int key0 = (0 < ntl) ? lo : SEQ;
    rk0 = *(const uint4*)(Kb + (size_t)(key0 + lr0) * 64 + lk0 * 8);
    rk1 = *(const uint4*)(Kb + (size_t)(key0 + lr1) * 64 + lk1 * 8);
    rv0 = *(const uint4*)(VT + (size_t)lr0 * KEYS + key0 + lk0 * 8);
    rv1 = *(const uint4*)(VT + (size_t)lr1 * KEYS + key0 + lk1 * 8);
  }
  *(uint4*)(smem + lr0 * 144 + lk0 * 16) = rk0;
  *(uint4*)(smem + lr1 * 144 + lk1 * 16) = rk1;
  *(uint4*)(smem + 9216 + lr0 * 144 + lk0 * 16) = rv0;
  *(uint4*)(smem + 9216 + lr1 * 144 + lk1 * 16) = rv1;
  __syncthreads();
  for (int ti = 0; ti < nt; ++ti) {
    const int key0 = (ti < ntl) ? (lo + ti * 64) : (SEQ + (ti - ntl) * 64);
    if (ti + 1 < nt) {
      const int kn = (ti + 1 < ntl) ? (lo + (ti + 1) * 64) : (SEQ + (ti + 1 - ntl) * 64);
      rk0 = *(const uint4*)(Kb + (size_t)(kn + lr0) * 64 + lk0 * 8);
      rk1 = *(const uint4*)(Kb + (size_t)(kn + lr1) * 64 + lk1 * 8);
      rv0 = *(const uint4*)(VT + (size_t)lr0 * KEYS + kn + lk0 * 8);
      rv1 = *(const uint4*)(VT + (size_t)lr1 * KEYS + kn + lk1 * 8);
    }
    __builtin_amdgcn_sched_barrier(0);
    const char* Ks = smem + (ti & 1) * 18432;
    const char* Vs = Ks + 9216;
    f32x16 s0, s1;
#pragma unroll
    for (int e = 0; e < 16; ++e) { s0[e] = 0.f; s1[e] = 0.f; }
#pragma unroll
    for (int ks = 0; ks < 4; ++ks) {
      bf16x8 a0 = *(const bf16x8*)(Ks + r * 144 + ks * 32 + h * 16);
      bf16x8 a1 = *(const bf16x8*)(Ks + (32 + r) * 144 + ks * 32 + h * 16);
      s0 = MFMA(a0, qf[ks], s0);
      s1 = MFMA(a1, qf[ks], s1);
    }
    if (window && key0 < SEQ) {
#pragma unroll
      for (int e = 0; e < 16; ++e) {
        int kp = key0 + (e & 3) + 8 * (e >> 2) + 4 * h;
        int d0 = qpos - kp; d0 = d0 < 0 ? -d0 : d0;
        int d1 = qpos - (kp + 32); d1 = d1 < 0 ? -d1 : d1;
        if (d0 > 128) s0[e] = -1e30f;
        if (d1 > 128) s1[e] = -1e30f;
      }
    }
    float mx = s0[0];
#pragma unroll
    for (int e = 1; e < 16; ++e) mx = fmaxf(mx, s0[e]);
#pragma unroll
    for (int e = 0; e < 16; ++e) mx = fmaxf(mx, s1[e]);
    mx = fmaxf(mx, __shfl_xor(mx, 32));
    const float mnew = fmaxf(m, mx);
    const float alpha = __builtin_amdgcn_exp2f(m - mnew);
    m = mnew;
    float ls = 0.f;
#pragma unroll
    for (int e = 0; e < 16; ++e) {
      s0[e] = __builtin_amdgcn_exp2f(s0[e] - mnew);
      s1[e] = __builtin_amdgcn_exp2f(s1[e] - mnew);
      ls += s0[e] + s1[e];
    }
    l = l * alpha + ls;
#pragma unroll
    for (int e = 0; e < 16; ++e) { o0[e] *= alpha; o1[e] *= alpha; }
#pragma unroll
    for (int kb = 0; kb < 2; ++kb) {
#pragma unroll
      for (int s2 = 0; s2 < 2; ++s2) {
        unsigned pk[4];
#pragma unroll
        for (int j = 0; j < 4; ++j) {
          float x0 = kb ? s1[8 * s2 + 2 * j] : s0[8 * s2 + 2 * j];
          float x1 = kb ? s1[8 * s2 + 2 * j + 1] : s0[8 * s2 + 2 * j + 1];
          pk[j] = pack2(x0, x1);
        }
        uint4 pku = make_uint4(pk[0], pk[1], pk[2], pk[3]);
        bf16x8 pf = __builtin_bit_cast(bf16x8, pku);
        const char* vb = Vs + r * 144 + (kb * 32 + 16 * s2 + 4 * h) * 2;
        s16x4 lo0 = *(const s16x4*)(vb);
        s16x4 hi0 = *(const s16x4*)(vb + 16);
        s16x4 lo1 = *(const s16x4*)(vb + 32 * 144);
        s16x4 hi1 = *(const s16x4*)(vb + 32 * 144 + 16);
        bf16x8 v0 = __builtin_shufflevector(lo0, hi0, 0, 1, 2, 3, 4, 5, 6, 7);
        bf16x8 v1 = __builtin_shufflevector(lo1, hi1, 0, 1, 2, 3, 4, 5, 6, 7);
        o0 = MFMA(v0, pf, o0);
        o1 = MFMA(v1, pf, o1);
      }
    }
    if (ti + 1 < nt) {
      char* sn = smem + ((ti + 1) & 1) * 18432;
      *(uint4*)(sn + lr0 * 144 + lk0 * 16) = rk0;
      *(uint4*)(sn + lr1 * 144 + lk1 * 16) = rk1;
      *(uint4*)(sn + 9216 + lr0 * 144 + lk0 * 16) = rv0;
      *(uint4*)(sn + 9216 + lr1 * 144 + lk1 * 16) = rv1;
    }
    __syncthreads();
  }
  const float lt = l + __shfl_xor(l, 32);
  const float inv = 1.f / lt;
  bf16* Os = (bf16*)(smem + 36864);
  {
    const int q = wave * 32 + r;
#pragma unroll
    for (int e = 0; e < 16; e += 2) {
      int d = (e & 3) + 8 * (e >> 2) + 4 * h;
      *(unsigned*)(Os + q * 72 + d) = pack2(o0[e] * inv, o0[e + 1] * inv);
      *(unsigned*)(Os + q * 72 + 32 + d) = pack2(o1[e] * inv, o1[e + 1] * inv);
    }
  }
  __syncthreads();
#pragma unroll
  for (int i = 0; i < 4; ++i) {
    int c = tid + 256 * i;
    int row = c >> 3, ch = c & 7;
    *(uint4*)(out + (size_t)row * 1024 + ch * 8) = *(const uint4*)(Os + row * 72 + ch * 8);
  }
  __syncthreads();
}

DI float conv3_at(const bf16* __restrict__ raw, int n, int len, float w0, float w1, float w2, float bb) {
  const int nm = (n >= 1) ? (n - 1) : 0, np = (n + 1 < len) ? (n + 1) : (len - 1);
  const float vm = bf2f(raw[nm]), v0 = bf2f(raw[n]), vp = bf2f(raw[np]);
  return bb + w1 * v0 + ((n >= 1) ? w0 * vm : 0.f) + ((n + 1 < len) ? w2 * vp : 0.f);
}

DI void hyena_fft_item(const Params& p, int layer, int it, char* smem) {
  const int tid = otid();
  const int ch = it & 255, bp = it >> 8, b0 = 2 * bp, b1 = b0 + 1;
  float2* X = (float2*)smem;
  const bf16* hyraw = (const bf16*)(p.ws + A_HYRAW);
  const float* cw = p.in[18] + layer * 3 * 768;
  const float* cb = p.in[19] + layer * 768;
  const float* hb = p.in[28] + layer * 2 * 256;
  const float2* tw8 = (const float2*)(p.ws + OFF_TW8);
  const float2* tw16 = (const float2*)(p.ws + OFF_TW16);
  bf16* ho0 = (bf16*)(p.ws + A_HYOUT) + ((size_t)(b0 * 256 + ch)) * 8192;
  bf16* ho1 = (bf16*)(p.ws + A_HYOUT) + ((size_t)(b1 * 256 + ch)) * 8192;
  float2* escr = (blockIdx.x < 256) ? ((float2*)(p.ws + A_ESCR0) + (size_t)blockIdx.x * 8192)
                                    : ((float2*)(p.ws + A_ESCR1) + (size_t)(blockIdx.x - 256) * 8192);
  const float vw0 = cw[ch], vw1 = cw[768 + ch], vw2 = cw[1536 + ch], vbb = cb[ch];
  const bf16* r0 = hyraw + ((size_t)(b0 * 768 + ch)) * 8192;
  const bf16* r1 = hyraw + ((size_t)(b1 * 768 + ch)) * 8192;
#pragma unroll 1
  for (int o = 0; o < 2; ++o) {
    const float2* Hl = (const float2*)(p.ws + OFF_SPEC) + ((size_t)(layer * 2 + o) * 256 + ch) * SPEC_LD;
#pragma unroll 8
    for (int i = 0; i < 32; ++i) {
      int n = tid + 256 * i;
      float za, zb;
      if (o == 0) {
        const bf16 qa = f2bf(conv3_at(r0, n, 8192, vw0, vw1, vw2, vbb)), qb = f2bf(conv3_at(r1, n, 8192, vw0, vw1, vw2, vbb));
        ho0[n] = qa; ho1[n] = qb;
        za = bf2f(qa); zb = bf2f(qb);
      } else { za = bf2f(ho0[n]); zb = bf2f(ho1[n]); }
      X[n] = make_float2(za, zb);
    }
    fft_fwd(X, tw8);
#pragma unroll 8
    for (int i = 0; i < 32; ++i) {
      int j = tid + 256 * i, mI = 2 * brev13(j);
      float2 hv = (mI <= 8192) ? Hl[mI] : Hl[16384 - mI];
      if (mI > 8192) hv.y = -hv.y;
      float2 x = X[j];
      X[j] = make_float2(x.x * hv.x - x.y * hv.y, x.x * hv.y + x.y * hv.x);
    }
    fft_inv(X, tw8);
#pragma unroll 8
    for (int i = 0; i < 32; ++i) escr[tid + 256 * i] = X[tid + 256 * i];
#pragma unroll 8
    for (int i = 0; i < 32; ++i) {
      int n = tid + 256 * i;
      const float za = bf2f(ho0[n]), zb = bf2f(ho1[n]);
      float2 w = tw16[n];
      X[n] = make_float2(za * w.x - zb * w.y, za * w.y + zb * w.x);
    }
    fft_fwd(X, tw8);
#pragma unroll 8
    for (int i = 0; i < 32; ++i) {
      int j = tid + 256 * i, mI = 2 * brev13(j) + 1;
      float2 hv = (mI <= 8192) ? Hl[mI] : Hl[16384 - mI];
      if (mI > 8192) hv.y = -hv.y;
      float2 x = X[j];
      X[j] = make_float2(x.x * hv.x - x.y * hv.y, x.x * hv.y + x.y * hv.x);
    }
    fft_inv(X, tw8);
    {
      const int gc = (o + 1) * 256 + ch;
      const float w0 = cw[gc], w1 = cw[768 + gc], w2 = cw[1536 + gc], bb = cb[gc];
      const bf16* g0p = hyraw + ((size_t)(b0 * 768 + gc)) * 8192;
      const bf16* g1p = hyraw + ((size_t)(b1 * 768 + gc)) * 8192;
      const float bias = hb[o * 256 + ch];
#pragma unroll 8
      for (int i = 0; i < 32; ++i) {
        int n = tid + 256 * i;
        const float za = bf2f(ho0[n]), zb = bf2f(ho1[n]);
        float2 x = X[n];
        float2 w = tw16[n];
        float2 ev = escr[n];
        float cr = (ev.x + x.x * w.x + x.y * w.y) * (1.f / 16384.f);
        float ci = (ev.y + x.y * w.x - x.x * w.y) * (1.f / 16384.f);
        float g0 = conv3_at(g0p, n, 8192, w0, w1, w2, bb);
        float g1 = conv3_at(g1p, n, 8192, w0, w1, w2, bb);
        ho0[n] = f2bf(g0 * (cr + za * bias));
        ho1[n] = f2bf(g1 * (ci + zb * bias));
      }
    }
    __syncthreads();
  }
}

DI void hyena_ctx_item(const Params& p, int layer, int ch, float* lds) {
  const int tid = otid();
  float* kf = lds;
  float* kb = lds + 512;
  float* z = lds + 1024;
  const float* part = (const float*)(p.ws + OFF_PART);
  const float* kc = (const float*)(p.ws + OFF_KC);
  const bf16* raw = (const bf16*)(p.ws + A_HYRAWC);
  const float* cw = p.in[18] + layer * 3 * 768;
  const float* cb = p.in[19] + layer * 768;
  const float* hb = p.in[28] + layer * 2 * 256;
  for (int o = 0; o < 2; ++o) {
    float s = 0.f;
    for (int t = 0; t < 8; ++t) s += part[((size_t)2 * 256 + t) * 1024 + o * 512 + ch] + part[((size_t)2 * 256 + t) * 1024 + o * 512 + 256 + ch];
    float sc = rsqrtf(s + EPS);
    kf[o * 256 + tid] = kc[(size_t)(o * 512 + ch) * 256 + tid] * sc;
    kb[o * 256 + tid] = kc[(size_t)(o * 512 + 256 + ch) * 256 + tid] * sc;
  }
  {
    const float w0 = cw[ch], w1 = cw[768 + ch], w2 = cw[1536 + ch], bb = cb[ch];
    for (int b = 0; b < 4; ++b) z[b * 256 + tid] = conv3_at(raw + ((size_t)(b * 768 + ch)) * 256, tid, 256, w0, w1, w2, bb);
  }
  __syncthreads();
  for (int o = 0; o < 2; ++o) {
    const int gc = (o + 1) * 256 + ch;
    const float w0 = cw[gc], w1 = cw[768 + gc], w2 = cw[1536 + gc], bb = cb[gc];
    const float bias = hb[o * 256 + ch];
    float zn[4];
    for (int b = 0; b < 4; ++b) {
      float y = 0.f;
      for (int j = 0; j <= tid; ++j) y += kf[o * 256 + tid - j] * z[b * 256 + j];
      for (int j = tid + 1; j < 256; ++j) y += kb[o * 256 + j - tid] * z[b * 256 + j];
      float g = conv3_at(raw + ((size_t)(b * 768 + gc)) * 256, tid, 256, w0, w1, w2, bb);
      zn[b] = g * (y + z[b * 256 + tid] * bias);
    }
    __syncthreads();
    for (int b = 0; b < 4; ++b) z[b * 256 + tid] = zn[b];
    __syncthreads();
  }
  bf16* ymix = (bf16*)(p.ws + A_YMIX);
  for (int b = 0; b < 4; ++b) ymix[((size_t)(NLAT + b * 256 + tid)) * 1024 + 256 + ch] = f2bf(z[b * 256 + tid]);
  __syncthreads();
}

DI void hyena_tr_item(const Params& p, int it, char* smem) {
  const int tid = otid();
  const int b = it >> 9, ct = (it >> 7) & 3, ntile = it & 127;
  bf16* t = (bf16*)smem;
  const bf16* src = (const bf16*)(p.ws + A_HYOUT) + ((size_t)(b * 256 + ct * 64)) * 8192 + ntile * 64;
  {
    const int nx = tid & 63, cy = tid >> 6;
#pragma unroll
    for (int i = 0; i < 16; ++i) { int c = cy + 4 * i; t[c * 66 + nx] = src[(size_t)c * 8192 + nx]; }
  }
  __syncthreads();
  {
    const int cx = tid & 63, ny = tid >> 6;
    bf16* dst = (bf16*)(p.ws + A_YMIX) + ((size_t)(b * 8192 + ntile * 64)) * 1024 + 256 + ct * 64;
#pragma unroll
    for (int i = 0; i < 16; ++i) { int n = ny + 4 * i; dst[(size_t)n * 1024 + cx] = t[cx * 66 + n]; }
  }
  __syncthreads();
}

constexpr int TLD = 68;
constexpr int TSZ = 64 * TLD;

DI void ssd_stage_raw(bf16* dstraw, const bf16* __restrict__ projA, int rowbase, int seqlen, int s0, int cofs) {
  const int tid = otid();
#pragma unroll
  for (int q = 0; q < 3; ++q) {
    const int c = tid + 256 * q;
    if (c < 544) {
      const int rr = c >> 3, ck = c & 7;
      const int t = s0 - 2 + rr;
      u32x4 v = {0u, 0u, 0u, 0u};
      if (t >= 0 && t < seqlen) v = *(const u32x4*)(projA + (size_t)(rowbase + t) * 768 + 256 + cofs + ck * 8);
      *(u32x4*)(dstraw + rr * 64 + ck * 8) = v;
    }
  }
}
DI void ssd_conv_tile(float* dst, bool transposed, const bf16* raw, int cofs, const float* __restrict__ cw, const float* __restrict__ cb) {
  const int tid = otid(), c = tid & 63, i0 = (tid >> 6) * 16;
  const float w0 = cw[cofs + c], w1 = cw[512 + cofs + c], w2 = cw[1024 + cofs + c], w3 = cw[1536 + cofs + c], w4 = cw[2048 + cofs + c];
  const float bb = cb[cofs + c];
  float x0 = bf2f(raw[(i0 + 0) * 64 + c]), x1 = bf2f(raw[(i0 + 1) * 64 + c]);
  float x2 = bf2f(raw[(i0 + 2) * 64 + c]), x3 = bf2f(raw[(i0 + 3) * 64 + c]);
#pragma unroll
  for (int q = 0; q < 16; ++q) {
    const int i = i0 + q;
    const float x4 = bf2f(raw[(i + 4) * 64 + c]);
    const float acc = bb + w0 * x0 + w1 * x1 + w2 * x2 + w3 * x3 + w4 * x4;
    const float v = silu_f(acc);
    if (transposed) dst[c * TLD + i] = v; else dst[i * TLD + c] = v;
    x0 = x1; x1 = x2; x2 = x3; x3 = x4;
  }
}
DI void ssd_dt2(float* misc, const float* __restrict__ dtraw, int rowbase, int s0, int head, const float* __restrict__ alog, const float* __restrict__ dtbias) {
  const int tid = otid();
  if (tid < 128) {
    const int dir = tid >> 6, l = tid & 63;
    const int j = dir ? (63 - l) : l;
    const float a_h = -expf(alog[dir * 4 + head]);
    float x = dtraw[(size_t)(rowbase + s0 + j) * 8 + dir * 4 + head] + dtbias[dir * 4 + head];
    float dt = (x > 20.f) ? x : log1pf(expf(x));
    float v = dt * a_h;
#pragma unroll
    for (int off = 1; off < 64; off <<= 1) {
      float u = __shfl_up(v, off);
      if (l >= off) v += u;
    }
    misc[dir * 64 + j] = dt;
    misc[128 + dir * 64 + j] = v;
  }
}

struct SsdItem2 { int b, head, c, rowbase, seqlen, s0, of, ob, seqf, seqb; bool ctx; };
DI SsdItem2 ssd_decode2(int it) {
  SsdItem2 s;
  const int bh = it / NORD, o = it % NORD;
  s.b = bh >> 2; s.head = bh & 3;
  s.ctx = (o < 4);
  if (s.ctx) { s.c = o; s.rowbase = NLAT + s.b * 256; s.seqlen = 256; s.of = o; s.ob = 3 - o; }
  else { s.c = o - 4; s.rowbase = s.b * 8192; s.seqlen = 8192; s.of = o; s.ob = 4 + 127 - s.c; }
  s.s0 = s.c * 64;
  s.seqf = (s.b * 2 + 0) * 4 + s.head;
  s.seqb = (s.b * 2 + 1) * 4 + s.head;
  return s;
}

DI void ssd_s1_item(const Params& p, int layer, int it, float* lds) {
  const int tid = otid();
  const SsdItem2 s = ssd_decode2(it);
  float* Xs = lds;
  float* Bs = lds + TSZ;
  bf16* raw = (bf16*)(lds + 2 * TSZ);
  float* misc = lds + 4 * TSZ;
  const bf16* projA = (const bf16*)(p.ws + A_PROJA);
  const float* cw = p.in[12] + layer * 5 * 512;
  const float* cb = p.in[13] + layer * 512;
  ssd_stage_raw(raw, projA, s.rowbase, s.seqlen, s.s0, s.head * 64);
  ssd_stage_raw(raw + 68 * 64, projA, s.rowbase, s.seqlen, s.s0, 256 + (s.head >> 1) * 64);
  ssd_dt2(misc, (const float*)(p.ws + OFF_DT), s.rowbase, s.s0, s.head, p.in[14] + layer * 8, p.in[15] + layer * 8);
  __syncthreads();
  ssd_conv_tile(Xs, false, raw, s.head * 64, cw, cb);
  ssd_conv_tile(Bs, false, raw + 68 * 64, 256 + (s.head >> 1) * 64, cw, cb);
  if (tid < 64) {
    misc[256 + tid] = fexp(misc[128 + 63] - misc[128 + tid]) * misc[tid];
    misc[320 + tid] = fexp(misc[192 + 0] - misc[192 + tid]) * misc[64 + tid];
  }
  __syncthreads();
  const int tp = tid >> 4, tn = tid & 15;
  v2f af2[4][2], ab2[4][2];
#pragma unroll
  for (int a = 0; a < 4; ++a)
#pragma unroll
    for (int c = 0; c < 2; ++c) { af2[a][c] = v2f{0.f, 0.f}; ab2[a][c] = v2f{0.f, 0.f}; }
#pragma unroll 2
  for (int j = 0; j < 64; ++j) {
    const float wf = misc[256 + j], wb = misc[320 + j];
    float4 xv = *(const float4*)(Xs + j * TLD + tp * 4);
    float4 bv = *(const float4*)(Bs + j * TLD + tn * 4);
    const v2f b01 = {bv.x, bv.y}, b23 = {bv.z, bv.w};
    float xa[4] = {xv.x, xv.y, xv.z, xv.w};
#pragma unroll
    for (int a = 0; a < 4; ++a) {
      const float xf = xa[a] * wf, xb = xa[a] * wb;
      const v2f xf2 = {xf, xf}, xb2 = {xb, xb};
      af2[a][0] += xf2 * b01; af2[a][1] += xf2 * b23;
      ab2[a][0] += xb2 * b01; ab2[a][1] += xb2 * b23;
    }
  }
  float accf[4][4], accb[4][4];
#pragma unroll
  for (int a = 0; a < 4; ++a) {
    accf[a][0] = af2[a][0].x; accf[a][1] = af2[a][0].y; accf[a][2] = af2[a][1].x; accf[a][3] = af2[a][1].y;
    accb[a][0] = ab2[a][0].x; accb[a][1] = ab2[a][0].y; accb[a][2] = ab2[a][1].x; accb[a][3] = ab2[a][1].y;
  }
  float* stf = (float*)(p.ws + A_STATES) + ((size_t)s.seqf * NORD + s.of) * 4096;
  float* stb = (float*)(p.ws + A_STATES) + ((size_t)s.seqb * NORD + s.ob) * 4096;
#pragma unroll
  for (int c = 0; c < 4; ++c) {
    *(float4*)(stf + (tn * 4 + c) * 64 + tp * 4) = make_float4(accf[0][c], accf[1][c], accf[2][c], accf[3][c]);
    *(float4*)(stb + (tn * 4 + c) * 64 + tp * 4) = make_float4(accb[0][c], accb[1][c], accb[2][c], accb[3][c]);
  }
  if (tid == 0) {
    ((float*)(p.ws + OFF_DEC))[s.seqf * NORD + s.of] = expf(misc[128 + 63]);
    ((float*)(p.ws + OFF_DEC))[s.seqb * NORD + s.ob] = expf(misc[192 + 0]);
  }
  __syncthreads();
}

DI void ssd_scan_item(const Params& p, int it) {
  const int g = it * 256 + otid();
  const int seq = g >> 12, e = g & 4095;
  float* st = (float*)(p.ws + A_STATES) + (size_t)seq * NORD * 4096 + e;
  const float* dec = (const float*)(p.ws + OFF_DEC) + seq * NORD;
  float hcur = 0.f;
#pragma unroll 12
  for (int o = 0; o < NORD; ++o) {
    float sv = st[(size_t)o * 4096];
    st[(size_t)o * 4096] = hcur;
    hcur = dec[o] * hcur + sv;
  }
}

DI void ssd_s3_item(const Params& p, int layer, int it, float* lds) {
  const int tid = otid();
  const SsdItem2 s = ssd_decode2(it);
  if (layer == 1 && s.ctx) return;
  float* T0 = lds;
  float* T1 = lds + TSZ;
  float* T2 = lds + 2 * TSZ;
  float* T3 = lds + 3 * TSZ;
  float* misc = lds + 4 * TSZ;
  bf16* raw = (bf16*)T2;
  const bf16* projA = (const bf16*)(p.ws + A_PROJA);
  const float* cw = p.in[12] + layer * 5 * 512;
  const float* cb = p.in[13] + layer * 512;
  ssd_stage_raw(raw, projA, s.rowbase, s.seqlen, s.s0, 384 + (s.head >> 1) * 64);
  ssd_stage_raw(raw + 68 * 64, projA, s.rowbase, s.seqlen, s.s0, 256 + (s.head >> 1) * 64);
  ssd_dt2(misc, (const float*)(p.ws + OFF_DT), s.rowbase, s.s0, s.head, p.in[14] + layer * 8, p.in[15] + layer * 8);
  __syncthreads();
  ssd_conv_tile(T0, true, raw, 384 + (s.head >> 1) * 64, cw, cb);
  ssd_conv_tile(T1, true, raw + 68 * 64, 256 + (s.head >> 1) * 64, cw, cb);
  __syncthreads();
  ssd_stage_raw(raw, projA, s.rowbase, s.seqlen, s.s0, s.head * 64);
  __syncthreads();
  ssd_conv_tile(T3, false, raw, s.head * 64, cw, cb);
  __syncthreads();
  const float* dtf = misc; const float* dtb = misc + 64; const float* af = misc + 128; const float* ab = misc + 192;
  const int ti = tid >> 4, tj = tid & 15;
  {
    float acc[4][4];
#pragma unroll
    for (int a = 0; a < 4; ++a)
#pragma unroll
      for (int c = 0; c < 4; ++c) acc[a][c] = 0.f;
    v2f g2[4][2];
#pragma unroll
    for (int a = 0; a < 4; ++a) { g2[a][0] = v2f{0.f, 0.f}; g2[a][1] = v2f{0.f, 0.f}; }
#pragma unroll 4
    for (int n = 0; n < 64; ++n) {
      float4 bv = *(const float4*)(T1 + n * TLD + tj * 4);
      const v2f b01 = {bv.x, bv.y}, b23 = {bv.z, bv.w};
      const float4 c4 = *(const float4*)(T0 + n * TLD + ti * 4);
      const float cva[4] = {c4.x, c4.y, c4.z, c4.w};
#pragma unroll
      for (int a = 0; a < 4; ++a) {
        const v2f c2 = {cva[a], cva[a]};
        g2[a][0] += c2 * b01; g2[a][1] += c2 * b23;
      }
    }
#pragma unroll
    for (int a = 0; a < 4; ++a) { acc[a][0] = g2[a][0].x; acc[a][1] = g2[a][0].y; acc[a][2] = g2[a][1].x; acc[a][3] = g2[a][1].y; }
#pragma unroll
    for (int c = 0; c < 4; ++c) {
      const int j = tj * 4 + c;
      float o4[4];
#pragma unroll
      for (int a = 0; a < 4; ++a) {
        const int i = ti * 4 + a;
        float m = 0.f;
        if (j <= i) m += fexp(af[i] - af[j]) * dtf[j];
        if (j >= i) m += fexp(ab[i] - ab[j]) * dtb[j];
        o4[a] = acc[a][c] * m;
      }
      *(float4*)(T2 + j * TLD + ti * 4) = make_float4(o4[0], o4[1], o4[2], o4[3]);
    }
  }
  __syncthreads();
  {
    const float* st = (const float*)(p.ws + A_STATES) + ((size_t)s.seqf * NORD + s.of) * 4096;
#pragma unroll
    for (int q = 0; q < 4; ++q) {
      int e4 = tid + 256 * q;
      int n = e4 >> 4, p4 = (e4 & 15) * 4;
      *(float4*)(T1 + n * TLD + p4) = *(const float4*)(st + n * 64 + p4);
    }
  }
  __syncthreads();
  const int tp = tj;
  float acc1[4][4], acc2[4][4];
#pragma unroll
  for (int a = 0; a < 4; ++a)
#pragma unroll
    for (int c = 0; c < 4; ++c) { acc1[a][c] = 0.f; acc2[a][c] = 0.f; }
  {
    v2f p1[4][2], p2[4][2];
#pragma unroll
    for (int a = 0; a < 4; ++a) { p1[a][0] = v2f{0.f, 0.f}; p1[a][1] = v2f{0.f, 0.f}; p2[a][0] = v2f{0.f, 0.f}; p2[a][1] = v2f{0.f, 0.f}; }
#pragma unroll 2
    for (int j = 0; j < 64; ++j) {
      float4 xv = *(const float4*)(T3 + j * TLD + tp * 4);
      float4 hv = *(const float4*)(T1 + j * TLD + tp * 4);
      const v2f x01 = {xv.x, xv.y}, x23 = {xv.z, xv.w}, h01 = {hv.x, hv.y}, h23 = {hv.z, hv.w};
      const float4 s4 = *(const float4*)(T2 + j * TLD + ti * 4), c4 = *(const float4*)(T0 + j * TLD + ti * 4);
      const float sva[4] = {s4.x, s4.y, s4.z, s4.w}, cva[4] = {c4.x, c4.y, c4.z, c4.w};
#pragma unroll
      for (int a = 0; a < 4; ++a) {
        const v2f s2 = {sva[a], sva[a]}, c2 = {cva[a], cva[a]};
        p1[a][0] += s2 * x01; p1[a][1] += s2 * x23;
        p2[a][0] += c2 * h01; p2[a][1] += c2 * h23;
      }
    }
#pragma unroll
    for (int a = 0; a < 4; ++a) {
      acc1[a][0] = p1[a][0].x; acc1[a][1] = p1[a][0].y; acc1[a][2] = p1[a][1].x; acc1[a][3] = p1[a][1].y;
      acc2[a][0] = p2[a][0].x; acc2[a][1] = p2[a][0].y; acc2[a][2] = p2[a][1].x; acc2[a][3] = p2[a][1].y;
    }
  }
#pragma unroll
  for (int a = 0; a < 4; ++a) {
    const float ei = fexp(af[ti * 4 + a]);
#pragma unroll
    for (int c = 0; c < 4; ++c) acc1[a][c] += ei * acc2[a][c];
  }
  __syncthreads();
  {
    const float* st = (const float*)(p.ws + A_STATES) + ((size_t)s.seqb * NORD + s.ob) * 4096;
#pragma unroll
    for (int q = 0; q < 4; ++q) {
      int e4 = tid + 256 * q;
      int n = e4 >> 4, p4 = (e4 & 15) * 4;
      *(float4*)(T1 + n * TLD + p4) = *(const float4*)(st + n * 64 + p4);
    }
  }
  __syncthreads();
#pragma unroll
  for (int a = 0; a < 4; ++a)
#pragma unroll
    for (int c = 0; c < 4; ++c) acc2[a][c] = 0.f;
  {
    v2f p2[4][2];
#pragma unroll
    for (int a = 0; a < 4; ++a) { p2[a][0] = v2f{0.f, 0.f}; p2[a][1] = v2f{0.f, 0.f}; }
#pragma unroll 4
    for (int n = 0; n < 64; ++n) {
      float4 hv = *(const float4*)(T1 + n * TLD + tp * 4);
      const v2f h01 = {hv.x, hv.y}, h23 = {hv.z, hv.w};
      const float4 c4 = *(const float4*)(T0 + n * TLD + ti * 4);
      const float cva[4] = {c4.x, c4.y, c4.z, c4.w};
#pragma unroll
      for (int a = 0; a < 4; ++a) {
        const v2f c2 = {cva[a], cva[a]};
        p2[a][0] += c2 * h01; p2[a][1] += c2 * h23;
      }
    }
#pragma unroll
    for (int a = 0; a < 4; ++a) { acc2[a][0] = p2[a][0].x; acc2[a][1] = p2[a][0].y; acc2[a][2] = p2[a][1].x; acc2[a][3] = p2[a][1].y; }
  }
  const float dsk = p.in[16][layer * 4 + s.head];
  float* yssd = (float*)(p.ws + A_YSSD);
#pragma unroll
  for (int a = 0; a < 4; ++a) {
    const int i = ti * 4 + a;
    const float eb = fexp(ab[i]);
    float4 xv = *(const float4*)(T3 + i * TLD + tp * 4);
    float4 o;
    o.x = acc1[a][0] + eb * acc2[a][0] + dsk * xv.x;
    o.y = acc1[a][1] + eb * acc2[a][1] + dsk * xv.y;
    o.z = acc1[a][2] + eb * acc2[a][2] + dsk * xv.z;
    o.w = acc1[a][3] + eb * acc2[a][3] + dsk * xv.w;
    *(float4*)(yssd + (size_t)(s.rowbase + s.s0 + i) * 256 + s.head * 64 + tp * 4) = o;
  }
  __syncthreads();
}

DI void ssd_gate_row(int lane, int row, f32x4 yv, u32x2 zv, const float* __restrict__ ng, bf16* __restrict__ ymix) {
  const int c0 = lane * 4;
  const float z[4] = {__uint_as_float(zv.x << 16), __uint_as_float(zv.x & 0xffff0000u), __uint_as_float(zv.y << 16), __uint_as_float(zv.y & 0xffff0000u)};
  const float y[4] = {yv.x, yv.y, yv.z, yv.w};
  float g[4];
  float ss = 0.f;
#pragma unroll
  for (int e = 0; e < 4; ++e) {
    g[e] = y[e] * silu_f(z[e]);
    ss += g[e] * g[e];
  }
  ss = wave_sum(ss);
  const float rstd = rsqrtf(ss * (1.f / 256.f) + EPS);
  float4 gw = *(const float4*)(ng + c0);
  uint2 o;
  o.x = pack2(g[0] * rstd * gw.x, g[1] * rstd * gw.y);
  o.y = pack2(g[2] * rstd * gw.z, g[3] * rstd * gw.w);
  *(uint2*)(ymix + (size_t)row * 1024 + c0) = o;
}
DI void ssd_gate_phase(const Params& p, int layer) {
  const int lane = otid() & 63, wave = otid() >> 6;
  const int nrows = (layer == 0) ? MROWS : NLAT;
  const bf16* projA = (const bf16*)(p.ws + A_PROJA);
  const float* yssd = (const float*)(p.ws + A_YSSD);
  const float* ng = p.in[17] + layer * 256;
  bf16* ymix = (bf16*)(p.ws + A_YMIX);
  const int c0 = lane * 4;
  for (int r4 = blockIdx.x; r4 * 4 < nrows; r4 += 2 * gridDim.x) {
    const int rowA = r4 * 4 + wave, rowB = rowA + 4 * (int)gridDim.x;
    const bool hasB = ((r4 + (int)gridDim.x) * 4 < nrows);
    const f32x4 yA = *(const f32x4*)(yssd + (size_t)rowA * 256 + c0);
    const u32x2 zA = *(const u32x2*)(projA + (size_t)rowA * 768 + c0);
    f32x4 yB = yA; u32x2 zB = zA;
    if (hasB) {
      yB = *(const f32x4*)(yssd + (size_t)rowB * 256 + c0);
      zB = *(const u32x2*)(projA + (size_t)rowB * 768 + c0);
    }
    ssd_gate_row(lane, rowA, yA, zA, ng, ymix);
    if (hasB) ssd_gate_row(lane, rowB, yB, zB, ng, ymix);
  }
}

DI void phase_pro0(const Params& p, char* smem) {
  float* lds = (float*)smem;
  const int tid = otid();
  constexpr int N_W = 5888, N_MOD = 192, N_F1 = 520, N_ROPE = 1024, N_TW = 48;
  const int rb = gridDim.x - 1 - blockIdx.x;
  for (int it = blockIdx.x; it < 512; it += gridDim.x) filt_f1(p, it >> 8, it & 255, lds);
  for (int it = rb; it < N_MOD; it += gridDim.x) mod_item(p, it, lds);
  for (int it = rb - N_MOD; it < N_F1 - 512; it += gridDim.x) if (it >= 0) filt_f1(p, 2, it, lds);
  {
    struct WT { const float* src; bf16* dst; int sld, dld, k0, n0, shift; };
    auto decode = [&](int it) -> WT {
      WT w; int kt, nt; w.shift = 0;
      if (it < 1280) {
        int layer = it / 640, r = it % 640; kt = r / 40; nt = r % 40; w.shift = 8;
        w.src = p.in[10] + (size_t)layer * 1024 * 2568; w.sld = 2568; w.dst = (bf16*)(p.ws + OFF_WIN) + (size_t)layer * 2560 * 1024; w.dld = 1024;
      } else if (it < 1792) {
        int r = it - 1280, layer = r / 256; r %= 256; kt = r / 16; nt = r % 16;
        w.src = p.in[11] + (size_t)layer * 1024 * 1024; w.sld = 1024; w.dst = (bf16*)(p.ws + OFF_WOUT) + (size_t)layer * 1024 * 1024; w.dld = 1024;
      } else if (it < 3840) {
        int r = it - 1792, layer = r / 1024; r %= 1024; kt = r / 64; nt = r % 64;
        w.src = p.in[32] + (size_t)layer * 1024 * 4096; w.sld = 4096; w.dst = (bf16*)(p.ws + OFF_W1) + (size_t)layer * 4096 * 1024; w.dld = 1024;
      } else {
        int r = it - 3840, layer = r / 1024; r %= 1024; kt = r / 16; nt = r % 16;
        w.src = p.in[33] + (size_t)layer * 4096 * 1024; w.sld = 1024; w.dst = (bf16*)(p.ws + OFF_W2) + (size_t)layer * 1024 * 4096; w.dld = 4096;
      }
      w.k0 = kt * 64; w.n0 = nt * 64;
      return w;
    };
    const int tx = tid & 63, ty = tid >> 6;
    const int kx2 = tid & 31, ny = tid >> 5;
    for (int it = blockIdx.x; it < N_W; it += 2 * gridDim.x) {
      const int itb = it + gridDim.x;
      const bool hasb = (itb < N_W);
      const WT wa = decode(it);
      const WT wb = decode(hasb ? itb : it);
      float va[16], vb[16];
      {
        const int na = wa.n0 + tx, ca = na + ((na >= 768) ? wa.shift : 0);
        const int nb = wb.n0 + tx, cb_ = nb + ((nb >= 768) ? wb.shift : 0);
#pragma unroll
        for (int i = 0; i < 16; ++i) va[i] = wa.src[(size_t)(wa.k0 + ty + 4 * i) * wa.sld + ca];
        if (hasb) {
#pragma unroll
          for (int i = 0; i < 16; ++i) vb[i] = wb.src[(size_t)(wb.k0 + ty + 4 * i) * wb.sld + cb_];
        }
      }
#pragma unroll
      for (int i = 0; i < 16; ++i) lds[(ty + 4 * i) * 65 + tx] = va[i];
      if (hasb) {
#pragma unroll
        for (int i = 0; i < 16; ++i) lds[4160 + (ty + 4 * i) * 65 + tx] = vb[i];
      }
      __syncthreads();
#pragma unroll
      for (int i = 0; i < 8; ++i) {
        const int nn = ny + 8 * i;
        *(unsigned*)(wa.dst + (size_t)(wa.n0 + nn) * wa.dld + wa.k0 + 2 * kx2) = pack2(lds[(2 * kx2) * 65 + nn], lds[(2 * kx2 + 1) * 65 + nn]);
      }
      if (hasb) {
#pragma unroll
        for (int i = 0; i < 8; ++i) {
          const int nn = ny + 8 * i;
          *(unsigned*)(wb.dst + (size_t)(wb.n0 + nn) * wb.dld + wb.k0 + 2 * kx2) = pack2(lds[4160 + (2 * kx2) * 65 + nn], lds[4160 + (2 * kx2 + 1) * 65 + nn]);
        }
      }
      __syncthreads();
    }
  }
  for (int it = blockIdx.x; it < N_TW; it += gridDim.x) {
    int idx = it * 256 + tid;
    if (idx < 4096) ((float2*)(p.ws + OFF_TW8))[idx] = make_float2(cospif((float)idx / 4096.f), -sinpif((float)idx / 4096.f));
    else { int j = idx - 4096; ((float2*)(p.ws + OFF_TW16))[j] = make_float2(cospif((float)j / 8192.f), -sinpif((float)j / 8192.f)); }
  }
}

DI void phase_pro1(const Params& p, char* smem) {
  for (int it = blockIdx.x; it < 1024; it += gridDim.x) filt_f2(p, it, smem);
  rowpass_phase(p, 0, 0, smem);
}

DI void attn_dispatch(const Params& p, int layer, int akind, int ar_, char* smem) {
  const bf16* QB = (const bf16*)(p.ws + A_QB);
  const bf16* KB = (const bf16*)(p.ws + A_KB);
  const bf16* VT = (const bf16*)(p.ws + A_VT);
  bf16* ymix = (bf16*)(p.ws + A_YMIX);
  int g, b, head, q0, lo, hi, orow, ocol;
  bool window = false, has_sink = false;
  if (akind == 0) {
    g = 1; b = ar_ >> 8; head = (ar_ >> 6) & 3; q0 = (ar_ & 63) * 128; lo = 0; hi = SEQ; orow = b * 8192 + q0; ocol = 768;
  } else if (akind == 1) {
    g = 0; b = ar_ >> 8; head = (ar_ >> 6) & 3; q0 = (ar_ & 63) * 128;
    lo = (q0 - 128 < 0) ? 0 : (q0 - 128); hi = (q0 + 256 > SEQ) ? SEQ : (q0 + 256);
    window = true; has_sink = true; orow = b * 8192 + q0; ocol = 512;
  } else {
    g = ar_ >> 5; b = (ar_ >> 3) & 3; head = (ar_ >> 1) & 3; const int qt = ar_ & 1;
    q0 = SEQ + qt * 128; lo = 0; hi = 0; has_sink = (g == 0); orow = NLAT + b * 256 + qt * 128; ocol = (g == 0) ? 512 : 768;
  }
  attn_item(QB + ((size_t)((g * 4 + b) * 4 + head)) * KEYS * 64, KB + ((size_t)((g * 4 + b) * 2 + (head >> 1))) * KEYS * 64,
            VT + ((size_t)((g * 4 + b) * 2 + (head >> 1))) * 64 * KEYS, q0, lo, hi, 4, window, has_sink,
            p.in[29][layer * 4 + head] * LOG2E, ymix + (size_t)orow * 1024 + ocol + head * 64, smem);
}

DI void phase_mix1(const Params& p, int layer, char* smem) {
  const int tid = otid();
  const int N_DENSE = 1024, N_FFT = 512, N_WIN = 1024, N_S1 = 16 * NORD;
  const int N_CH = (layer == 0) ? 256 : 0, N_CA = (layer == 0) ? 64 : 0;
  const int n_att = N_DENSE + N_WIN + N_CA;
  for (int it = blockIdx.x; it < n_att; it += gridDim.x) {
    int akind, ar_;
    if (it < N_DENSE) { akind = 0; ar_ = it; }
    else if (it < N_DENSE + N_WIN) { akind = 1; ar_ = it - N_DENSE; }
    else { akind = 2; ar_ = it - N_DENSE - N_WIN; }
    attn_dispatch(p, layer, akind, ar_, smem);
  }
  for (int it = blockIdx.x; it < N_FFT; it += gridDim.x) hyena_fft_item(p, layer, it, smem);
  for (int it = blockIdx.x; it < N_S1; it += gridDim.x) ssd_s1_item(p, layer, it, (float*)smem);
  for (int it = blockIdx.x; it < N_CH; it += gridDim.x) hyena_ctx_item(p, layer, it, (float*)smem);
}

DI void phase_mix2(const Params& p, int layer, char* smem) {
  const int total = 512 + 2048;
  for (int it = blockIdx.x; it < total; it += gridDim.x) {
    if (it < 512) ssd_scan_item(p, it);
    else hyena_tr_item(p, it - 512, smem);
  }
}

DI void phase_mix3(const Params& p, int layer, char* smem) {
  for (int it = blockIdx.x; it < 16 * NORD; it += gridDim.x) ssd_s3_item(p, layer, it, (float*)smem);
}

template <int K>
DI void run_phase_k(const Params& p, int layer, char* smem) {
  if (K == -2) phase_pro0(p, smem);
  else if (K == -1) phase_pro1(p, smem);
  else if (K == 0) gemm_phase(p, layer, 1, 0, smem);
  else if (K == 1) phase_mix1(p, layer, smem);
  else if (K == 2) phase_mix2(p, layer, smem);
  else if (K == 3) phase_mix3(p, layer, smem);
  else if (K == 4) ssd_gate_phase(p, layer);
  else if (K == 5) gemm_phase(p, layer, 2, 0, smem);
  else if (K == 6) rowpass_phase(p, layer, 1, smem);
  else if (K == 7) gemm_phase(p, layer, 3, 0, smem);
  else if (K == 8) gemm_phase(p, layer, 4, 0, smem);
  else if (K == 9) gemm_phase(p, layer, 3, 1, smem);
  else if (K == 10) gemm_phase(p, layer, 4, 1, smem);
  else rowpass_phase(p, layer, 2, smem);
}
#ifndef PHASE_MASK
#define PHASE_MASK 0xffff
#endif
#define PM(k) ((PHASE_MASK >> (k)) & 1)
DI void run_phase(const Params& p, int ph, char* smem) {
  if (ph == 0) { if (PM(12)) run_phase_k<-2>(p, 0, smem); return; }
  if (ph == 1) { if (PM(13)) run_phase_k<-1>(p, 0, smem); return; }
  const int layer = (ph - 2) / 12, k = (ph - 2) % 12;
  switch (k) {
    case 0: if (PM(0)) run_phase_k<0>(p, layer, smem); break;
    case 1: if (PM(1)) run_phase_k<1>(p, layer, smem); break;
    case 2: if (PM(2)) run_phase_k<2>(p, layer, smem); break;
    case 3: if (PM(3)) run_phase_k<3>(p, layer, smem); break;
    case 4: if (PM(4)) run_phase_k<4>(p, layer, smem); break;
    case 5: if (PM(5)) run_phase_k<5>(p, layer, smem); break;
    case 6: if (PM(6)) run_phase_k<6>(p, layer, smem); break;
    case 7: if (PM(7)) run_phase_k<7>(p, layer, smem); break;
    case 8: if (PM(8)) run_phase_k<8>(p, layer, smem); break;
    case 9: if (PM(9)) run_phase_k<9>(p, layer, smem); break;
    case 10: if (PM(10)) run_phase_k<10>(p, layer, smem); break;
    default: if (PM(11)) run_phase_k<11>(p, layer, smem); break;
  }
}

constexpr int N_PHASES = 2 + 2 * 12;

#if 1
__global__ void __launch_bounds__(256, 2) fwd_megakernel(Params p) {
  __shared__ __attribute__((aligned(16))) char smem[SMEM_BYTES];
  __shared__ uint4 xb_words;
  if (threadIdx.x == 0) xb_words = make_uint4(0u, 0u, 0u, 0u);
  __syncthreads();
  XcdBarrier xb = xcd_barrier_post((unsigned*)(p.ws + OFF_BAR), (volatile LAS unsigned*)&xb_words);
  for (int ph = p.ph0; ph < p.ph1; ++ph) {
    run_phase(p, ph, smem);
    if (ph + 1 < p.ph1) {
      if (p.coop == 2) cg::this_grid().sync();
      else xcd_barrier(xb);
    }
  }
}
#endif
#if 1
template <int K>
__global__ void __launch_bounds__(256, 2) phase_kernel(Params p) {
  __shared__ __attribute__((aligned(16))) char smem[SMEM_BYTES];
  run_phase_k<K>(p, p.ph0, smem);
}
template <int K>
static void launch_phase(Params p, int layer, int grid, hipStream_t stream) {
  p.ph0 = layer; p.ph1 = layer + 1;
  hipLaunchKernelGGL(phase_kernel<K>, dim3(grid), dim3(256), 0, stream, p);
}
#endif

extern "C" void kernel_launch(void* const* d_in, const int* in_sizes, int n_in, void* d_out, int out_size, void* d_ws,
                              size_t ws_size, hipStream_t stream) {
  static int grid_blocks = 0, grid_fallback = 0;
  if (!grid_blocks) {
    int dev = 0, cus = 0, per_cu = 0;
    (void)hipGetDevice(&dev);
    (void)hipDeviceGetAttribute(&cus, hipDeviceAttributeMultiprocessorCount, dev);
#if ONE_LAUNCH
    (void)hipOccupancyMaxActiveBlocksPerMultiprocessor(&per_cu, fwd_megakernel, 256, 0);
#else
    per_cu = 2;
#endif
    if (per_cu < 1) per_cu = 1;
    if (per_cu > 2) per_cu = 2;
    grid_fallback = cus * per_cu;
    grid_blocks = cus * 2;
  }
  Params p{};
  for (int i = 0; i < 34; ++i) p.in[i] = (const float*)d_in[i];
  p.out = (float*)d_out;
  p.ws = (char*)d_ws;
  p.pad = 0;
  if (ws_size < WS_TOTAL) { fprintf(stderr, "workspace too small: %zu < %zu\n", ws_size, (size_t)WS_TOTAL); return; }
#if ONE_LAUNCH == 2
#ifndef SEP_MASK
#define SEP_MASK 0x7A1
#endif
  for (int ph = 0; ph < N_PHASES; ++ph) {
    p.coop = 0;
    const int k = (ph < 2) ? (12 + ph) : ((ph - 2) % 12), layer = (ph < 2) ? 0 : (ph - 2) / 12;
    if ((SEP_MASK >> k) & 1) {
      switch (k) {
        case 0: launch_phase<0>(p, layer, 512, stream); break;
        case 1: launch_phase<1>(p, layer, 512, stream); break;
        case 2: launch_phase<2>(p, layer, 512, stream); break;
        case 3: launch_phase<3>(p, layer, 512, stream); break;
        case 4: launch_phase<4>(p, layer, 512, stream); break;
        case 5: launch_phase<5>(p, layer, 512, stream); break;
        case 6: launch_phase<6>(p, layer, 512, stream); break;
        case 7: launch_phase<7>(p, layer, 512, stream); break;
        case 8: launch_phase<8>(p, layer, 512, stream); break;
        case 9: launch_phase<9>(p, layer, 512, stream); break;
        case 10: launch_phase<10>(p, layer, 512, stream); break;
        case 11: launch_phase<11>(p, layer, 512, stream); break;
        case 12: launch_phase<-2>(p, 0, 512, stream); break;
        default: launch_phase<-1>(p, 0, 512, stream); break;
      }
    } else {
      p.ph0 = ph; p.ph1 = ph + 1;
      hipLaunchKernelGGL(fwd_megakernel, dim3(512), dim3(256), 0, stream, p);
    }
  }
#elif ONE_LAUNCH
  p.ph0 = 0; p.ph1 = N_PHASES; p.coop = 1;
  void* args[] = {&p};
  (void)hipMemsetAsync(p.ws + OFF_BAR, 0, XCD_BAR_WORDS * 4, stream);
  hipError_t e = hipLaunchCooperativeKernel((void*)fwd_megakernel, dim3(grid_blocks), dim3(256), args, 0, stream);
  if (e != hipSuccess && grid_blocks != grid_fallback) {
    (void)hipGetLastError();
    grid_blocks = grid_fallback;
    e = hipLaunchCooperativeKernel((void*)fwd_megakernel, dim3(grid_blocks), dim3(256), args, 0, stream);
  }
  if (e != hipSuccess) fprintf(stderr, "cooperative launch failed: %s (grid %d)\n", hipGetErrorString(e), grid_blocks);
#else
  p.coop = 0;
  launch_phase<-2>(p, 0, grid_blocks, stream);
  launch_phase<-1>(p, 0, grid_blocks, stream);
  for (int layer = 0; layer < 2; ++layer) {
    launch_phase<0>(p, layer, grid_blocks, stream);
    launch_phase<1>(p, layer, grid_blocks, stream);
    launch_phase<2>(p, layer, grid_blocks, stream);
    launch_phase<3>(p, layer, grid_blocks, stream);
    launch_phase<4>(p, layer, grid_blocks, stream);
    launch_phase<5>(p, layer, grid_blocks, stream);
    launch_phase<6>(p, layer, grid_blocks, stream);
    launch_phase<7>(p, layer, grid_blocks, stream);
    launch_phase<8>(p, layer, grid_blocks, stream);
    launch_phase<9>(p, layer, grid_blocks, stream);
    launch_phase<10>(p, layer, grid_blocks, stream);
    launch_phase<11>(p, layer, grid_blocks, stream);
  }
#endif
}
```
